# Optimizing an MI355X kernel written in HIP

```python
import math
import jax, jax.numpy as jnp
from jax import lax
import numpy as np

D_MODEL = 1024
BATCH = 4
SEQ = 8192
DEPTH = 2

N_MIXERS = 2
N_A_LAYERS = (DEPTH + 1) // 2
N_B_LAYERS = DEPTH // 2

CHUNK = 128
GATE_WIDTH = D_MODEL
GATE_GROUPS = 8
GATE_GROUP_DIM = GATE_WIDTH // GATE_GROUPS

WINDOW_DILATIONS = ((128, 1), (512, 4), (2048, 16))
N_DIL_GROUPS = len(WINDOW_DILATIONS)
ATT_HEADS = 8
HEAD_DIM = 64
ATT_WIDTH = ATT_HEADS * HEAD_DIM

N_BUCKETS = 32
MAX_EXACT = N_BUCKETS // 2
REL_MAX_DISTANCE = max(w for w, _ in WINDOW_DILATIONS)

D_FF = 4 * D_MODEL

EPS = 1e-6
NEG_INF = -1e30

kernel_name = "interleaved_gmlp_dilated_attention_trunk"


def _rms_norm(x, g):
    xf = x.astype(jnp.float32)
    y = xf * lax.rsqrt(jnp.mean(xf * xf, axis=-1, keepdims=True) + EPS)
    return (y * g.astype(jnp.float32)).astype(x.dtype)


def _layer_norm(x, g, b):
    xf = x.astype(jnp.float32)
    mu = jnp.mean(xf, axis=-1, keepdims=True)
    xc = xf - mu
    y = xc * lax.rsqrt(jnp.mean(xc * xc, axis=-1, keepdims=True) + EPS)
    return (y * g.astype(jnp.float32) + b.astype(jnp.float32)).astype(x.dtype)


def _t5_bucket(distance):
    small = distance < MAX_EXACT
    nf = jnp.maximum(distance, 1).astype(jnp.float32)
    large = MAX_EXACT + (jnp.log(nf / MAX_EXACT) / math.log(REL_MAX_DISTANCE / MAX_EXACT)
                         * (N_BUCKETS - MAX_EXACT)).astype(jnp.int32)
    large = jnp.minimum(large, N_BUCKETS - 1)
    return jnp.where(small, distance, large)


def _chunk_gating_mixer(h, w_in, ln_g, ln_b, w_s, b_s, w_out):
    B_, S_, _ = h.shape
    uv = jax.nn.gelu(h @ w_in, approximate=False)
    u, v = jnp.split(uv, 2, axis=-1)
    v = _layer_norm(v, ln_g, ln_b)
    nc = S_ // CHUNK
    v = v.reshape(B_, nc, CHUNK, GATE_GROUPS, GATE_GROUP_DIM)
    causal = jnp.tril(jnp.ones((CHUNK, CHUNK), dtype=bool))
    w = jnp.where(causal[None], w_s, 0.0)
    mixed = jnp.einsum('gts,bnsgc->bntgc', w, v) + b_s.T[None, None, :, :, None]
    gate = mixed.reshape(B_, S_, GATE_WIDTH)
    return (u * gate) @ w_out


def _dilated_group(q, k, v, bias_table, window, dilation):
    B_, S_, H, hd = q.shape
    blk = window // dilation
    span = blk * dilation
    Sp = -(-S_ // span) * span
    nb = Sp // span

    def split(t):
        t = jnp.pad(t, ((0, 0), (0, Sp - S_), (0, 0), (0, 0)))
        return t.reshape(B_, nb, blk, dilation, H, hd)

    def with_prev(t):
        prev = jnp.pad(t, ((0, 0), (1, 0), (0, 0), (0, 0), (0, 0), (0, 0)))[:, :-1]
        return jnp.concatenate([prev, t], axis=2)

    qb = split(q)
    kc = with_prev(split(k))
    vc = with_prev(split(v))

    s = jnp.einsum('bnqrhc,bnkrhc->bnrhqk', qb, kc) * (HEAD_DIM ** -0.5)
    rel = blk + jnp.arange(blk)[:, None] - jnp.arange(2 * blk)[None, :]
    band = (rel >= 0) & (rel <= blk)
    bucket = _t5_bucket(jnp.clip(rel, 0, blk) * dilation)
    bias = jnp.transpose(bias_table[bucket], (2, 0, 1))
    first = (jnp.arange(nb)[:, None, None] == 0) & (jnp.arange(2 * blk)[None, None, :] < blk)
    valid = band[None] & ~first
    logits = jnp.where(valid[None, :, None, None], s + bias[None, None, None], NEG_INF)

    m = jnp.max(logits, axis=-1)
    p = jnp.exp(logits - m[..., None])
    den = jnp.sum(p, axis=-1)
    num = jnp.einsum('bnrhqk,bnkrhc->bnqrhc', p, vc)

    num = num.reshape(B_, Sp, H, hd)[:, :S_]
    den = jnp.transpose(den, (0, 1, 4, 2, 3)).reshape(B_, Sp, H)[:, :S_]
    m = jnp.transpose(m, (0, 1, 4, 2, 3)).reshape(B_, Sp, H)[:, :S_]
    return num, den, m


def _dilated_attention_mixer(h, w_qkv, w_out, rel_bias):
    B_, S_, _ = h.shape
    qkv = (h @ w_qkv).astype(jnp.float32).reshape(B_, S_, 3, N_DIL_GROUPS, ATT_HEADS, HEAD_DIM)
    rb = rel_bias.astype(jnp.float32)
    nums, dens, maxs = [], [], []
    for g, (window, dil) in enumerate(WINDOW_DILATIONS):
        n_, d_, m_ = _dilated_group(qkv[:, :, 0, g], qkv[:, :, 1, g], qkv[:, :, 2, g],
                                    rb[:, g * ATT_HEADS:(g + 1) * ATT_HEADS], window, dil)
        nums.append(n_)
        dens.append(d_)
        maxs.append(m_)
    m_all = jnp.max(jnp.stack(maxs), axis=0)
    scales = [jnp.exp(m_ - m_all) for m_ in maxs]
    num_sum = sum(n_ * c[..., None] for n_, c in zip(nums, scales))
    den_sum = sum(d_ * c for d_, c in zip(dens, scales))
    o = (num_sum / den_sum[..., None]).astype(h.dtype).reshape(B_, S_, ATT_WIDTH)
    return o @ w_out


def setup_inputs(seed: int = 0) -> dict:
    key = jax.random.key(seed)
    ks = jax.random.split(key, 16)
    f32 = jnp.float32
    nrm = lambda k, shape, s: jax.random.normal(k, shape, f32) * s
    qkv_cols = 3 * N_DIL_GROUPS * ATT_HEADS * HEAD_DIM
    return {
        "x": jax.random.normal(ks[0], (BATCH, SEQ, D_MODEL), f32),
        "mix_norm_g": 1.0 + nrm(ks[1], (DEPTH, D_MODEL), 0.05),
        "mlp_norm_g": 1.0 + nrm(ks[2], (DEPTH, D_MODEL), 0.05),
        "final_norm_g": 1.0 + nrm(ks[3], (D_MODEL,), 0.05),
        "a_w_in": nrm(ks[4], (N_A_LAYERS, D_MODEL, 2 * GATE_WIDTH), D_MODEL ** -0.5),
        "a_ln_g": 1.0 + nrm(ks[5], (N_A_LAYERS, GATE_WIDTH), 0.05),
        "a_ln_b": nrm(ks[6], (N_A_LAYERS, GATE_WIDTH), 0.02),
        "a_w_s": nrm(ks[7], (N_A_LAYERS, GATE_GROUPS, CHUNK, CHUNK), CHUNK ** -0.5),
        "a_b_s": 1.0 + nrm(ks[8], (N_A_LAYERS, GATE_GROUPS, CHUNK), 0.1),
        "a_w_out": nrm(ks[9], (N_A_LAYERS, GATE_WIDTH, D_MODEL), GATE_WIDTH ** -0.5),
        "b_w_qkv": nrm(ks[10], (N_B_LAYERS, D_MODEL, qkv_cols), D_MODEL ** -0.5),
        "b_w_out": nrm(ks[11], (N_B_LAYERS, ATT_WIDTH, D_MODEL), ATT_WIDTH ** -0.5),
        "rel_bias": nrm(ks[12], (N_BUCKETS, N_DIL_GROUPS * ATT_HEADS), 0.5),
        "w_up": nrm(ks[13], (DEPTH, D_MODEL, D_FF), D_MODEL ** -0.5),
        "w_down": nrm(ks[14], (DEPTH, D_FF, D_MODEL), D_FF ** -0.5),
    }


def reference(x, mix_norm_g, mlp_norm_g, final_norm_g, a_w_in, a_ln_g, a_ln_b, a_w_s, a_b_s,
              a_w_out, b_w_qkv, b_w_out, rel_bias, w_up, w_down):
    h = x
    for layer in range(DEPTH):
        y = _rms_norm(h, mix_norm_g[layer])
        j = layer // N_MIXERS
        if layer % N_MIXERS == 0:
            y = _chunk_gating_mixer(y, a_w_in[j], a_ln_g[j], a_ln_b[j], a_w_s[j], a_b_s[j], a_w_out[j])
        else:
            y = _dilated_attention_mixer(y, b_w_qkv[j], b_w_out[j], rel_bias)
        h = h + y
        y = _rms_norm(h, mlp_norm_g[layer])
        h = h + jnp.square(jax.nn.relu(y @ w_up[layer])) @ w_down[layer]
    return _rms_norm(h, final_norm_g)
```

```cpp
#include <hip/hip_runtime.h>
#include <cstdio>
#include <cstdint>
namespace pg8 {
#define PG8_LAS __attribute__((address_space(3)))
typedef unsigned short bf16_t;
typedef short bf16x8 __attribute__((ext_vector_type(8)));
typedef float f32x4 __attribute__((ext_vector_type(4)));
typedef unsigned u32x4 __attribute__((ext_vector_type(4)));
constexpr int BM = 256, BK = 64, HALF = 128, HTB = HALF * BK * 2  , STAGE_BYTES = 8 * HTB, NXCD = 8, WGM = 8;

__host__ __device__ __forceinline__ int lds_byte(int r, int c) { const int st = (r >> 4) * 2 + (c >> 5), rr = r & 15, cc = c & 31, ob = rr * 64 + cc * 2; return st * 1024 + (ob ^ (((ob >> 9) & 1) << 5)); }
__host__ __device__ __forceinline__ void stage_rc(int b, int& R, int& C) { const int st = b / 1024, sb = b % 1024, swz = sb ^ (((sb >> 9) & 1) << 5); R = (st >> 1) * 16 + swz / 64; C = (st & 1) * 32 + (swz % 64) / 2; }
__host__ __device__ __forceinline__ int perm32(int rho) { const int n = rho >> 4, i = rho & 15; return 8 * (i >> 2) + 4 * n + (i & 3); }

struct Unit { int pm, pn; };
struct Gemm { const bf16_t* A; const bf16_t* Bt; int M, N, K; };

struct StaticOrder {
    int nM, nN, nwg, G, c;
    __host__ __device__ void init(int M, int N, int G_, int c_) { nM = M / BM; nN = N / BM; nwg = nM * nN; G = G_; c = c_; }
    __host__ __device__ bool next(int i, Unit& u) const {
        const long L = (long)i * G + c; if (L >= nwg) return false;
        int wgid = (int)L; { const int q = nwg / NXCD, r = nwg % NXCD, xcd = wgid % NXCD, off = wgid / NXCD; wgid = (xcd < r ? xcd * (q + 1) : r * (q + 1) + (xcd - r) * q) + off; }
        const int nig = WGM * nN, gid = wgid / nig, fm = gid * WGM, gsz = (nM - fm) < WGM ? (nM - fm) : WGM;
        u.pm = fm + ((wgid % nig) % gsz); u.pn = (wgid % nig) / gsz; return true;
    }
    __device__ __forceinline__ void a_ready(const Unit&) const {}
    __device__ __forceinline__ void done(const Unit&) const {}
};

__device__ __forceinline__ unsigned cvt_pk_bf16(float lo, float hi) { unsigned r; asm volatile("v_cvt_pk_bf16_f32 %0, %1, %2" : "=v"(r) : "v"(lo), "v"(hi)); return r; }
typedef float f32x2 __attribute__((ext_vector_type(2)));
__device__ __forceinline__ f32x2 gelu_pk(f32x2 v) {
    const f32x2 av = __builtin_elementwise_abs(v), d = av * 0.2316418882f + 1.0f;
    f32x2 t; t.x = __builtin_amdgcn_rcpf(d.x); t.y = __builtin_amdgcn_rcpf(d.y);
    f32x2 q = t * 0.5307027145f + (-0.7265760135f); q = q * t + 0.7107068705f; q = q * t + (-0.142248368f); q = q * t + 0.127414796f; q = q * t;
    const f32x2 s = (v * v) * (-0.72134752044f);
    f32x2 e; e.x = __builtin_amdgcn_exp2f(s.x); e.y = __builtin_amdgcn_exp2f(s.y);
    const f32x2 m = v * (q * e), r = v - m;
    f32x2 o; o.x = v.x < 0.f ? m.x : r.x; o.y = v.y < 0.f ? m.y : r.y; return o;
}

__device__ __forceinline__ float row_rs(const float* ssq, int row, int fq) {
    const f32x4 p = *(const f32x4*)(ssq + (size_t)row * 16 + fq * 4);
    float s = (p[0] + p[1]) + (p[2] + p[3]);
    s += __shfl_xor(s, 16); s += __shfl_xor(s, 32);
    return __builtin_amdgcn_rsqf(s * (1.0f / 1024.0f) + 1e-6f);
}
template <int ACT> struct EpiAct {
    static constexpr bool PERM = true, AFTER_DRAIN = false;
    bf16_t* O; int ldc; const float* ssq; float* vst;
    __device__ __forceinline__ void operator()(const f32x4 (&acc)[2][2][4][2], const Unit& u, int wr, int wc, int fr, int fq) const {
        const int row0 = u.pm * BM + wr * 64 + fr, col0 = u.pn * BM + wc * 32 + 8 * fq;
        const bool vhalf = (ACT == 1) && (u.pn >= 4);
#pragma unroll
        for (int ai = 0; ai < 2; ++ai)
#pragma unroll
            for (int m = 0; m < 4; ++m) {
                const int row = row0 + ai * HALF + m * 16;
                const float rs = row_rs(ssq, row, fq);
                bf16_t* rowp = O + (size_t)row * ldc + col0;
                float s1 = 0.f, s2 = 0.f;
#pragma unroll
                for (int bj = 0; bj < 2; ++bj) {
                    f32x4 v0 = acc[ai][bj][m][0] * rs, v1 = acc[ai][bj][m][1] * rs;
                    if (ACT == 1) { f32x2 a = gelu_pk((f32x2){v0[0], v0[1]}), b = gelu_pk((f32x2){v0[2], v0[3]}), c = gelu_pk((f32x2){v1[0], v1[1]}), d = gelu_pk((f32x2){v1[2], v1[3]});
                        v0 = (f32x4){a.x, a.y, b.x, b.y}; v1 = (f32x4){c.x, c.y, d.x, d.y};
                        s1 += ((v0[0] + v0[1]) + (v0[2] + v0[3])) + ((v1[0] + v1[1]) + (v1[2] + v1[3]));
                        s2 += ((v0[0] * v0[0] + v0[1] * v0[1]) + (v0[2] * v0[2] + v0[3] * v0[3])) + ((v1[0] * v1[0] + v1[1] * v1[1]) + (v1[2] * v1[2] + v1[3] * v1[3])); }
                    if (ACT == 2) {
#pragma unroll
                        for (int e = 0; e < 4; ++e) { const float a = fmaxf(v0[e], 0.f), b = fmaxf(v1[e], 0.f); v0[e] = a * a; v1[e] = b * b; } }
                    u32x4 w; w.x = cvt_pk_bf16(v0[0], v0[1]); w.y = cvt_pk_bf16(v0[2], v0[3]); w.z = cvt_pk_bf16(v1[0], v1[1]); w.w = cvt_pk_bf16(v1[2], v1[3]);
                    *(u32x4*)(rowp + bj * HALF) = w; }
                if (ACT == 1) { if (vhalf) { s1 += __shfl_xor(s1, 16); s1 += __shfl_xor(s1, 32); s2 += __shfl_xor(s2, 16); s2 += __shfl_xor(s2, 32);
                        if (fq == 0) *(f32x2*)(vst + ((size_t)row * 16 + (u.pn - 4) * 4 + wc) * 2) = (f32x2){s1, s2}; } }
            }
    }
};
struct EpiRes {
    static constexpr bool PERM = true, AFTER_DRAIN = false;
    const float* res; float* out; bf16_t* xn; float* ssq; int ldc;
    __device__ __forceinline__ void operator()(const f32x4 (&acc)[2][2][4][2], const Unit& u, int wr, int wc, int fr, int fq) const {
        const int row0 = u.pm * BM + wr * 64 + fr, col0 = u.pn * BM + wc * 32 + 8 * fq;
#pragma unroll
        for (int ai = 0; ai < 2; ++ai)
#pragma unroll
            for (int m = 0; m < 4; ++m) {
                const int row = row0 + ai * HALF + m * 16;
                const size_t off = (size_t)row * ldc + col0;
                float q = 0.f;
#pragma unroll
                for (int bj = 0; bj < 2; ++bj) {
                    const f32x4 r0 = *(const f32x4*)(res + off + bj * HALF), r1 = *(const f32x4*)(res + off + bj * HALF + 4);
                    const f32x4 h0 = r0 + acc[ai][bj][m][0], h1 = r1 + acc[ai][bj][m][1];
                    *(f32x4*)(out + off + bj * HALF) = h0; *(f32x4*)(out + off + bj * HALF + 4) = h1;
                    u32x4 w; w.x = cvt_pk_bf16(h0[0], h0[1]); w.y = cvt_pk_bf16(h0[2], h0[3]); w.z = cvt_pk_bf16(h1[0], h1[1]); w.w = cvt_pk_bf16(h1[2], h1[3]);
                    *(u32x4*)(xn + off + bj * HALF) = w;
                    q += ((h0[0] * h0[0] + h0[1] * h0[1]) + (h0[2] * h0[2] + h0[3] * h0[3])) + ((h1[0] * h1[0] + h1[1] * h1[1]) + (h1[2] * h1[2] + h1[3] * h1[3])); }
                q += __shfl_xor(q, 16); q += __shfl_xor(q, 32);
                if (fq == 0) ssq[(size_t)row * 16 + u.pn * 4 + wc] = q;
                asm volatile("" ::: "memory");
            }
    }
};
template <class Epi, class Sched, bool ALIGN_EPI = false, bool SP2 = false>
__device__ __forceinline__ void gemm_phase(PG8_LAS unsigned char* lds, const Gemm g, const Sched& S, const Epi& E) {
    const int tid = threadIdx.x, wid = __builtin_amdgcn_readfirstlane(tid >> 6), lane = tid & 63, wr = wid >> 2, wc = wid & 3, fr = lane & 15, fq = lane >> 4;
    const int K = g.K, nt = K / BK;
    unsigned voffA[2], voffB[2];
#pragma unroll
    for (int i = 0; i < 2; ++i) { int R, C; stage_rc(tid * 16 + i * 8192, R, C); const int Rb = Epi::PERM ? ((R & ~31) + perm32(R & 31)) : R;
        voffA[i] = (unsigned)(R * K + C) * 2u; voffB[i] = (unsigned)(Rb * K + C) * 2u; }
    const size_t kstep = (size_t)(BK * 2);
    const size_t hstep = (size_t)HALF * K * 2;
    const size_t tstep = 2 * hstep;
    const unsigned ldsw = (unsigned)wid * 1024u;
    const int aoff = lds_byte(wr * 64 + fr, fq * 8), boff = lds_byte(wc * 32 + fr, fq * 8);
#define PG8_SA(b, h) (((b) * 2 + (h)) * HTB)
#define PG8_SB(b, h) ((4 + (b) * 2 + (h)) * HTB)
#define PG8_STAGE(bufoff, gbase, voff) do { _Pragma("unroll") for (int _i = 0; _i < 2; ++_i) \
        __builtin_amdgcn_global_load_lds((const unsigned*)((const char*)(gbase) + (voff)[_i]), (PG8_LAS unsigned*)(lds + (bufoff) + ldsw + _i * 8192), 16, 0, 0); } while (0)
#define PG8_LDA(dst, b, h) do { _Pragma("unroll") for (int m = 0; m < 4; ++m) _Pragma("unroll") for (int k = 0; k < 2; ++k) dst[m][k] = *(const PG8_LAS bf16x8*)(lds + PG8_SA(b, h) + aoff + m * 2048 + k * 1024); } while (0)
#define PG8_LDB(dst, b, h) do { _Pragma("unroll") for (int n = 0; n < 2; ++n) _Pragma("unroll") for (int k = 0; k < 2; ++k) dst[n][k] = *(const PG8_LAS bf16x8*)(lds + PG8_SB(b, h) + boff + n * 2048 + k * 1024); } while (0)
#define PG8_MMA(ai, bj, At, Bt) do { __builtin_amdgcn_s_setprio(1); _Pragma("unroll") for (int m = 0; m < 4; ++m) _Pragma("unroll") for (int n = 0; n < 2; ++n) _Pragma("unroll") for (int k = 0; k < 2; ++k) \
        acc[ai][bj][m][n] = __builtin_amdgcn_mfma_f32_16x16x32_bf16(Bt[n][k], At[m][k], acc[ai][bj][m][n], 0, 0, 0); __builtin_amdgcn_s_setprio(0); } while (0)
#define PG8_WAIT_V(n) asm volatile("s_waitcnt vmcnt(" #n ")" ::: "memory")
#define PG8_WAIT_L(n) asm volatile("s_waitcnt lgkmcnt(" #n ")" ::: "memory")
#define PG8_BAR __builtin_amdgcn_s_barrier()
#define PG8_SCHED __builtin_amdgcn_sched_barrier(0)
    Unit cur, nxt; int ui = 0;
    if (!S.next(0, cur)) return;
    f32x4 acc[2][2][4][2];
#pragma unroll
    for (int a = 0; a < 2; ++a)
#pragma unroll
        for (int b = 0; b < 2; ++b)
#pragma unroll
            for (int m = 0; m < 4; ++m)
#pragma unroll
                for (int n = 0; n < 2; ++n) acc[a][b][m][n] = (f32x4){0.f, 0.f, 0.f, 0.f};
    bf16x8 At[4][2], B0[2][2], B1[2][2];
    const char* cA = (const char*)g.A + (size_t)cur.pm * tstep; const char* cB = (const char*)g.Bt + (size_t)cur.pn * tstep;
    S.a_ready(cur);
    if constexpr (SP2) {
        PG8_STAGE(PG8_SB(0, 0), cB, voffB); PG8_STAGE(PG8_SB(0, 1), cB + hstep, voffB); PG8_STAGE(PG8_SA(0, 0), cA, voffA); PG8_STAGE(PG8_SA(0, 1), cA + hstep, voffA);
        if (wr == 1) PG8_BAR;
        PG8_WAIT_V(2); PG8_BAR;
        PG8_STAGE(PG8_SB(1, 0), cB + kstep, voffB); PG8_STAGE(PG8_SA(1, 0), cA + kstep, voffA); PG8_STAGE(PG8_SB(1, 1), cB + hstep + kstep, voffB);
        PG8_WAIT_V(6); PG8_BAR;
    } else {
        PG8_STAGE(PG8_SB(0, 0), cB, voffB); PG8_STAGE(PG8_SA(0, 0), cA, voffA); PG8_STAGE(PG8_SB(0, 1), cB + hstep, voffB); PG8_STAGE(PG8_SA(0, 1), cA + hstep, voffA);
        if (wr == 1) PG8_BAR;
        PG8_WAIT_V(4); PG8_BAR;
        PG8_STAGE(PG8_SB(1, 0), cB + kstep, voffB); PG8_STAGE(PG8_SA(1, 0), cA + kstep, voffA); PG8_STAGE(PG8_SB(1, 1), cB + hstep + kstep, voffB);
        PG8_WAIT_V(6); PG8_BAR;
    }
    for (;;) {
        const bool has_next = S.next(ui + 1, nxt);
        const char* nA = has_next ? (const char*)g.A + (size_t)nxt.pm * tstep : cA; const char* nB = has_next ? (const char*)g.Bt + (size_t)nxt.pn * tstep : cB;
        for (int t = 0; t < nt; t += 2) {
            const bool last = (t == nt - 2);
            const char* a1 = cA + (size_t)(t + 1) * kstep;
            const char* a2 = last ? nA : cA + (size_t)(t + 2) * kstep; const char* b2 = last ? nB : cB + (size_t)(t + 2) * kstep;
            const char* a3 = a2 + kstep; const char* b3 = b2 + kstep;
            if (last && has_next) S.a_ready(nxt);
            if constexpr (SP2) {
            PG8_LDB(B0, 0, 0); PG8_LDB(B1, 0, 1); PG8_SCHED; PG8_LDA(At, 0, 0); PG8_STAGE(PG8_SA(1, 1), a1 + hstep, voffA);
            PG8_WAIT_V(8); PG8_WAIT_L(0); PG8_BAR; PG8_MMA(0, 0, At, B0); PG8_MMA(0, 1, At, B1); PG8_BAR; PG8_SCHED;
            PG8_LDA(At, 0, 1); PG8_STAGE(PG8_SB(0, 0), b2, voffB); PG8_STAGE(PG8_SB(0, 1), b2 + hstep, voffB); PG8_STAGE(PG8_SA(0, 0), a2, voffA);
            PG8_WAIT_V(8); PG8_WAIT_L(0); PG8_BAR; PG8_MMA(1, 0, At, B0); PG8_MMA(1, 1, At, B1); PG8_BAR; PG8_SCHED;
            PG8_LDB(B0, 1, 0); PG8_LDB(B1, 1, 1); PG8_SCHED; PG8_LDA(At, 1, 0); PG8_STAGE(PG8_SA(0, 1), a2 + hstep, voffA);
            PG8_WAIT_V(8); PG8_WAIT_L(0); PG8_BAR; PG8_MMA(0, 0, At, B0); PG8_MMA(0, 1, At, B1); PG8_BAR; PG8_SCHED;
            PG8_LDA(At, 1, 1); PG8_STAGE(PG8_SB(1, 0), b3, voffB); PG8_STAGE(PG8_SB(1, 1), b3 + hstep, voffB); PG8_STAGE(PG8_SA(1, 0), a3, voffA);
            PG8_WAIT_V(8); PG8_WAIT_L(0); PG8_BAR; PG8_MMA(1, 0, At, B0); PG8_MMA(1, 1, At, B1); PG8_BAR; PG8_SCHED;
            } else {
            PG8_LDB(B0, 0, 0); PG8_SCHED; PG8_LDA(At, 0, 0); PG8_STAGE(PG8_SA(1, 1), a1 + hstep, voffA);
            PG8_WAIT_L(8); PG8_BAR; PG8_WAIT_L(0); PG8_MMA(0, 0, At, B0); PG8_BAR; PG8_SCHED;
            PG8_LDB(B1, 0, 1); PG8_STAGE(PG8_SB(0, 0), b2, voffB);
            PG8_BAR; PG8_WAIT_L(0); PG8_MMA(0, 1, At, B1); PG8_BAR;
            PG8_LDA(At, 0, 1); PG8_STAGE(PG8_SA(0, 0), a2, voffA);
            PG8_BAR; PG8_WAIT_L(0); PG8_MMA(1, 0, At, B0); PG8_BAR; PG8_SCHED;
            PG8_STAGE(PG8_SB(0, 1), b2 + hstep, voffB);
            PG8_WAIT_V(6); PG8_BAR; PG8_MMA(1, 1, At, B1); PG8_BAR;
            PG8_LDB(B0, 1, 0); PG8_SCHED; PG8_LDA(At, 1, 0); PG8_STAGE(PG8_SA(0, 1), a2 + hstep, voffA);
            PG8_WAIT_L(8); PG8_BAR; PG8_WAIT_L(0); PG8_MMA(0, 0, At, B0); PG8_BAR; PG8_SCHED;
            PG8_LDB(B1, 1, 1); PG8_STAGE(PG8_SB(1, 0), b3, voffB);
            PG8_BAR; PG8_WAIT_L(0); PG8_MMA(0, 1, At, B1); PG8_BAR;
            PG8_LDA(At, 1, 1); PG8_STAGE(PG8_SA(1, 0), a3, voffA);
            PG8_BAR; PG8_WAIT_L(0); PG8_MMA(1, 0, At, B0); PG8_BAR; PG8_SCHED;
            PG8_STAGE(PG8_SB(1, 1), b3 + hstep, voffB);
            PG8_WAIT_V(6); PG8_BAR; PG8_MMA(1, 1, At, B1); PG8_BAR;
            }
        }
        if constexpr (ALIGN_EPI) { if (wr == 0) PG8_BAR; }
        if constexpr (!Epi::AFTER_DRAIN) { E(acc, cur, wr, wc, fr, fq); S.done(cur); }
        if (!has_next) break;
#pragma unroll
        for (int a = 0; a < 2; ++a)
#pragma unroll
            for (int b = 0; b < 2; ++b)
#pragma unroll
                for (int m = 0; m < 4; ++m)
#pragma unroll
                    for (int n = 0; n < 2; ++n) acc[a][b][m][n] = (f32x4){0.f, 0.f, 0.f, 0.f};
        cur = nxt; cA = nA; cB = nB; ++ui;
        if constexpr (ALIGN_EPI) { if (wr == 1) PG8_BAR; }
    }
    PG8_WAIT_V(0);
    if constexpr (!ALIGN_EPI) { if (wr == 0) PG8_BAR; }
    PG8_BAR;
    if constexpr (Epi::AFTER_DRAIN) { E.fused(acc, cur, wr, wc, fr, fq, lds, wid, lane); S.done(cur); }
#undef PG8_SA
#undef PG8_SB
#undef PG8_STAGE
#undef PG8_LDA
#undef PG8_LDB
#undef PG8_MMA
#undef PG8_WAIT_V
#undef PG8_WAIT_L
#undef PG8_BAR
#undef PG8_SCHED
}
}
constexpr int NWAVES = 8;
constexpr int BATCH = 4, SEQ = 8192, D = 1024, FF = 4096, NQKV = 4608, AW = 512, NH = 8, HD = 64;
constexpr int M = BATCH * SEQ;
constexpr int CHUNK = 128, NCHUNK = M / CHUNK, NGRP = 8;
constexpr float EPS = 1e-6f;
constexpr float LOG2E = 1.4426950408889634f;
constexpr int LUT_N = 176;
#ifndef MK_SPLIT
#define MK_SPLIT 0
#endif
constexpr int N_PHASES = 13;

constexpr size_t MiB = 1u << 20;
constexpr size_t WS_CTL = 0, CTL_ZERO_BYTES = 1 * MiB;
constexpr size_t WS_WIN = 2 * MiB, WS_WOA = 6 * MiB, WS_WQKV = 8 * MiB, WS_WOB = 17 * MiB, WS_WUP = 18 * MiB, WS_WDN = 34 * MiB;
constexpr size_t WS_WST = 50 * MiB;
constexpr size_t WS_LUT = 50 * MiB + 512 * 1024;
constexpr size_t WS_SSQ = 51 * MiB;
constexpr size_t WS_VST = 53 * MiB;
constexpr size_t WS_LSE = 57 * MiB;
constexpr size_t WS_XN = 64 * MiB;
constexpr size_t WS_BIG = 128 * MiB;
constexpr size_t WS_UG = 256 * MiB;
constexpr size_t WS_OM = 416 * MiB;
constexpr size_t WS_END = 448 * MiB;
constexpr int CW_TMO = 0, CW_CODE = 1, CW_BAR = 4096;

constexpr int RING_OFF = 0, RING_BYTES = 131072;
constexpr int LDSCTL_OFF = RING_BYTES, MISC_OFF = LDSCTL_OFF + 320;
constexpr int LDS_BYTES = 147456;

#define GAS __attribute__((address_space(1)))
#define LAS __attribute__((address_space(3)))
typedef unsigned short bf16;
typedef unsigned v4u __attribute__((ext_vector_type(4)));
typedef float f32x4 __attribute__((ext_vector_type(4)));
typedef short bf16x8 __attribute__((ext_vector_type(8)));
typedef GAS unsigned gu32;
typedef GAS unsigned long long gu64;
#define RLX_AGENT __ATOMIC_RELAXED, __HIP_MEMORY_SCOPE_AGENT
#define LDS_WAIT() asm volatile("s_waitcnt lgkmcnt(0)" ::: "memory")
#define VM_WAIT() asm volatile("s_waitcnt vmcnt(0)" ::: "memory")
__device__ __forceinline__ unsigned long long rt() { return __builtin_amdgcn_s_memrealtime(); }
__device__ __forceinline__ unsigned f2bf(float f) { unsigned u = __builtin_bit_cast(unsigned, f); return (u + 0x7fffu + ((u >> 16) & 1u)) >> 16; }
__device__ __forceinline__ unsigned pk2(float lo, float hi) { return f2bf(lo) | (f2bf(hi) << 16); }

#define XB_TMO      128
#define XB_XCNT(j)  (256  + 64 * (j))
#define XB_XSUB(j)  (1280 + 64 * (j))
#define XB_XGEN(j)  (2304 + 64 * (j))
#define XB_TOP      3328
#define XB_TOPGEN   3392
#define XCD_BAR_WORDS 3456
#define XB_SPIN_CAP (1u << 18)

__device__ __forceinline__ unsigned xb_ld(unsigned* p)              { return __hip_atomic_load(p, __ATOMIC_RELAXED, __HIP_MEMORY_SCOPE_AGENT); }
__device__ __forceinline__ unsigned xb_add(unsigned* p, unsigned v) { return __hip_atomic_fetch_add(p, v, __ATOMIC_RELAXED, __HIP_MEMORY_SCOPE_AGENT); }
__device__ __forceinline__ unsigned xb_xcc_id() { return (unsigned)__builtin_amdgcn_s_getreg((3 << 11) | 20) & 0xFu; }
#define XB_SPIN(cond, bar) do { unsigned _sp = 0; while (cond) { __builtin_amdgcn_s_sleep(1); \
    if ((++_sp & 255u) == 0u) { if (xb_ld(&(bar)[XB_TMO])) break; if (_sp > XB_SPIN_CAP) { atomicAdd(&(bar)[XB_TMO], 1u); break; } } } } while (0)

struct XcdBarrier {
    unsigned* bar; unsigned x;
    volatile LAS unsigned* st;
};

__device__ __forceinline__ XcdBarrier xcd_barrier_post(unsigned* bar, volatile LAS unsigned* st) {
    XcdBarrier b; b.bar = bar; b.x = xb_xcc_id(); b.st = st;
    if (threadIdx.x == 0) (void)xb_add(&bar[XB_XCNT(b.x)], 1u);
    return b;
}
__device__ __forceinline__ void xcd_barrier_complete(unsigned* bar, unsigned x, unsigned& nloc, unsigned& nx) {
    const unsigned G = gridDim.x * gridDim.y * gridDim.z;
    unsigned sum, cnt, mine, sp = 0u;
    for (;;) {
        sum = 0u; cnt = 0u; mine = 0u;
#pragma unroll
        for (unsigned j = 0; j < 16; ++j) { const unsigned c = xb_ld(&bar[XB_XCNT(j)]); sum += c; cnt += (c > 0u) ? 1u : 0u; mine = (j == x) ? c : mine; }
        if (sum == G) break;
        __builtin_amdgcn_s_sleep(1);
        if ((++sp & 255u) == 0u) { if (xb_ld(&bar[XB_TMO])) break; if (sp > XB_SPIN_CAP) { atomicAdd(&bar[XB_TMO], 1u); break; } }
    }
    nloc = mine > 0u ? mine : 1u; nx = cnt > 0u ? cnt : 1u;
}

__device__ __forceinline__ void xcd_barrier(const XcdBarrier& b) {
    asm volatile("s_waitcnt vmcnt(0)" ::: "memory");
    __syncthreads();
    if (threadIdx.x == 0) {
        unsigned* bar = b.bar;
        __builtin_amdgcn_s_waitcnt(0);
        unsigned nloc = b.st[0], nx = b.st[1];
        if (nloc == 0u) { xcd_barrier_complete(bar, b.x, nloc, nx); b.st[0] = nloc; b.st[1] = nx; }
        const unsigned old = xb_add(&bar[XB_XSUB(b.x)], 1u);
        const unsigned gen = old / nloc;
        if (old + 1u == (gen + 1u) * nloc) {
            __builtin_amdgcn_fence(__ATOMIC_RELEASE, "agent");
            asm volatile("s_waitcnt vmcnt(0)" ::: "memory");
            const unsigned og = xb_add(&bar[XB_TOP], 1u);
            const unsigned tg = og / nx;
            if (og + 1u == (tg + 1u) * nx) xb_add(&bar[XB_TOPGEN], 1u);
            else XB_SPIN(xb_ld(&bar[XB_TOPGEN]) == tg, bar);
            __builtin_amdgcn_fence(__ATOMIC_ACQUIRE, "agent");
            xb_add(&bar[XB_XGEN(b.x)], 1u);
            asm volatile("s_waitcnt vmcnt(0)" ::: "memory");
        } else {
            XB_SPIN(xb_ld(&bar[XB_XGEN(b.x)]) == gen, bar);
            __builtin_amdgcn_fence(__ATOMIC_ACQUIRE, "agent");
            asm volatile("s_waitcnt vmcnt(0)" ::: "memory");
        }
    }
    __syncthreads();
}
typedef float f32x2v __attribute__((ext_vector_type(2)));
typedef pg8::u32x4 u32x4;
typedef unsigned u32x2v __attribute__((ext_vector_type(2)));
typedef unsigned short bf16x8us __attribute__((ext_vector_type(8)));
__device__ __forceinline__ unsigned cvtpk(float lo, float hi) { unsigned r; asm volatile("v_cvt_pk_bf16_f32 %0, %1, %2" : "=v"(r) : "v"(lo), "v"(hi)); return r; }
__device__ __forceinline__ float bf2f(unsigned short b) { return __builtin_bit_cast(float, (unsigned)b << 16); }
__device__ __forceinline__ float bflo(unsigned w) { return __builtin_bit_cast(float, w << 16); }
__device__ __forceinline__ float bfhi(unsigned w) { return __builtin_bit_cast(float, w & 0xffff0000u); }
__device__ __forceinline__ float wave_sum(float v) {
#pragma unroll
    for (int o = 1; o < 64; o <<= 1) v += __shfl_xor(v, o);
    return v;
}
struct Ctx { LAS unsigned char* lds; int tid, lane, wave, vcu, G; };

__device__ __forceinline__ void p0_transpose_item(const float* W, const float* gsc, int K, int N, bf16* WT, LAS float* scr, int item, int lane) {
    const int nblk = N / 32, kb = item / nblk, nb = item % nblk, k0 = 64 * kb, n0 = 32 * nb;
#pragma unroll 8
    for (int i = 0; i < 32; ++i) { const int kk = 2 * i + (lane >> 5); float w = W[(size_t)(k0 + kk) * N + n0 + (lane & 31)]; if (gsc) w *= gsc[k0 + kk]; scr[kk * 33 + (lane & 31)] = w; }
    LDS_WAIT(); asm volatile("" ::: "memory");
    const int c = lane & 7;
#pragma unroll
    for (int j = 0; j < 4; ++j) { const int n = (lane >> 3) + 8 * j; const LAS float* s = scr + (8 * c) * 33 + n;
        v4u o; o.x = cvtpk(s[0 * 33], s[1 * 33]); o.y = cvtpk(s[2 * 33], s[3 * 33]); o.z = cvtpk(s[4 * 33], s[5 * 33]); o.w = cvtpk(s[6 * 33], s[7 * 33]);
        *(v4u*)(WT + (size_t)(n0 + n) * K + k0 + 8 * c) = o; }
    LDS_WAIT(); asm volatile("" ::: "memory");
}
struct P0Args { const float *x, *mixg, *mlpg, *w_in, *w_s, *w_outa, *w_qkv, *w_outb, *relb, *w_up, *w_dn; unsigned char* ws; };
__device__ __forceinline__ void p0_prologue(const Ctx& C, const P0Args& A) {
    LAS float* scr = (LAS float*)(C.lds + RING_OFF + C.wave * 16384);
    const int gw = C.vcu * NWAVES + C.wave, NGW = C.G * NWAVES;
    constexpr int I0 = (D / 64) * (2 * D / 32), I1 = (D / 64) * (D / 32), I2 = (D / 64) * (NQKV / 32), I3 = (AW / 64) * (D / 32), I4 = (D / 64) * (FF / 32), I6 = (FF / 64) * (D / 32);
    constexpr int NITEMS = I0 + I1 + I2 + I3 + 2 * I4 + 2 * I6;
    unsigned char* ws = A.ws;
    for (int it = gw; it < NITEMS; it += NGW) {
        int r = it;
        if (r < I0) { p0_transpose_item(A.w_in, A.mixg, D, 2 * D, (bf16*)(ws + WS_WIN), scr, r, C.lane); continue; } r -= I0;
        if (r < I1) { p0_transpose_item(A.w_outa, nullptr, D, D, (bf16*)(ws + WS_WOA), scr, r, C.lane); continue; } r -= I1;
        if (r < I2) { p0_transpose_item(A.w_qkv, A.mixg + D, D, NQKV, (bf16*)(ws + WS_WQKV), scr, r, C.lane); continue; } r -= I2;
        if (r < I3) { p0_transpose_item(A.w_outb, nullptr, AW, D, (bf16*)(ws + WS_WOB), scr, r, C.lane); continue; } r -= I3;
        if (r < I4) { p0_transpose_item(A.w_up, A.mlpg, D, FF, (bf16*)(ws + WS_WUP), scr, r, C.lane); continue; } r -= I4;
        if (r < I4) { p0_transpose_item(A.w_up + (size_t)D * FF, A.mlpg + D, D, FF, (bf16*)(ws + WS_WUP + 8 * MiB), scr, r, C.lane); continue; } r -= I4;
        if (r < I6) { p0_transpose_item(A.w_dn, nullptr, FF, D, (bf16*)(ws + WS_WDN), scr, r, C.lane); continue; } r -= I6;
        p0_transpose_item(A.w_dn + (size_t)FF * D, nullptr, FF, D, (bf16*)(ws + WS_WDN + 8 * MiB), scr, r, C.lane);
    }
    const int gt = (C.vcu * NWAVES + C.wave) * 64 + C.lane, NGT = NGW * 64;
    { bf16* wst = (bf16*)(ws + WS_WST);
      for (int i = gt; i < NGRP * CHUNK * CHUNK; i += NGT) { const int t = (i >> 7) & 127, s = i & 127; const float w = (s <= t) ? A.w_s[i] : 0.f; wst[i] = (bf16)(cvtpk(w, 0.f) & 0xffffu); } }
    { float* lut = (float*)(ws + WS_LUT);
      for (int i = gt; i < 24 * LUT_N; i += NGT) { const int gh = i / LUT_N, idx = i % LUT_N, g = gh >> 3, rel = idx - 16; float v = 0.f;
          if (rel >= 0 && rel <= 128) { const int dil = (g == 0) ? 1 : (g == 1) ? 4 : 16; const int dist = rel * dil; int bucket;
              if (dist < 16) bucket = dist; else { const float nf = (float)dist; int lg = 16 + (int)(logf(nf / 16.0f) / 4.852030263919617f * 16.0f); bucket = lg < 31 ? lg : 31; }
              v = A.relb[bucket * 24 + gh] * LOG2E; }
          lut[i] = v; } }
    { bf16* xn = (bf16*)(ws + WS_XN); float* ssq = (float*)(ws + WS_SSQ);
      for (int m = gw; m < M; m += NGW) {
          const f32x4* xr = (const f32x4*)(A.x + (size_t)m * D) + C.lane; f32x4 v[4]; float s = 0.f;
#pragma unroll
          for (int j = 0; j < 4; ++j) { v[j] = xr[64 * j]; s += (v[j][0] * v[j][0] + v[j][1] * v[j][1]) + (v[j][2] * v[j][2] + v[j][3] * v[j][3]); }
          s = wave_sum(s);
          u32x2v* o8 = (u32x2v*)(xn + (size_t)m * D) + C.lane;
#pragma unroll
          for (int j = 0; j < 4; ++j) o8[64 * j] = (u32x2v){cvtpk(v[j][0], v[j][1]), cvtpk(v[j][2], v[j][3])};
          if (C.lane < 16) ssq[(size_t)m * 16 + C.lane] = (C.lane == 0) ? s : 0.f; } }
}

constexpr int G_VT = 0, G_WS = 32768, G_STAT = G_WS + 128 * 136 * 2, G_BS = G_STAT + 1024;
__device__ __forceinline__ int vt_off(int c, int s) { return c * 128 + ((((s >> 3) ^ (c & 7) ^ ((c >> 3) & 15)) & 15) << 3) + (s & 7); }
__device__ __forceinline__ void p2_gating(const Ctx& C, const bf16* UV, bf16* UG, const float* vst, const bf16* wst, const float* lng, const float* lnb, const float* bs) {
    LAS bf16* VT = (LAS bf16*)(C.lds + G_VT); LAS bf16* WS = (LAS bf16*)(C.lds + G_WS); LAS f32x2v* STAT = (LAS f32x2v*)(C.lds + G_STAT); LAS float* BS = (LAS float*)(C.lds + G_BS);
    const int tid = C.tid, lane = C.lane, w = C.wave, r16 = lane & 15, qq = lane >> 4;
    for (int chunk = C.vcu; chunk < NCHUNK; chunk += C.G) {
        const size_t tok0 = (size_t)chunk * CHUNK;
        __syncthreads();
        { const int row = tid >> 2, part = tid & 3; const f32x4* p = (const f32x4*)(vst + ((tok0 + row) * 16 + part * 4) * 2);
          const f32x4 a = p[0], b = p[1]; float s1 = (a[0] + a[2]) + (b[0] + b[2]), s2 = (a[1] + a[3]) + (b[1] + b[3]);
          s1 += __shfl_xor(s1, 1); s1 += __shfl_xor(s1, 2); s2 += __shfl_xor(s2, 1); s2 += __shfl_xor(s2, 2);
          const float mean = s1 * (1.0f / 1024.0f), var = s2 * (1.0f / 1024.0f) - mean * mean;
          if (part == 0) STAT[row] = (f32x2v){mean, __builtin_amdgcn_rsqf(fmaxf(var, 0.f) + EPS)}; }
        for (int g = 0; g < NGRP; ++g) {
            __syncthreads();
            { const int cc = tid & 15;
              const f32x4 g0 = *(const f32x4*)(lng + g * 128 + cc * 8), g1 = *(const f32x4*)(lng + g * 128 + cc * 8 + 4), b0 = *(const f32x4*)(lnb + g * 128 + cc * 8), b1 = *(const f32x4*)(lnb + g * 128 + cc * 8 + 4);
#pragma unroll
              for (int i = 0; i < 4; ++i) { const int s = (tid >> 4) + 32 * i;
                  const v4u raw = *(const v4u*)(UV + (tok0 + s) * (2 * D) + D + g * 128 + cc * 8);
                  const f32x2v st = STAT[s];
                  float v[8] = {bflo(raw.x), bfhi(raw.x), bflo(raw.y), bfhi(raw.y), bflo(raw.z), bfhi(raw.z), bflo(raw.w), bfhi(raw.w)};
#pragma unroll
                  for (int j = 0; j < 8; ++j) { const float gg = j < 4 ? g0[j & 3] : g1[j & 3], bb = j < 4 ? b0[j & 3] : b1[j & 3];
                      const float y = (v[j] - st.x) * st.y * gg + bb; VT[vt_off(cc * 8 + j, s)] = (bf16)(cvtpk(y, 0.f) & 0xffffu); } }
#pragma unroll
              for (int i = 0; i < 4; ++i) { const int id = tid + 512 * i, t = id >> 4, sc = id & 15;
                  *(LAS v4u*)(WS + t * 136 + sc * 8) = *(const v4u*)(wst + (size_t)g * 16384 + t * 128 + sc * 8); }
              if (tid < 128) BS[tid] = bs[g * 128 + tid]; }
            __syncthreads();
            bf16x8 xf[4];
#pragma unroll
            for (int ks = 0; ks < 4; ++ks) xf[ks] = *(const LAS bf16x8*)(VT + vt_off(16 * w + r16, 32 * ks + 8 * qq));
#pragma unroll
            for (int tt = 0; tt < 8; ++tt) {
                f32x4 acc = (f32x4){0.f, 0.f, 0.f, 0.f};
#pragma unroll
                for (int ks = 0; ks <= tt / 2; ++ks) { const bf16x8 yf = *(const LAS bf16x8*)(WS + (16 * tt + r16) * 136 + 32 * ks + 8 * qq);
                    acc = __builtin_amdgcn_mfma_f32_16x16x32_bf16(xf[ks], yf, acc, 0, 0, 0); }
                const int t = 16 * tt + r16; const float bsv = BS[t];
                const size_t tok = tok0 + t; const int ch = g * 128 + 16 * w + 4 * qq;
                const u32x2v uu = *(const u32x2v*)(UV + tok * (2 * D) + ch);
                const float o0 = bflo(uu.x) * (acc[0] + bsv), o1 = bfhi(uu.x) * (acc[1] + bsv), o2 = bflo(uu.y) * (acc[2] + bsv), o3 = bfhi(uu.y) * (acc[3] + bsv);
                *(u32x2v*)(UG + tok * D + ch) = (u32x2v){cvtpk(o0, o1), cvtpk(o2, o3)};
            }
        }
    }
    __syncthreads();
}
constexpr int A_KS = 0, A_VT = 256 * 72 * 2, A_LUT = A_VT + 64 * 256 * 2;
constexpr int ATT_UNITS = 3 * BATCH * NH * 64;
__device__ __forceinline__ int vta_off(int d, int kv) { return d * 256 + ((((kv >> 3) ^ (d >> 3) ^ (d & 7)) & 31) << 3) + (kv & 7); }
__device__ __forceinline__ void p7_attention(const Ctx& C, bf16* QKV, float* lse, const float* lutg) {
    LAS bf16* KS = (LAS bf16*)(C.lds + A_KS); LAS bf16* VTA = (LAS bf16*)(C.lds + A_VT); LAS float* LUT = (LAS float*)(C.lds + A_LUT);
    const int tid = C.tid, lane = C.lane, w = C.wave, r16 = lane & 15, qq = lane >> 4;
    const int per = (ATT_UNITS + C.G - 1) / C.G;
    const int u_lo = C.vcu * per, u_hi = (u_lo + per < ATT_UNITS) ? u_lo + per : ATT_UNITS;
    for (int U = u_lo; U < u_hi; ++U) {
        const int g = U >> 11, rem = U & 2047, b = rem >> 9, h = (rem >> 6) & 7, rn = rem & 63;
        const int dil = (g == 0) ? 1 : (g == 1) ? 4 : 16, nb = 64 / dil, r = rn / nb, n = rn % nb;
        const size_t rowbase = (size_t)b * SEQ;
        const int qcol = g * 512 + h * 64, kcol = (3 + g) * 512 + h * 64, vcol = (6 + g) * 512 + h * 64;
#pragma unroll
        for (int i = 0; i < 4; ++i) { const int id = tid + 512 * i, kk = id >> 3, ch = id & 7;
            const int pos = (n * 128 + kk - 128) * dil + r; const bool ok = (n > 0) || (kk >= 128);
            v4u kv = (v4u){0u, 0u, 0u, 0u}, vv = (v4u){0u, 0u, 0u, 0u};
            if (ok) { const bf16* rowp = QKV + (rowbase + pos) * NQKV; kv = *(const v4u*)(rowp + kcol + ch * 8); vv = *(const v4u*)(rowp + vcol + ch * 8); }
            *(LAS v4u*)(KS + kk * 72 + ch * 8) = kv;
            const unsigned vw[4] = {vv.x, vv.y, vv.z, vv.w};
#pragma unroll
            for (int j = 0; j < 8; ++j) VTA[vta_off(ch * 8 + j, kk)] = (bf16)((j & 1) ? (vw[j >> 1] >> 16) : (vw[j >> 1] & 0xffffu)); }
        if (tid < LUT_N) LUT[tid] = lutg[(g * 8 + h) * LUT_N + tid];
        const size_t qrow = rowbase + (size_t)((n * 128 + 16 * w + r16) * dil + r);
        bf16x8 qf[2];
#pragma unroll
        for (int ks = 0; ks < 2; ++ks) qf[ks] = *(const bf16x8*)(QKV + qrow * NQKV + qcol + 32 * ks + 8 * qq);
        __syncthreads();
        f32x4 s[9];
#pragma unroll
        for (int kt = 0; kt < 9; ++kt) { const LAS bf16* kp = KS + (16 * w + 16 * kt + r16) * 72 + 8 * qq;
            const bf16x8 k0 = *(const LAS bf16x8*)(kp), k1 = *(const LAS bf16x8*)(kp + 32);
            f32x4 a = (f32x4){0.f, 0.f, 0.f, 0.f};
            a = __builtin_amdgcn_mfma_f32_16x16x32_bf16(k0, qf[0], a, 0, 0, 0);
            a = __builtin_amdgcn_mfma_f32_16x16x32_bf16(k1, qf[1], a, 0, 0, 0); s[kt] = a; }
        const float SC = 0.125f * LOG2E, NEG = -1e30f;
        float mx = NEG;
#pragma unroll
        for (int kt = 0; kt < 9; ++kt)
#pragma unroll
            for (int j = 0; j < 4; ++j) { const int rel = 128 + r16 - 16 * kt - 4 * qq - j; const int kk = 16 * w + 16 * kt + 4 * qq + j;
                const bool ok = (rel >= 0) && (rel <= 128) && ((n > 0) || (kk >= 128));
                const float t = ok ? (s[kt][j] * SC + LUT[rel + 16]) : NEG; s[kt][j] = t; mx = fmaxf(mx, t); }
        mx = fmaxf(mx, __shfl_xor(mx, 16)); mx = fmaxf(mx, __shfl_xor(mx, 32));
        float lsum = 0.f;
#pragma unroll
        for (int kt = 0; kt < 9; ++kt)
#pragma unroll
            for (int j = 0; j < 4; ++j) { const float p = __builtin_amdgcn_exp2f(s[kt][j] - mx); s[kt][j] = p; lsum += p; }
        lsum += __shfl_xor(lsum, 16); lsum += __shfl_xor(lsum, 32);
        f32x4 o[4];
#pragma unroll
        for (int dt = 0; dt < 4; ++dt) o[dt] = (f32x4){0.f, 0.f, 0.f, 0.f};
#pragma unroll
        for (int ks = 0; ks < 5; ++ks) {
            u32x4 pw; pw.x = cvtpk(s[2 * ks][0], s[2 * ks][1]); pw.y = cvtpk(s[2 * ks][2], s[2 * ks][3]);
            if (ks < 4) { pw.z = cvtpk(s[2 * ks + 1][0], s[2 * ks + 1][1]); pw.w = cvtpk(s[2 * ks + 1][2], s[2 * ks + 1][3]); } else { pw.z = 0u; pw.w = 0u; }
            const bf16x8 pf = __builtin_bit_cast(bf16x8, pw);
            const int kv0 = 16 * w + 32 * ks + 4 * qq;
#pragma unroll
            for (int dt = 0; dt < 4; ++dt) { const int d = 16 * dt + r16;
                const u32x2v lo = *(const LAS u32x2v*)(VTA + vta_off(d, kv0));
                u32x2v hi = (u32x2v){0u, 0u}; if (ks < 4) hi = *(const LAS u32x2v*)(VTA + vta_off(d, kv0 + 16));
                const u32x4 vw = (u32x4){lo.x, lo.y, hi.x, hi.y};
                o[dt] = __builtin_amdgcn_mfma_f32_16x16x32_bf16(__builtin_bit_cast(bf16x8, vw), pf, o[dt], 0, 0, 0); } }
        const float inv = 1.0f / lsum;
#pragma unroll
        for (int dt = 0; dt < 4; ++dt)
            *(u32x2v*)(QKV + qrow * NQKV + qcol + 16 * dt + 4 * qq) = (u32x2v){cvtpk(o[dt][0] * inv, o[dt][1] * inv), cvtpk(o[dt][2] * inv, o[dt][3] * inv)};
        if (qq == 0) lse[((size_t)g * M + qrow) * NH + h] = mx + log2f(lsum);
        __syncthreads();
    }
}
__device__ __forceinline__ void p8_merge(const Ctx& C, const bf16* QKV, const float* lse, bf16* OM) {
    const int gt = (C.vcu * NWAVES + C.wave) * 64 + C.lane, NGT = C.G * NWAVES * 64;
    for (int idx = gt; idx < M * 64; idx += NGT) { const int tok = idx >> 6, cch = idx & 63, h = cch >> 3;
        const float l0 = lse[((size_t)0 * M + tok) * NH + h], l1 = lse[((size_t)1 * M + tok) * NH + h], l2 = lse[((size_t)2 * M + tok) * NH + h];
        const float mx = fmaxf(l0, fmaxf(l1, l2)); float w0 = __builtin_amdgcn_exp2f(l0 - mx), w1 = __builtin_amdgcn_exp2f(l1 - mx), w2 = __builtin_amdgcn_exp2f(l2 - mx);
        const float inv = 1.0f / (w0 + w1 + w2); w0 *= inv; w1 *= inv; w2 *= inv;
        const bf16* rowp = QKV + (size_t)tok * NQKV + cch * 8;
        const v4u a = *(const v4u*)(rowp), bb = *(const v4u*)(rowp + 512), c = *(const v4u*)(rowp + 1024);
        v4u o;
        o.x = cvtpk(w0 * bflo(a.x) + w1 * bflo(bb.x) + w2 * bflo(c.x), w0 * bfhi(a.x) + w1 * bfhi(bb.x) + w2 * bfhi(c.x));
        o.y = cvtpk(w0 * bflo(a.y) + w1 * bflo(bb.y) + w2 * bflo(c.y), w0 * bfhi(a.y) + w1 * bfhi(bb.y) + w2 * bfhi(c.y));
        o.z = cvtpk(w0 * bflo(a.z) + w1 * bflo(bb.z) + w2 * bflo(c.z), w0 * bfhi(a.z) + w1 * bfhi(bb.z) + w2 * bfhi(c.z));
        o.w = cvtpk(w0 * bflo(a.w) + w1 * bflo(bb.w) + w2 * bflo(c.w), w0 * bfhi(a.w) + w1 * bfhi(bb.w) + w2 * bfhi(c.w));
        *(v4u*)(OM + (size_t)tok * AW + cch * 8) = o; }
}
__device__ __forceinline__ void p12_final(const Ctx& C, float* out, const float* ssq, const float* gfin) {
    const int gw = C.vcu * NWAVES + C.wave, NGW = C.G * NWAVES;
    f32x4 gv[4];
#pragma unroll
    for (int j = 0; j < 4; ++j) gv[j] = ((const f32x4*)gfin)[C.lane + 64 * j];
    for (int m = gw; m < M; m += NGW) {
        float s = ssq[(size_t)m * 16 + (C.lane & 15)];
        s += __shfl_xor(s, 1); s += __shfl_xor(s, 2); s += __shfl_xor(s, 4); s += __shfl_xor(s, 8);
        const float rs = __builtin_amdgcn_rsqf(s * (1.0f / 1024.0f) + EPS);
        f32x4* xr = (f32x4*)(out + (size_t)m * D) + C.lane;
#pragma unroll
        for (int j = 0; j < 4; ++j) { const f32x4 v = xr[64 * j]; xr[64 * j] = v * rs * gv[j]; } }
}
struct Args { const float* in[15]; float* out; unsigned char* ws; int ph_lo, ph_hi; };
__global__ void __launch_bounds__(NWAVES * 64, 2) trunk_fwd(Args args) {
    extern __shared__ __attribute__((aligned(16))) unsigned char lds[];
    Ctx C;
    C.lds = (LAS unsigned char*)lds;
    volatile LAS unsigned* MISC = (volatile LAS unsigned*)(C.lds + MISC_OFF);
    C.tid = threadIdx.x; C.lane = C.tid & 63; C.wave = __builtin_amdgcn_readfirstlane(C.tid >> 6);
    C.G = gridDim.x; { const int bx = blockIdx.x; C.vcu = (C.G % 8 == 0) ? (bx % 8) * (C.G / 8) + bx / 8 : bx; }
    unsigned char* ws = args.ws;
    gu32* ctl = (gu32*)(ws + WS_CTL);
    for (int u = C.tid; u < (LDS_BYTES - LDSCTL_OFF) / 4; u += NWAVES * 64) ((LAS unsigned*)(C.lds + LDSCTL_OFF))[u] = 0u;
    __syncthreads();
    XcdBarrier bar; bar.bar = (unsigned*)(ctl + CW_BAR); bar.x = 0; bar.st = nullptr;
    if (!MK_SPLIT) bar = xcd_barrier_post((unsigned*)(ctl + CW_BAR), MISC + 8);
    const int lo = args.ph_lo, hi = args.ph_hi;
#define IN(k) (lo <= (k) && (k) < hi)
#define SEAM(k) do { if (IN(k) && IN((k) + 1)) xcd_barrier(bar); } while (0)
    const float* x = args.in[0]; const float* mixg = args.in[1]; const float* mlpg = args.in[2]; const float* fing = args.in[3];
    bf16* XN = (bf16*)(ws + WS_XN); bf16* UV = (bf16*)(ws + WS_BIG); bf16* HID = (bf16*)(ws + WS_BIG); bf16* QKV = (bf16*)(ws + WS_BIG); bf16* UG = (bf16*)(ws + WS_UG); bf16* OM = (bf16*)(ws + WS_OM);
    float* SSQ = (float*)(ws + WS_SSQ); float* VST = (float*)(ws + WS_VST); float* LSE = (float*)(ws + WS_LSE);
    float* out = args.out;

    if (IN(0)) { P0Args A{x, mixg, mlpg, args.in[4], args.in[7], args.in[9], args.in[10], args.in[11], args.in[12], args.in[13], args.in[14], ws}; p0_prologue(C, A); }
    SEAM(0);
    if (IN(1)) {
        pg8::Gemm g{XN, (const bf16*)(ws + WS_WIN), M, 2 * D, D}; pg8::StaticOrder S; S.init(M, 2 * D, C.G, (int)blockIdx.x);
        pg8::EpiAct<1> E{UV, 2 * D, SSQ, VST};
        pg8::gemm_phase<pg8::EpiAct<1>, pg8::StaticOrder, true, true>(C.lds + RING_OFF, g, S, E); }
    SEAM(1);
    if (IN(2)) p2_gating(C, UV, UG, VST, (const bf16*)(ws + WS_WST), args.in[5], args.in[6], args.in[8]);
    SEAM(2);
    if (IN(3)) {
        pg8::Gemm g{UG, (const bf16*)(ws + WS_WOA), M, D, D}; pg8::StaticOrder S; S.init(M, D, C.G, (int)blockIdx.x);
        pg8::EpiRes E{x, out, XN, SSQ, D};
        pg8::gemm_phase<pg8::EpiRes, pg8::StaticOrder, true, true>(C.lds + RING_OFF, g, S, E); }
    SEAM(3);
    if (IN(4)) {
        pg8::Gemm g{XN, (const bf16*)(ws + WS_WUP), M, FF, D}; pg8::StaticOrder S; S.init(M, FF, C.G, (int)blockIdx.x);
        pg8::EpiAct<2> E{HID, FF, SSQ, nullptr};
        pg8::gemm_phase<pg8::EpiAct<2>, pg8::StaticOrder, true, true>(C.lds + RING_OFF, g, S, E); }
    SEAM(4);
    if (IN(5)) {
        pg8::Gemm g{HID, (const bf16*)(ws + WS_WDN), M, D, FF}; pg8::StaticOrder S; S.init(M, D, C.G, (int)blockIdx.x);
        pg8::EpiRes E{out, out, XN, SSQ, D};
        pg8::gemm_phase<pg8::EpiRes, pg8::StaticOrder, true, true>(C.lds + RING_OFF, g, S, E); }
    SEAM(5);
    if (IN(6)) {
        pg8::Gemm g{XN, (const bf16*)(ws + WS_WQKV), M, NQKV, D}; pg8::StaticOrder S; S.init(M, NQKV, C.G, (int)blockIdx.x);
        pg8::EpiAct<0> E{QKV, NQKV, SSQ, nullptr};
        pg8::gemm_phase<pg8::EpiAct<0>, pg8::StaticOrder, true, true>(C.lds + RING_OFF, g, S, E); }
    SEAM(6);
    if (IN(7)) p7_attention(C, QKV, LSE, (const float*)(ws + WS_LUT));
    SEAM(7);
    if (IN(8)) p8_merge(C, QKV, LSE, OM);
    SEAM(8);
    if (IN(9)) {
        pg8::Gemm g{OM, (const bf16*)(ws + WS_WOB), M, D, AW}; pg8::StaticOrder S; S.init(M, D, C.G, (int)blockIdx.x);
        pg8::EpiRes E{out, out, XN, SSQ, D};
        pg8::gemm_phase<pg8::EpiRes, pg8::StaticOrder, true, true>(C.lds + RING_OFF, g, S, E); }
    SEAM(9);
    if (IN(10)) {
        pg8::Gemm g{XN, (const bf16*)(ws + WS_WUP + 8 * MiB), M, FF, D}; pg8::StaticOrder S; S.init(M, FF, C.G, (int)blockIdx.x);
        pg8::EpiAct<2> E{HID, FF, SSQ, nullptr};
        pg8::gemm_phase<pg8::EpiAct<2>, pg8::StaticOrder, true, true>(C.lds + RING_OFF, g, S, E); }
    SEAM(10);
    if (IN(11)) {
        pg8::Gemm g{HID, (const bf16*)(ws + WS_WDN + 8 * MiB), M, D, FF}; pg8::StaticOrder S; S.init(M, D, C.G, (int)blockIdx.x);
        pg8::EpiRes E{out, out, XN, SSQ, D};
        pg8::gemm_phase<pg8::EpiRes, pg8::StaticOrder, true, true>(C.lds + RING_OFF, g, S, E); }
    SEAM(11);
    if (IN(12)) p12_final(C, out, SSQ, fing);
#undef IN
#undef SEAM
}

extern "C" void kernel_launch(void* const* d_in, const int* in_sizes, int n_in, void* d_out, int out_size, void* d_ws, size_t ws_size, hipStream_t stream) {
    static int grid = 0;
    if (grid == 0) {
        if (n_in != 15 || in_sizes[0] != M * D || out_size != M * D || ws_size < WS_END) { fprintf(stderr, "kernel_launch: shape/workspace mismatch (n_in %d, in0 %d, out %d, ws %zu); nothing launched\n", n_in, n_in > 0 ? in_sizes[0] : -1, out_size, ws_size); grid = -1; return; }
        int dev = 0, cus = 0, per_cu = 0;
        if (hipGetDevice(&dev) != hipSuccess || hipDeviceGetAttribute(&cus, hipDeviceAttributeMultiprocessorCount, dev) != hipSuccess) { grid = -1; return; }
        if (hipFuncSetAttribute((const void*)trunk_fwd, hipFuncAttributeMaxDynamicSharedMemorySize, LDS_BYTES) != hipSuccess) { fprintf(stderr, "kernel_launch: hipFuncSetAttribute failed\n"); grid = -1; return; }
        if (hipOccupancyMaxActiveBlocksPerMultiprocessor(&per_cu, (const void*)trunk_fwd, NWAVES * 64, LDS_BYTES) != hipSuccess || per_cu < 1)
            fprintf(stderr, "kernel_launch: note: occupancy query reports %d workgroups per CU\n", per_cu);
        (void)hipGetLastError();
        grid = cus;
    }
    if (grid < 0) return;
    if (hipMemsetAsync((char*)d_ws + WS_CTL, 0, CTL_ZERO_BYTES, stream) != hipSuccess) return;
    Args a{};
    for (int i = 0; i < 15; ++i) a.in[i] = (const float*)d_in[i];
    a.out = (float*)d_out; a.ws = (unsigned char*)d_ws;
#if MK_SPLIT
    for (int p = 0; p < N_PHASES; ++p) { a.ph_lo = p; a.ph_hi = p + 1; hipLaunchKernelGGL(trunk_fwd, dim3(grid), dim3(NWAVES * 64), LDS_BYTES, stream, a); }
#else
    a.ph_lo = 0; a.ph_hi = N_PHASES;
    hipLaunchKernelGGL(trunk_fwd, dim3(grid), dim3(NWAVES * 64), LDS_BYTES, stream, a);
#endif
    const hipError_t le = hipPeekAtLastError();
    if (le != hipSuccess) fprintf(stderr, "kernel_launch: launch failed: %s\n", hipGetErrorName(le));
}
```

```cpp
#include <hip/hip_runtime.h>
#include <cstdio>
#include <cstdint>
namespace pg8 {
#define PG8_LAS __attribute__((address_space(3)))
typedef unsigned short bf16_t;
typedef short bf16x8 __attribute__((ext_vector_type(8)));
typedef float f32x4 __attribute__((ext_vector_type(4)));
typedef unsigned u32x4 __attribute__((ext_vector_type(4)));
constexpr int BM = 256, BK = 64, HALF = 128, HTB = HALF * BK * 2  , STAGE_BYTES = 8 * HTB, NXCD = 8, WGM = 8;

__host__ __device__ __forceinline__ int lds_byte(int r, int c) { const int st = (r >> 4) * 2 + (c >> 5), rr = r & 15, cc = c & 31, ob = rr * 64 + cc * 2; return st * 1024 + (ob ^ (((ob >> 9) & 1) << 5)); }
__host__ __device__ __forceinline__ void stage_rc(int b, int& R, int& C) { const int st = b / 1024, sb = b % 1024, swz = sb ^ (((sb >> 9) & 1) << 5); R = (st >> 1) * 16 + swz / 64; C = (st & 1) * 32 + (swz % 64) / 2; }
__host__ __device__ __forceinline__ int perm32(int rho) { const int n = rho >> 4, i = rho & 15; return 8 * (i >> 2) + 4 * n + (i & 3); }

struct Unit { int pm, pn; };
struct Gemm { const bf16_t* A; const bf16_t* Bt; int M, N, K; size_t tstepA; };

struct StaticOrder {
    int nM, nN, nwg, G, c, rev, pnrev;
    __host__ __device__ void init(int M, int N, int G_, int c_) { nM = M / BM; nN = N / BM; nwg = nM * nN; G = G_; c = c_; rev = 0; pnrev = 0; }
    __host__ __device__ void columns_descending() { pnrev = 1; }
    __host__ __device__ void reversed() { rev = (nwg + G - 1) / G; }
    __host__ __device__ bool next(int i, Unit& u) const {
        if (rev) { if (i >= rev) return false; i = rev - 1 - i; }
        const long L = (long)i * G + c; if (L >= nwg) return false;
        int wgid = (int)L; { const int q = nwg / NXCD, r = nwg % NXCD, xcd = wgid % NXCD, off = wgid / NXCD; wgid = (xcd < r ? xcd * (q + 1) : r * (q + 1) + (xcd - r) * q) + off; }
        const int nig = WGM * nN, gid = wgid / nig, fm = gid * WGM, gsz = (nM - fm) < WGM ? (nM - fm) : WGM;
        u.pm = fm + ((wgid % nig) % gsz); u.pn = (wgid % nig) / gsz; if (pnrev) u.pn = nN - 1 - u.pn; return true;
    }
    __device__ __forceinline__ void a_ready(const Unit&) const {}
    __device__ __forceinline__ void done(const Unit&) const {}
};

__device__ __forceinline__ unsigned cvt_pk_bf16(float lo, float hi) { unsigned r; asm volatile("v_cvt_pk_bf16_f32 %0, %1, %2" : "=v"(r) : "v"(lo), "v"(hi)); return r; }
typedef float f32x2 __attribute__((ext_vector_type(2)));
__device__ __forceinline__ f32x2 gelu_pk(f32x2 v) {
    f32x2 a; a.x = fminf(__builtin_fabsf(v.x), 5.3f); a.y = fminf(__builtin_fabsf(v.y), 5.3f);
    const f32x2 x = a * 0.377358496f + (-1.0f);
    f32x2 q = x * (-2.680665057e-04f) + (-4.321495537e-03f);
    q = q * x + 7.164665032e-03f; q = q * x + 1.980672404e-02f; q = q * x + (-4.157880694e-02f); q = q * x + (-2.189491689e-02f); q = q * x + 1.078988388e-01f;
    q = q * x + (-5.974620953e-02f); q = q * x + (-1.094131693e-01f); q = q * x + 2.026295662e-01f; q = q * x + (-8.957923949e-02f); q = q * x + (-1.324163824e-01f);
    q = q * x + 2.609098256e-01f; q = q * x + (-2.224893272e-01f); q = q * x + 1.108414084e-01f; q = q * x + (-3.156794980e-02f); q = q * x + 4.024588503e-03f;
    const f32x2 m = v * q, r = v - m;
    f32x2 o; o.x = v.x < 0.f ? m.x : r.x; o.y = v.y < 0.f ? m.y : r.y; return o;
}

struct RsTable {
    const float* ssq; PG8_LAS float* tab; mutable int pm_cached;
    __device__ __forceinline__ void get(const Unit& u, int wr, int fr, float (&rs)[2][4]) const {
        if (u.pm != pm_cached) {
            const int t = threadIdx.x, row = t >> 1, half = t & 1;
            const f32x4 a = *(const f32x4*)(ssq + (size_t)(u.pm * BM + row) * 16 + half * 8), b = *(const f32x4*)(ssq + (size_t)(u.pm * BM + row) * 16 + half * 8 + 4);
            float s = ((a[0] + a[1]) + (a[2] + a[3])) + ((b[0] + b[1]) + (b[2] + b[3]));
            s += __shfl_xor(s, 1);
            if (half == 0) tab[row] = __builtin_amdgcn_rsqf(s * (1.0f / 1024.0f) + 1e-6f);
            asm volatile("s_waitcnt lgkmcnt(0)" ::: "memory"); __builtin_amdgcn_s_barrier(); asm volatile("" ::: "memory");
            pm_cached = u.pm;
        }
#pragma unroll
        for (int ai = 0; ai < 2; ++ai)
#pragma unroll
            for (int m = 0; m < 4; ++m) rs[ai][m] = tab[ai * HALF + wr * 64 + m * 16 + fr];
    }
};
struct GateW { const unsigned* cnt; unsigned target; mutable int passed;
    __device__ __forceinline__ void wait() const { if (cnt && !passed) { unsigned sp = 0u; while (__hip_atomic_load(cnt, __ATOMIC_RELAXED, __HIP_MEMORY_SCOPE_AGENT) < target) { __builtin_amdgcn_s_sleep(2); if (++sp > (1u << 22)) break; } passed = 1; } } };
template <int ACT> struct EpiAct {
    static constexpr bool PERM = true, AFTER_DRAIN = false;
    bf16_t* O; int ldc; size_t pstride; RsTable rt; float* vst; GateW gate;
    __device__ __forceinline__ void operator()(const f32x4 (&acc)[2][2][4][2], const Unit& u, int wr, int wc, int fr, int fq) const {
        const int row0 = u.pm * BM + wr * 64 + fr, col0 = u.pn * BM + wc * 32 + 8 * fq;
        const bool vhalf = (ACT == 1) && (u.pn >= 4);
        float rsv[2][4]; rt.get(u, wr, fr, rsv); gate.wait();
#pragma unroll
        for (int ai = 0; ai < 2; ++ai)
#pragma unroll
            for (int m = 0; m < 4; ++m) {
                const int row = row0 + ai * HALF + m * 16;
                const float rs = rsv[ai][m];
                bf16_t* rowp = O + (size_t)u.pm * pstride + (size_t)(row - u.pm * BM) * ldc + col0;
                float s1 = 0.f, s2 = 0.f;
#pragma unroll
                for (int bj = 0; bj < 2; ++bj) {
                    f32x4 v0 = acc[ai][bj][m][0] * rs, v1 = acc[ai][bj][m][1] * rs;
                    if (ACT == 1) { f32x2 a = gelu_pk((f32x2){v0[0], v0[1]}), b = gelu_pk((f32x2){v0[2], v0[3]}), c = gelu_pk((f32x2){v1[0], v1[1]}), d = gelu_pk((f32x2){v1[2], v1[3]});
                        v0 = (f32x4){a.x, a.y, b.x, b.y}; v1 = (f32x4){c.x, c.y, d.x, d.y};
                        s1 += ((v0[0] + v0[1]) + (v0[2] + v0[3])) + ((v1[0] + v1[1]) + (v1[2] + v1[3]));
                        s2 += ((v0[0] * v0[0] + v0[1] * v0[1]) + (v0[2] * v0[2] + v0[3] * v0[3])) + ((v1[0] * v1[0] + v1[1] * v1[1]) + (v1[2] * v1[2] + v1[3] * v1[3])); }
                    if (ACT == 2) {
#pragma unroll
                        for (int e = 0; e < 4; ++e) { const float a = fmaxf(v0[e], 0.f), b = fmaxf(v1[e], 0.f); v0[e] = a * a; v1[e] = b * b; } }
                    u32x4 w; w.x = cvt_pk_bf16(v0[0], v0[1]); w.y = cvt_pk_bf16(v0[2], v0[3]); w.z = cvt_pk_bf16(v1[0], v1[1]); w.w = cvt_pk_bf16(v1[2], v1[3]);
                    *(u32x4*)(rowp + bj * HALF) = w; }
                if (ACT == 1) { if (vhalf) { s1 += __shfl_xor(s1, 16); s1 += __shfl_xor(s1, 32); s2 += __shfl_xor(s2, 16); s2 += __shfl_xor(s2, 32);
                        if (fq == 0) *(f32x2*)(vst + ((size_t)row * 16 + (u.pn - 4) * 4 + wc) * 2) = (f32x2){s1, s2}; } }
            }
    }
};
struct EpiQKV {
    static constexpr bool PERM = true, AFTER_DRAIN = false;
    bf16_t* O; RsTable rt; int seq, nb; GateW gate;
    __device__ __forceinline__ void operator()(const f32x4 (&acc)[2][2][4][2], const Unit& u, int wr, int wc, int fr, int fq) const {
        const int row0 = u.pm * BM + wr * 64 + fr, col0 = u.pn * BM + wc * 32 + 8 * fq;
        const int g = ((u.pn * BM) / 512) % 3, lg = 2 * g, dm = (1 << lg) - 1;
        float rsv[2][4]; rt.get(u, wr, fr, rsv); gate.wait();
#pragma unroll
        for (int ai = 0; ai < 2; ++ai)
#pragma unroll
            for (int m = 0; m < 4; ++m) {
                const int row = row0 + ai * HALF + m * 16, b = row / seq, pos = row - b * seq;
                const size_t prow = (size_t)b * seq + (size_t)(pos & dm) * (seq >> lg) + (pos >> lg);
                const float rs = rsv[ai][m];
#pragma unroll
                for (int bj = 0; bj < 2; ++bj) { const int col = col0 + bj * HALF, hd = col >> 6;
                    const f32x4 v0 = acc[ai][bj][m][0] * rs, v1 = acc[ai][bj][m][1] * rs;
                    u32x4 w; w.x = cvt_pk_bf16(v0[0], v0[1]); w.y = cvt_pk_bf16(v0[2], v0[3]); w.z = cvt_pk_bf16(v1[0], v1[1]); w.w = cvt_pk_bf16(v1[2], v1[3]);
                    *(u32x4*)(O + ((size_t)hd * nb * seq + prow) * 64 + (col & 63)) = w; } }
    }
};
__device__ __forceinline__ float bf_lo(unsigned w) { return __builtin_bit_cast(float, w << 16); }
__device__ __forceinline__ float bf_hi(unsigned w) { return __builtin_bit_cast(float, w & 0xffff0000u); }
struct EpiRes {
    static constexpr bool PERM = true, AFTER_DRAIN = false;
    bf16_t* hb; float* ssq; int ldc;
    __device__ __forceinline__ void operator()(const f32x4 (&acc)[2][2][4][2], const Unit& u, int wr, int wc, int fr, int fq) const {
        const int row0 = u.pm * BM + wr * 64 + fr, col0 = u.pn * BM + wc * 32 + 8 * fq;
        u32x4 r[2][4][2];
#pragma unroll
        for (int ai = 0; ai < 2; ++ai)
#pragma unroll
            for (int m = 0; m < 4; ++m)
#pragma unroll
                for (int bj = 0; bj < 2; ++bj) r[ai][m][bj] = *(const u32x4*)(hb + (size_t)(row0 + ai * HALF + m * 16) * ldc + col0 + bj * HALF);
        asm volatile("" ::: "memory");
#pragma unroll
        for (int ai = 0; ai < 2; ++ai)
#pragma unroll
            for (int m = 0; m < 4; ++m) {
                const int row = row0 + ai * HALF + m * 16;
                float q = 0.f;
#pragma unroll
                for (int bj = 0; bj < 2; ++bj) { const u32x4 rr = r[ai][m][bj];
                    const f32x4 h0 = (f32x4){bf_lo(rr.x), bf_hi(rr.x), bf_lo(rr.y), bf_hi(rr.y)} + acc[ai][bj][m][0], h1 = (f32x4){bf_lo(rr.z), bf_hi(rr.z), bf_lo(rr.w), bf_hi(rr.w)} + acc[ai][bj][m][1];
                    u32x4 w; w.x = cvt_pk_bf16(h0[0], h0[1]); w.y = cvt_pk_bf16(h0[2], h0[3]); w.z = cvt_pk_bf16(h1[0], h1[1]); w.w = cvt_pk_bf16(h1[2], h1[3]);
                    *(u32x4*)(hb + (size_t)row * ldc + col0 + bj * HALF) = w;
                    q += ((h0[0] * h0[0] + h0[1] * h0[1]) + (h0[2] * h0[2] + h0[3] * h0[3])) + ((h1[0] * h1[0] + h1[1] * h1[1]) + (h1[2] * h1[2] + h1[3] * h1[3])); }
                q += __shfl_xor(q, 16); q += __shfl_xor(q, 32);
                if (fq == 0) ssq[(size_t)row * 16 + u.pn * 4 + wc] = q;
            }
    }
};
struct EpiNull {
    static constexpr bool PERM = true, AFTER_DRAIN = false;
    __device__ __forceinline__ void operator()(const f32x4 (&acc)[2][2][4][2], const Unit& u, int wr, int wc, int fr, int fq) const {
#pragma unroll
        for (int ai = 0; ai < 2; ++ai)
#pragma unroll
            for (int bj = 0; bj < 2; ++bj)
#pragma unroll
                for (int m = 0; m < 4; ++m)
#pragma unroll
                    for (int n = 0; n < 2; ++n) asm volatile("" :: "v"(acc[ai][bj][m][n]));
    }
};
struct EpiStoreOnly {
    static constexpr bool PERM = true, AFTER_DRAIN = false;
    bf16_t* O; int ldc;
    __device__ __forceinline__ void operator()(const f32x4 (&acc)[2][2][4][2], const Unit& u, int wr, int wc, int fr, int fq) const {
        const int row0 = u.pm * BM + wr * 64 + fr, col0 = u.pn * BM + wc * 32 + 8 * fq;
#pragma unroll
        for (int ai = 0; ai < 2; ++ai)
#pragma unroll
            for (int m = 0; m < 4; ++m) {
                bf16_t* rowp = O + (size_t)(row0 + ai * HALF + m * 16) * ldc + col0;
#pragma unroll
                for (int bj = 0; bj < 2; ++bj) { const f32x4 v0 = acc[ai][bj][m][0], v1 = acc[ai][bj][m][1];
                    u32x4 w; w.x = cvt_pk_bf16(v0[0], v0[1]); w.y = cvt_pk_bf16(v0[2], v0[3]); w.z = cvt_pk_bf16(v1[0], v1[1]); w.w = cvt_pk_bf16(v1[2], v1[3]);
                    *(u32x4*)(rowp + bj * HALF) = w; } }
    }
};
template <class Epi, class Sched, bool ALIGN_EPI = false, bool SP2 = false>
__device__ __forceinline__ void gemm_phase(PG8_LAS unsigned char* lds, const Gemm g, const Sched& S, const Epi& E) {
    const int tid = threadIdx.x, wid = __builtin_amdgcn_readfirstlane(tid >> 6), lane = tid & 63, wr = wid >> 2, wc = wid & 3, fr = lane & 15, fq = lane >> 4;
    const int K = g.K, nt = K / BK;
    unsigned voffA[2], voffB[2];
#pragma unroll
    for (int i = 0; i < 2; ++i) { int R, C; stage_rc(tid * 16 + i * 8192, R, C); const int Rb = Epi::PERM ? ((R & ~31) + perm32(R & 31)) : R;
        voffA[i] = (unsigned)(R * K + C) * 2u; voffB[i] = (unsigned)(Rb * K + C) * 2u; }
    const size_t kstep = (size_t)(BK * 2);
    const size_t hstep = (size_t)HALF * K * 2;
    const size_t tstep = 2 * hstep;
    const unsigned ldsw = (unsigned)wid * 1024u;
    const int aoff = lds_byte(wr * 64 + fr, fq * 8), boff = lds_byte(wc * 32 + fr, fq * 8);
#define PG8_SA(b, h) (((b) * 2 + (h)) * HTB)
#define PG8_SB(b, h) ((4 + (b) * 2 + (h)) * HTB)
#define PG8_STAGE(bufoff, gbase, voff) do { _Pragma("unroll") for (int _i = 0; _i < 2; ++_i) \
        __builtin_amdgcn_global_load_lds((const unsigned*)((const char*)(gbase) + (voff)[_i]), (PG8_LAS unsigned*)(lds + (bufoff) + ldsw + _i * 8192), 16, 0, 0); } while (0)
#define PG8_LDA(dst, b, h) do { _Pragma("unroll") for (int m = 0; m < 4; ++m) _Pragma("unroll") for (int k = 0; k < 2; ++k) dst[m][k] = *(const PG8_LAS bf16x8*)(lds + PG8_SA(b, h) + aoff + m * 2048 + k * 1024); } while (0)
#define PG8_LDB(dst, b, h) do { _Pragma("unroll") for (int n = 0; n < 2; ++n) _Pragma("unroll") for (int k = 0; k < 2; ++k) dst[n][k] = *(const PG8_LAS bf16x8*)(lds + PG8_SB(b, h) + boff + n * 2048 + k * 1024); } while (0)
#define PG8_MMA(ai, bj, At, Bt) do { __builtin_amdgcn_s_setprio(1); _Pragma("unroll") for (int m = 0; m < 4; ++m) _Pragma("unroll") for (int n = 0; n < 2; ++n) _Pragma("unroll") for (int k = 0; k < 2; ++k) \
        acc[ai][bj][m][n] = __builtin_amdgcn_mfma_f32_16x16x32_bf16(Bt[n][k], At[m][k], acc[ai][bj][m][n], 0, 0, 0); __builtin_amdgcn_s_setprio(0); } while (0)
#define PG8_WAIT_V(n) asm volatile("s_waitcnt vmcnt(" #n ")" ::: "memory")
#define PG8_WAIT_L(n) asm volatile("s_waitcnt lgkmcnt(" #n ")" ::: "memory")
#define PG8_BAR __builtin_amdgcn_s_barrier()
#define PG8_SCHED __builtin_amdgcn_sched_barrier(0)
    Unit cur, nxt; int ui = 0;
    if (!S.next(0, cur)) return;
    f32x4 acc[2][2][4][2];
#pragma unroll
    for (int a = 0; a < 2; ++a)
#pragma unroll
        for (int b = 0; b < 2; ++b)
#pragma unroll
            for (int m = 0; m < 4; ++m)
#pragma unroll
                for (int n = 0; n < 2; ++n) acc[a][b][m][n] = (f32x4){0.f, 0.f, 0.f, 0.f};
    bf16x8 At[4][2], B0[2][2], B1[2][2];
    const char* cA = (const char*)g.A + (size_t)cur.pm * g.tstepA; const char* cB = (const char*)g.Bt + (size_t)cur.pn * tstep;
    S.a_ready(cur);
    if constexpr (SP2) {
        PG8_STAGE(PG8_SB(0, 0), cB, voffB); PG8_STAGE(PG8_SB(0, 1), cB + hstep, voffB); PG8_STAGE(PG8_SA(0, 0), cA, voffA); PG8_STAGE(PG8_SA(0, 1), cA + hstep, voffA);
        if (wr == 1) PG8_BAR;
        PG8_WAIT_V(2); PG8_BAR;
        PG8_STAGE(PG8_SB(1, 0), cB + kstep, voffB); PG8_STAGE(PG8_SA(1, 0), cA + kstep, voffA); PG8_STAGE(PG8_SB(1, 1), cB + hstep + kstep, voffB);
        PG8_WAIT_V(6); PG8_BAR;
    } else {
        PG8_STAGE(PG8_SB(0, 0), cB, voffB); PG8_STAGE(PG8_SA(0, 0), cA, voffA); PG8_STAGE(PG8_SB(0, 1), cB + hstep, voffB); PG8_STAGE(PG8_SA(0, 1), cA + hstep, voffA);
        if (wr == 1) PG8_BAR;
        PG8_WAIT_V(4); PG8_BAR;
        PG8_STAGE(PG8_SB(1, 0), cB + kstep, voffB); PG8_STAGE(PG8_SA(1, 0), cA + kstep, voffA); PG8_STAGE(PG8_SB(1, 1), cB + hstep + kstep, voffB);
        PG8_WAIT_V(6); PG8_BAR;
    }
    for (;;) {
        const bool has_next = S.next(ui + 1, nxt);
        const char* nA = has_next ? (const char*)g.A + (size_t)nxt.pm * g.tstepA : cA; const char* nB = has_next ? (const char*)g.Bt + (size_t)nxt.pn * tstep : cB;
        for (int t = 0; t < nt; t += 2) {
            const bool last = (t == nt - 2);
            const char* a1 = cA + (size_t)(t + 1) * kstep;
            const char* a2 = last ? nA : cA + (size_t)(t + 2) * kstep; const char* b2 = last ? nB : cB + (size_t)(t + 2) * kstep;
            const char* a3 = a2 + kstep; const char* b3 = b2 + kstep;
            if (last && has_next) S.a_ready(nxt);
            if constexpr (SP2) {
            PG8_LDB(B0, 0, 0); PG8_LDB(B1, 0, 1); PG8_SCHED; PG8_LDA(At, 0, 0); PG8_STAGE(PG8_SA(1, 1), a1 + hstep, voffA);
            PG8_WAIT_V(8); PG8_WAIT_L(0); PG8_BAR; PG8_MMA(0, 0, At, B0); PG8_MMA(0, 1, At, B1); PG8_BAR; PG8_SCHED;
            PG8_LDA(At, 0, 1); PG8_STAGE(PG8_SB(0, 0), b2, voffB); PG8_STAGE(PG8_SB(0, 1), b2 + hstep, voffB); PG8_STAGE(PG8_SA(0, 0), a2, voffA);
            PG8_WAIT_V(8); PG8_WAIT_L(0); PG8_BAR; PG8_MMA(1, 0, At, B0); PG8_MMA(1, 1, At, B1); PG8_BAR; PG8_SCHED;
            PG8_LDB(B0, 1, 0); PG8_LDB(B1, 1, 1); PG8_SCHED; PG8_LDA(At, 1, 0); PG8_STAGE(PG8_SA(0, 1), a2 + hstep, voffA);
            PG8_WAIT_V(8); PG8_WAIT_L(0); PG8_BAR; PG8_MMA(0, 0, At, B0); PG8_MMA(0, 1, At, B1); PG8_BAR; PG8_SCHED;
            PG8_LDA(At, 1, 1); PG8_STAGE(PG8_SB(1, 0), b3, voffB); PG8_STAGE(PG8_SB(1, 1), b3 + hstep, voffB); PG8_STAGE(PG8_SA(1, 0), a3, voffA);
            PG8_WAIT_V(8); PG8_WAIT_L(0); PG8_BAR; PG8_MMA(1, 0, At, B0); PG8_MMA(1, 1, At, B1); PG8_BAR; PG8_SCHED;
            } else {
            PG8_LDB(B0, 0, 0); PG8_SCHED; PG8_LDA(At, 0, 0); PG8_STAGE(PG8_SA(1, 1), a1 + hstep, voffA);
            PG8_WAIT_L(8); PG8_BAR; PG8_WAIT_L(0); PG8_MMA(0, 0, At, B0); PG8_BAR; PG8_SCHED;
            PG8_LDB(B1, 0, 1); PG8_STAGE(PG8_SB(0, 0), b2, voffB);
            PG8_BAR; PG8_WAIT_L(0); PG8_MMA(0, 1, At, B1); PG8_BAR;
            PG8_LDA(At, 0, 1); PG8_STAGE(PG8_SA(0, 0), a2, voffA);
            PG8_BAR; PG8_WAIT_L(0); PG8_MMA(1, 0, At, B0); PG8_BAR; PG8_SCHED;
            PG8_STAGE(PG8_SB(0, 1), b2 + hstep, voffB);
            PG8_WAIT_V(6); PG8_BAR; PG8_MMA(1, 1, At, B1); PG8_BAR;
            PG8_LDB(B0, 1, 0); PG8_SCHED; PG8_LDA(At, 1, 0); PG8_STAGE(PG8_SA(0, 1), a2 + hstep, voffA);
            PG8_WAIT_L(8); PG8_BAR; PG8_WAIT_L(0); PG8_MMA(0, 0, At, B0); PG8_BAR; PG8_SCHED;
            PG8_LDB(B1, 1, 1); PG8_STAGE(PG8_SB(1, 0), b3, voffB);
            PG8_BAR; PG8_WAIT_L(0); PG8_MMA(0, 1, At, B1); PG8_BAR;
            PG8_LDA(At, 1, 1); PG8_STAGE(PG8_SA(1, 0), a3, voffA);
            PG8_BAR; PG8_WAIT_L(0); PG8_MMA(1, 0, At, B0); PG8_BAR; PG8_SCHED;
            PG8_STAGE(PG8_SB(1, 1), b3 + hstep, voffB);
            PG8_WAIT_V(6); PG8_BAR; PG8_MMA(1, 1, At, B1); PG8_BAR;
            }
        }
        if constexpr (ALIGN_EPI) { if (wr == 0) PG8_BAR; }
        if constexpr (!Epi::AFTER_DRAIN) { E(acc, cur, wr, wc, fr, fq); S.done(cur); }
        if (!has_next) break;
#pragma unroll
        for (int a = 0; a < 2; ++a)
#pragma unroll
            for (int b = 0; b < 2; ++b)
#pragma unroll
                for (int m = 0; m < 4; ++m)
#pragma unroll
                    for (int n = 0; n < 2; ++n) acc[a][b][m][n] = (f32x4){0.f, 0.f, 0.f, 0.f};
        cur = nxt; cA = nA; cB = nB; ++ui;
        if constexpr (ALIGN_EPI) { if (wr == 1) PG8_BAR; }
    }
    PG8_WAIT_V(0);
    if constexpr (!ALIGN_EPI) { if (wr == 0) PG8_BAR; }
    PG8_BAR;
    if constexpr (Epi::AFTER_DRAIN) { E.fused(acc, cur, wr, wc, fr, fq, lds, wid, lane); S.done(cur); }
#undef PG8_SA
#undef PG8_SB
#undef PG8_STAGE
#undef PG8_LDA
#undef PG8_LDB
#undef PG8_MMA
#undef PG8_WAIT_V
#undef PG8_WAIT_L
#undef PG8_BAR
#undef PG8_SCHED
}
}
constexpr int NWAVES = 8;
constexpr int BATCH = 4, SEQ = 8192, D = 1024, FF = 4096, NQKV = 4608, AW = 512, NH = 8, HD = 64;
constexpr int M = BATCH * SEQ;
constexpr int CHUNK = 128, NCHUNK = M / CHUNK, NGRP = 8;
constexpr float EPS = 1e-6f;
constexpr float LOG2E = 1.4426950408889634f;
constexpr int LUT_N = 176;
#ifndef MK_SPLIT
#define MK_SPLIT 0
#endif
constexpr int N_PHASES = 12;
#define DUP_AFTER (-1)
#define DUP_N 0
#define DUP_BODY
#define BAR_REPS 1
constexpr int N_SEQ = N_PHASES + DUP_N;

constexpr size_t MiB = 1u << 20;
constexpr size_t WS_CTL = 0, CTL_ZERO_BYTES = 128 * 1024;
constexpr size_t WS_WIN = 2 * MiB, WS_WOA = 6 * MiB, WS_WQKV = 8 * MiB, WS_WOB = 17 * MiB, WS_WUP = 18 * MiB, WS_WDN = 34 * MiB;
constexpr size_t WS_WST = 50 * MiB;
constexpr size_t WS_LUT = 50 * MiB + 512 * 1024;
constexpr size_t WS_SSQ = 51 * MiB;
constexpr size_t WS_VST = 53 * MiB;
constexpr size_t WS_LSE = 57 * MiB;
constexpr size_t WS_XN = 64 * MiB;
constexpr size_t WS_BIG = 128 * MiB;
constexpr size_t BLK = 2304 * 1024;
constexpr size_t BLK_UG = 1 * MiB, QSLICE = 256 * 64;
constexpr size_t WS_OM = 416 * MiB;
constexpr size_t WS_END = 448 * MiB;
constexpr int CW_TMO = 0, CW_CODE = 1, CW_BAR = 4096, CW_GRP = 8192, CW_XCC = 16384, CW_GATE = 20480;
static_assert((size_t)(CW_GATE + 256) * 4 <= CTL_ZERO_BYTES, "control words inside the per-call memset");

constexpr int RING_OFF = 0, RING_BYTES = 131072;
constexpr int LDSCTL_OFF = 159744  , MISC_OFF = LDSCTL_OFF + 320, RSTAB_OFF = LDSCTL_OFF + 1024;
constexpr int LDS_BYTES = 163840;

#define GAS __attribute__((address_space(1)))
#define LAS __attribute__((address_space(3)))
typedef unsigned short bf16;
typedef unsigned v4u __attribute__((ext_vector_type(4)));
typedef float f32x4 __attribute__((ext_vector_type(4)));
typedef short bf16x8 __attribute__((ext_vector_type(8)));
typedef GAS unsigned gu32;
typedef GAS unsigned long long gu64;
#define RLX_AGENT __ATOMIC_RELAXED, __HIP_MEMORY_SCOPE_AGENT
#define LDS_WAIT() asm volatile("s_waitcnt lgkmcnt(0)" ::: "memory")
#define VM_WAIT() asm volatile("s_waitcnt vmcnt(0)" ::: "memory")
__device__ __forceinline__ unsigned long long rt() { return __builtin_amdgcn_s_memrealtime(); }
__device__ __forceinline__ unsigned f2bf(float f) { unsigned u = __builtin_bit_cast(unsigned, f); return (u + 0x7fffu + ((u >> 16) & 1u)) >> 16; }
__device__ __forceinline__ unsigned pk2(float lo, float hi) { return f2bf(lo) | (f2bf(hi) << 16); }

#define XB_TMO      128
#define XB_XCNT(j)  (256  + 64 * (j))
#define XB_XSUB(j)  (1280 + 64 * (j))
#define XB_XGEN(j)  (2304 + 64 * (j))
#define XB_TOP      3328
#define XB_TOPGEN   3392
#define XCD_BAR_WORDS 3456
#define XB_SPIN_CAP (1u << 18)

__device__ __forceinline__ unsigned xb_ld(unsigned* p)              { return __hip_atomic_load(p, __ATOMIC_RELAXED, __HIP_MEMORY_SCOPE_AGENT); }
__device__ __forceinline__ unsigned xb_add(unsigned* p, unsigned v) { return __hip_atomic_fetch_add(p, v, __ATOMIC_RELAXED, __HIP_MEMORY_SCOPE_AGENT); }
__device__ __forceinline__ unsigned xb_xcc_id() { return (unsigned)__builtin_amdgcn_s_getreg((3 << 11) | 20) & 0xFu; }
#define XB_SPIN(cond, bar) do { unsigned _sp = 0; while (cond) { __builtin_amdgcn_s_sleep(1); \
    if ((++_sp & 255u) == 0u) { if (xb_ld(&(bar)[XB_TMO])) break; if (_sp > XB_SPIN_CAP) { atomicAdd(&(bar)[XB_TMO], 1u); break; } } } } while (0)

struct XcdBarrier {
    unsigned* bar; unsigned x;
    volatile LAS unsigned* st;
};

__device__ __forceinline__ XcdBarrier xcd_barrier_post(unsigned* bar, volatile LAS unsigned* st) {
    XcdBarrier b; b.bar = bar; b.x = xb_xcc_id(); b.st = st;
    if (threadIdx.x == 0) (void)xb_add(&bar[XB_XCNT(b.x)], 1u);
    return b;
}
__device__ __forceinline__ void xcd_barrier_complete(unsigned* bar, unsigned x, unsigned& nloc, unsigned& nx) {
    const unsigned G = gridDim.x * gridDim.y * gridDim.z;
    unsigned sum, cnt, mine, sp = 0u;
    for (;;) {
        sum = 0u; cnt = 0u; mine = 0u;
#pragma unroll
        for (unsigned j = 0; j < 16; ++j) { const unsigned c = xb_ld(&bar[XB_XCNT(j)]); sum += c; cnt += (c > 0u) ? 1u : 0u; mine = (j == x) ? c : mine; }
        if (sum == G) break;
        __builtin_amdgcn_s_sleep(1);
        if ((++sp & 255u) == 0u) { if (xb_ld(&bar[XB_TMO])) break; if (sp > XB_SPIN_CAP) { atomicAdd(&bar[XB_TMO], 1u); break; } }
    }
    nloc = mine > 0u ? mine : 1u; nx = cnt > 0u ? cnt : 1u;
}

__device__ __forceinline__ void xcd_barrier(const XcdBarrier& b) {
    asm volatile("s_waitcnt vmcnt(0)" ::: "memory");
    __syncthreads();
    if (threadIdx.x == 0) {
        unsigned* bar = b.bar;
        __builtin_amdgcn_s_waitcnt(0);
        unsigned nloc = b.st[0], nx = b.st[1];
        if (nloc == 0u) { xcd_barrier_complete(bar, b.x, nloc, nx); b.st[0] = nloc; b.st[1] = nx; }
        const unsigned old = xb_add(&bar[XB_XSUB(b.x)], 1u);
        const unsigned gen = old / nloc;
        if (old + 1u == (gen + 1u) * nloc) {
            __builtin_amdgcn_fence(__ATOMIC_RELEASE, "agent");
            asm volatile("s_waitcnt vmcnt(0)" ::: "memory");
            const unsigned og = xb_add(&bar[XB_TOP], 1u);
            const unsigned tg = og / nx;
            if (og + 1u == (tg + 1u) * nx) xb_add(&bar[XB_TOPGEN], 1u);
            else XB_SPIN(xb_ld(&bar[XB_TOPGEN]) == tg, bar);
            __builtin_amdgcn_fence(__ATOMIC_ACQUIRE, "agent");
            xb_add(&bar[XB_XGEN(b.x)], 1u);
            asm volatile("s_waitcnt vmcnt(0)" ::: "memory");
        } else {
            XB_SPIN(xb_ld(&bar[XB_XGEN(b.x)]) == gen, bar);
            __builtin_amdgcn_fence(__ATOMIC_ACQUIRE, "agent");
            asm volatile("s_waitcnt vmcnt(0)" ::: "memory");
        }
    }
    __syncthreads();
}
typedef float f32x2v __attribute__((ext_vector_type(2)));
typedef pg8::u32x4 u32x4;
typedef unsigned u32x2v __attribute__((ext_vector_type(2)));
typedef unsigned short bf16x8us __attribute__((ext_vector_type(8)));
__device__ __forceinline__ unsigned cvtpk(float lo, float hi) { unsigned r; asm volatile("v_cvt_pk_bf16_f32 %0, %1, %2" : "=v"(r) : "v"(lo), "v"(hi)); return r; }
__device__ __forceinline__ float bf2f(unsigned short b) { return __builtin_bit_cast(float, (unsigned)b << 16); }
__device__ __forceinline__ float bflo(unsigned w) { return __builtin_bit_cast(float, w << 16); }
__device__ __forceinline__ float bfhi(unsigned w) { return __builtin_bit_cast(float, w & 0xffff0000u); }
__device__ __forceinline__ float wave_sum(float v) {
#pragma unroll
    for (int o = 1; o < 64; o <<= 1) v += __shfl_xor(v, o);
    return v;
}
struct Ctx { LAS unsigned char* lds; int tid, lane, wave, vcu, G; };

struct P0Item { const float* W; const float* gsc; bf16* WT; int K, N, item; };
__device__ __forceinline__ void p0_item_load(const P0Item& I, int lane, f32x4 (&v)[8]) {
    const int nblk = I.N / 32, kb = I.item / nblk, nb = I.item % nblk, k0 = 64 * kb, n0 = 32 * nb, kr = lane >> 3, c4 = (lane & 7) * 4;
#pragma unroll
    for (int i = 0; i < 8; ++i) v[i] = *(const f32x4*)(I.W + (size_t)(k0 + 8 * i + kr) * I.N + n0 + c4);
}
__device__ __forceinline__ void p0_item_store(const P0Item& I, int lane, f32x4 (&v)[8], LAS float* scr) {
    const int nblk = I.N / 32, kb = I.item / nblk, nb = I.item % nblk, k0 = 64 * kb, n0 = 32 * nb, kr = lane >> 3, c4 = (lane & 7) * 4;
    if (I.gsc) {
#pragma unroll
        for (int i = 0; i < 8; ++i) v[i] = v[i] * I.gsc[k0 + 8 * i + kr]; }
#pragma unroll
    for (int i = 0; i < 8; ++i) { LAS float* d = scr + (8 * i + kr) * 33 + c4; d[0] = v[i][0]; d[1] = v[i][1]; d[2] = v[i][2]; d[3] = v[i][3]; }
    LDS_WAIT(); asm volatile("" ::: "memory");
    const int c = lane & 7;
#pragma unroll
    for (int j = 0; j < 4; ++j) { const int n = (lane >> 3) + 8 * j; const LAS float* s = scr + (8 * c) * 33 + n;
        v4u o; o.x = cvtpk(s[0 * 33], s[1 * 33]); o.y = cvtpk(s[2 * 33], s[3 * 33]); o.z = cvtpk(s[4 * 33], s[5 * 33]); o.w = cvtpk(s[6 * 33], s[7 * 33]);
        *(v4u*)(I.WT + (size_t)(n0 + n) * I.K + k0 + 8 * c) = o; }
    LDS_WAIT(); asm volatile("" ::: "memory");
}
struct P0Args { const float *x, *mixg, *mlpg, *w_in, *w_s, *w_outa, *w_qkv, *w_outb, *relb, *w_up, *w_dn; unsigned char* ws; };
__device__ __forceinline__ P0Item p0_item(const P0Args& A, int it) {
    constexpr int I0 = (D / 64) * (2 * D / 32), I1 = (D / 64) * (D / 32), I2 = (D / 64) * (NQKV / 32), I3 = (AW / 64) * (D / 32), I4 = (D / 64) * (FF / 32), I6 = (FF / 64) * (D / 32);
    unsigned char* ws = A.ws; int r = it;
    if (r < I0) return P0Item{A.w_in, A.mixg, (bf16*)(ws + WS_WIN), D, 2 * D, r}; r -= I0;
    if (r < I1) return P0Item{A.w_outa, nullptr, (bf16*)(ws + WS_WOA), D, D, r}; r -= I1;
    if (r < I2) return P0Item{A.w_qkv, A.mixg + D, (bf16*)(ws + WS_WQKV), D, NQKV, r}; r -= I2;
    if (r < I3) return P0Item{A.w_outb, nullptr, (bf16*)(ws + WS_WOB), AW, D, r}; r -= I3;
    if (r < I4) return P0Item{A.w_up, A.mlpg, (bf16*)(ws + WS_WUP), D, FF, r}; r -= I4;
    if (r < I4) return P0Item{A.w_up + (size_t)D * FF, A.mlpg + D, (bf16*)(ws + WS_WUP + 8 * MiB), D, FF, r}; r -= I4;
    if (r < I6) return P0Item{A.w_dn, nullptr, (bf16*)(ws + WS_WDN), FF, D, r}; r -= I6;
    return P0Item{A.w_dn + (size_t)FF * D, nullptr, (bf16*)(ws + WS_WDN + 8 * MiB), FF, D, r};
}
constexpr int P0_I_IN = (D / 64) * (2 * D / 32), P0_I_OA = (D / 64) * (D / 32), P0_I_QKV = (D / 64) * (NQKV / 32), P0_I_OB = (AW / 64) * (D / 32), P0_I_UP = (D / 64) * (FF / 32), P0_I_DN = (FF / 64) * (D / 32);
constexpr int P0_AT_OA = P0_I_IN, P0_AT_UP0 = P0_AT_OA + P0_I_OA + P0_I_QKV + P0_I_OB, P0_AT_UP1 = P0_AT_UP0 + P0_I_UP, P0_AT_DN0 = P0_AT_UP1 + P0_I_UP, P0_AT_DN1 = P0_AT_DN0 + P0_I_DN;
__device__ __forceinline__ void p0_items(const Ctx& C, const P0Args& A, int widx, int wcnt, int a0, int n0, int a1, int n1) {
    LAS float* scr = (LAS float*)(C.lds + RING_OFF + C.wave * 16384);
    const int n = n0 + n1;
#define P0_MAP(j_) ((j_) < n0 ? a0 + (j_) : a1 + ((j_) - n0))
    if (widx < n) {
        f32x4 va[8], vb[8]; P0Item ia = p0_item(A, P0_MAP(widx)); p0_item_load(ia, C.lane, va);
        for (int it = widx; it < n; it += 2 * wcnt) {
            const bool hb = it + wcnt < n; P0Item ib = ia; if (hb) { ib = p0_item(A, P0_MAP(it + wcnt)); p0_item_load(ib, C.lane, vb); }
            p0_item_store(ia, C.lane, va, scr);
            const bool ha = it + 2 * wcnt < n; if (ha) { ia = p0_item(A, P0_MAP(it + 2 * wcnt)); p0_item_load(ia, C.lane, va); }
            if (hb) p0_item_store(ib, C.lane, vb, scr);
        }
    }
#undef P0_MAP
}
__device__ __forceinline__ void p0_prologue(const Ctx& C, const P0Args& A) {
    const int gw = C.vcu * NWAVES + C.wave, NGW = C.G * NWAVES;
    unsigned char* ws = A.ws;
    p0_items(C, A, gw, NGW, 0, P0_I_IN, 0, 0);
    const int gt = (C.vcu * NWAVES + C.wave) * 64 + C.lane, NGT = NGW * 64;
    { bf16* wst = (bf16*)(ws + WS_WST);
      for (int i = gt; i < NGRP * CHUNK * CHUNK; i += NGT) { const int t = (i >> 7) & 127, s = i & 127; const float w = (s <= t) ? A.w_s[i] : 0.f; wst[i] = (bf16)(cvtpk(w, 0.f) & 0xffffu); } }
    { float* lut = (float*)(ws + WS_LUT);
      for (int i = gt; i < 24 * LUT_N; i += NGT) { const int gh = i / LUT_N, idx = i % LUT_N, g = gh >> 3, rel = idx - 16; float v = 0.f;
          if (rel >= 0 && rel <= 128) { const int dil = (g == 0) ? 1 : (g == 1) ? 4 : 16; const int dist = rel * dil; int bucket;
              if (dist < 16) bucket = dist; else { const float nf = (float)dist; int lg = 16 + (int)(logf(nf / 16.0f) / 4.852030263919617f * 16.0f); bucket = lg < 31 ? lg : 31; }
              v = A.relb[bucket * 24 + gh] * LOG2E; }
          lut[i] = v; } }
    { bf16* xn = (bf16*)(ws + WS_XN); float* ssq = (float*)(ws + WS_SSQ);
      f32x4 v0[4], v1[4];
      if (gw < M) {
#pragma unroll
          for (int j = 0; j < 4; ++j) v0[j] = ((const f32x4*)(A.x + (size_t)gw * D) + C.lane)[64 * j]; }
#define P0_ROW(m_, v_) do { float s_ = 0.f; _Pragma("unroll") for (int j = 0; j < 4; ++j) s_ += (v_[j][0] * v_[j][0] + v_[j][1] * v_[j][1]) + (v_[j][2] * v_[j][2] + v_[j][3] * v_[j][3]); \
          u32x2v* o_ = (u32x2v*)(xn + (size_t)(m_) * D) + C.lane; _Pragma("unroll") for (int j = 0; j < 4; ++j) o_[64 * j] = (u32x2v){cvtpk(v_[j][0], v_[j][1]), cvtpk(v_[j][2], v_[j][3])}; \
          s_ = wave_sum(s_); if (C.lane < 16) ssq[(size_t)(m_) * 16 + C.lane] = (C.lane == 0) ? s_ : 0.f; } while (0)
      for (int m = gw; m < M; m += 2 * NGW) {
          const bool hb = m + NGW < M;
          if (hb) {
#pragma unroll
              for (int j = 0; j < 4; ++j) v1[j] = ((const f32x4*)(A.x + (size_t)(m + NGW) * D) + C.lane)[64 * j]; }
          P0_ROW(m, v0);
          if (m + 2 * NGW < M) {
#pragma unroll
              for (int j = 0; j < 4; ++j) v0[j] = ((const f32x4*)(A.x + (size_t)(m + 2 * NGW) * D) + C.lane)[64 * j]; }
          if (hb) P0_ROW(m + NGW, v1);
      }
#undef P0_ROW
    }
}

constexpr int G_VT = 0, G_WS = 32768, G_BS = G_WS + 128 * 136 * 2, G_BUF = G_BS + 512, G_STAT = 2 * G_BUF, G_LN = G_STAT + 1024;
static_assert(G_LN + 12288 <= LDSCTL_OFF, "gating LDS map");
__device__ __forceinline__ int vt_off(int c, int s) { return c * 128 + ((((s >> 3) ^ (c & 7) ^ ((c >> 3) & 15)) & 15) << 3) + (s & 7); }
__device__ __forceinline__ void p2_gating(const Ctx& C, int chunk0, unsigned char* big, const float* vst, const bf16* wst, const float* lng, const float* lnb, const float* bs) {
    LAS f32x2v* STAT = (LAS f32x2v*)(C.lds + G_STAT); LAS float* LNP = (LAS float*)(C.lds + G_LN);
    const int tid = C.tid, lane = C.lane, w = C.wave, r16 = lane & 15, qq = lane >> 4;
    const int cc = tid & 15;
    for (int chunk = chunk0; chunk < chunk0 + 1; ++chunk) {
        const size_t tok0 = (size_t)chunk * CHUNK;
        const bf16* UVc = (const bf16*)(big + (size_t)(chunk >> 1) * BLK) + (size_t)(chunk & 1) * CHUNK * (2 * D);
        bf16* UGc = (bf16*)(big + (size_t)(chunk >> 1) * BLK + BLK_UG) + (size_t)(chunk & 1) * CHUNK * D;
        __syncthreads();
        { const int row = tid >> 2, part = tid & 3; const f32x4* pp = (const f32x4*)(vst + ((tok0 + row) * 16 + part * 4) * 2);
          const f32x4 a = pp[0], b = pp[1]; float s1 = (a[0] + a[2]) + (b[0] + b[2]), s2 = (a[1] + a[3]) + (b[1] + b[3]);
          s1 += __shfl_xor(s1, 1); s1 += __shfl_xor(s1, 2); s2 += __shfl_xor(s2, 1); s2 += __shfl_xor(s2, 2);
          const float mean = s1 * (1.0f / 1024.0f), var = s2 * (1.0f / 1024.0f) - mean * mean;
          if (part == 0) STAT[row] = (f32x2v){mean, __builtin_amdgcn_rsqf(fmaxf(var, 0.f) + EPS)}; }
        { *(LAS f32x2v*)(LNP + tid * 2) = *(const f32x2v*)(lng + tid * 2); *(LAS f32x2v*)(LNP + 1024 + tid * 2) = *(const f32x2v*)(lnb + tid * 2); *(LAS f32x2v*)(LNP + 2048 + tid * 2) = *(const f32x2v*)(bs + tid * 2); }
        v4u vraw[2][4], wraw[4]; u32x2v uu[2][8];
#define P2_LOADW(g) do { _Pragma("unroll") for (int i = 0; i < 4; ++i) { const int id_ = tid + 512 * i; wraw[i] = *(const v4u*)(wst + (size_t)(g) * 16384 + (id_ >> 4) * 128 + (id_ & 15) * 8); } } while (0)
#define P2_LOADV(g, set) do { _Pragma("unroll") for (int i = 0; i < 4; ++i) vraw[set][i] = *(const v4u*)(UVc + (size_t)((tid >> 4) + 32 * i) * (2 * D) + D + (g) * 128 + cc * 8); } while (0)
#define P2_LOADU(g, set) do { _Pragma("unroll") for (int tt = 0; tt < 8; ++tt) uu[set][tt] = *(const u32x2v*)(UVc + (size_t)(16 * tt + r16) * (2 * D) + (g) * 128 + 16 * w + 4 * qq); } while (0)
#define P2_WRITE(g, buf, set) do { LAS bf16* VT_ = (LAS bf16*)(C.lds + (buf) * G_BUF + G_VT); LAS bf16* WS_ = (LAS bf16*)(C.lds + (buf) * G_BUF + G_WS); \
        const LAS f32x4* lp_ = (const LAS f32x4*)(LNP + (g) * 128 + cc * 8); const f32x4 g0 = lp_[0], g1 = lp_[1], b0 = lp_[256], b1 = lp_[257]; \
        _Pragma("unroll") for (int i = 0; i < 4; ++i) { const int s = (tid >> 4) + 32 * i; const f32x2v st = STAT[s]; const v4u raw = vraw[set][i]; \
            const float v[8] = {bflo(raw.x), bfhi(raw.x), bflo(raw.y), bfhi(raw.y), bflo(raw.z), bfhi(raw.z), bflo(raw.w), bfhi(raw.w)}; \
            _Pragma("unroll") for (int j = 0; j < 8; ++j) { const float gg = j < 4 ? g0[j & 3] : g1[j & 3], bb = j < 4 ? b0[j & 3] : b1[j & 3]; \
                const float y = (v[j] - st.x) * st.y * gg + bb; VT_[vt_off(cc * 8 + j, s)] = (bf16)(cvtpk(y, 0.f) & 0xffffu); } \
            const int id_ = tid + 512 * i; *(LAS v4u*)(WS_ + (id_ >> 4) * 136 + (id_ & 15) * 8) = wraw[i]; } } while (0)
        P2_LOADW(0); P2_LOADV(0, 0); P2_LOADV(1, 1); P2_LOADU(0, 0);
        __syncthreads();
        P2_WRITE(0, 0, 0);
        P2_LOADW(1); P2_LOADV(2, 0); P2_LOADU(1, 1);
        __syncthreads();
#define P2_BODY(g, PAR) do { \
            const LAS bf16* VT = (const LAS bf16*)(C.lds + (PAR) * G_BUF + G_VT); const LAS bf16* WS = (const LAS bf16*)(C.lds + (PAR) * G_BUF + G_WS); const LAS float* BS = LNP + 2048 + (g) * 128; \
              \
            bf16x8 xf[4]; \
            _Pragma("unroll") for (int ks = 0; ks < 4; ++ks) xf[ks] = *(const LAS bf16x8*)(VT + vt_off(16 * w + r16, 32 * ks + 8 * qq)); \
            _Pragma("unroll") for (int tt = 0; tt < 8; ++tt) { \
                f32x4 acc = (f32x4){0.f, 0.f, 0.f, 0.f}; \
                _Pragma("unroll") for (int ks = 0; ks <= tt / 2; ++ks) { const bf16x8 yf = *(const LAS bf16x8*)(WS + (16 * tt + r16) * 136 + 32 * ks + 8 * qq); \
                    acc = __builtin_amdgcn_mfma_f32_16x16x32_bf16(xf[ks], yf, acc, 0, 0, 0); } \
                const int t = 16 * tt + r16; const float bsv = BS[t]; const u32x2v uv_ = uu[PAR][tt]; \
                const float o0 = bflo(uv_.x) * (acc[0] + bsv), o1 = bfhi(uv_.x) * (acc[1] + bsv), o2 = bflo(uv_.y) * (acc[2] + bsv), o3 = bfhi(uv_.y) * (acc[3] + bsv); \
                *(u32x2v*)(UGc + (size_t)t * D + (g) * 128 + 16 * w + 4 * qq) = (u32x2v){cvtpk(o0, o1), cvtpk(o2, o3)}; \
            } \
            if ((g) + 1 < NGRP) P2_WRITE((g) + 1, (PAR) ^ 1, (PAR) ^ 1);        \
            if ((g) + 2 < NGRP) P2_LOADW((g) + 2); \
            if ((g) + 3 < NGRP) P2_LOADV((g) + 3, (PAR) ^ 1); \
            if ((g) + 2 < NGRP) P2_LOADU((g) + 2, PAR); \
            __syncthreads(); } while (0)
        for (int g = 0; g < NGRP; g += 2) { P2_BODY(g, 0); P2_BODY(g + 1, 1); }
#undef P2_BODY
#undef P2_LOADW
#undef P2_LOADV
#undef P2_LOADU
#undef P2_WRITE
    }
    __syncthreads();
}
constexpr int A_SLOT = 32768, A_VOFF = 16384, A_QOFF = 4 * A_SLOT, A_LUT = A_QOFF + 16384;
static_assert(A_LUT + 1024 <= LDSCTL_OFF, "attention LDS map");
constexpr int ATT_UNITS = 3 * BATCH * NH * 64;
typedef short v4i16_t __attribute__((ext_vector_type(4)));
__device__ __forceinline__ u32x2v tr16(const LAS bf16* p) { return __builtin_bit_cast(u32x2v, __builtin_amdgcn_ds_read_tr16_b64_v4i16((LAS v4i16_t*)p)); }
__device__ __forceinline__ float max3f(float a, float b, float c) { float r; asm("v_max3_f32 %0, %1, %2, %3" : "=v"(r) : "v"(a), "v"(b), "v"(c)); return r; }
struct AU { int g, b, h, r, n, dil; };
__device__ __forceinline__ AU att_decode(int U) { AU a; a.g = U >> 11; const int rem = U & 2047; a.b = rem >> 9; a.h = (rem >> 6) & 7; const int rn = rem & 63;
    a.dil = (a.g == 0) ? 1 : (a.g == 1) ? 4 : 16; const int nb = 64 / a.dil; a.r = rn / nb; a.n = rn % nb; return a; }
template <int VAR> __device__ __forceinline__ void p7_attention(const Ctx& C, bf16* QKV, float* lse, const float* lutg) {
    LAS unsigned char* L = C.lds; LAS float* LUT = (LAS float*)(L + A_LUT);
    const int tid = C.tid, lane = C.lane, w = C.wave, r16 = lane & 15, qq = lane >> 4;
    const int per = (ATT_UNITS + C.G - 1) / C.G;
    const int u_lo = C.vcu * per, u_hi = (u_lo + per < ATT_UNITS) ? u_lo + per : ATT_UNITS;
    if (u_lo >= u_hi) return;
#define ATT_SLICE(a, t) (QKV + ((size_t)((((t) * 3 + (a).g) * 8 + (a).h) * BATCH + (a).b) * SEQ + (size_t)(a).r * (SEQ / (a).dil)) * 64)
    const int drow = lane >> 3, dch = lane & 7;
#define ATT_GLDS(gsrc, ldsoff) do { unsigned keep_; const unsigned ldst_ = (unsigned)__builtin_amdgcn_readfirstlane((int)((unsigned)(uintptr_t)L + (unsigned)(ldsoff))); const bf16* gs_ = (gsrc); \
        asm volatile("s_mov_b32 %0, m0\n\ts_mov_b32 m0, %2\n\ts_nop 0\n\tglobal_load_lds_dwordx4 %1, off\n\ts_mov_b32 m0, %0" : "=&s"(keep_) : "v"(gs_), "s"(ldst_) : "memory"); } while (0)
#define ATT_DMA_BLOCK(a, nblk, slot) do { _Pragma("unroll") for (int j_ = 0; j_ < 2; ++j_) { const int row_ = 16 * w + 8 * j_ + drow; \
        const size_t go_ = (size_t)((nblk) * 128 + row_) * 64 + ((dch ^ ((row_ >> 1) & 7)) << 3); const int lo_ = (slot) * A_SLOT + (16 * w + 8 * j_) * 128; \
        ATT_GLDS(ATT_SLICE(a, 1) + go_, lo_); ATT_GLDS(ATT_SLICE(a, 2) + go_, lo_ + A_VOFF); } } while (0)
#define ATT_LDQ(a, q0, q1) do { const bf16* qp_ = ATT_SLICE(a, 0) + (size_t)((a).n * 128 + 16 * w + r16) * 64 + 8 * qq; \
        asm volatile("global_load_dwordx4 %0, %2, off\n\tglobal_load_dwordx4 %1, %2, off offset:64" : "=&v"(q0), "=&v"(q1) : "v"(qp_) : "memory"); } while (0)
#define ATT_WAITBAR_Q(N, q0, q1) do { asm volatile("s_waitcnt vmcnt(" #N ") lgkmcnt(0)" : "+v"(q0), "+v"(q1) :: "memory"); __builtin_amdgcn_s_barrier(); asm volatile("" ::: "memory"); } while (0)
#define ATT_WAITBAR(N) do { asm volatile("s_waitcnt vmcnt(" #N ") lgkmcnt(0)" ::: "memory"); __builtin_amdgcn_s_barrier(); asm volatile("" ::: "memory"); } while (0)
    AU cu = att_decode(u_lo);
    u32x4 qreg[2][2];
    {
      __builtin_amdgcn_s_waitcnt(0x0F70);
      __builtin_amdgcn_s_barrier();
      if (cu.n > 0) { ATT_DMA_BLOCK(cu, cu.n - 1, 3); }
      else { _Pragma("unroll") for (int i = 0; i < 4; ++i) *(LAS v4u*)(L + 3 * A_SLOT + (tid + 512 * i) * 16) = (v4u){0u, 0u, 0u, 0u};
             _Pragma("unroll") for (int j_ = 0; j_ < 4; ++j_) ATT_GLDS(ATT_SLICE(cu, 1) + (size_t)lane * 8, 2 * A_SLOT + (16 * w + 8 * (j_ & 1)) * 128 + (j_ >> 1) * A_VOFF); }
      ATT_DMA_BLOCK(cu, cu.n, 0);
      const AU n1 = att_decode(u_lo + 1 < u_hi ? u_lo + 1 : u_lo);
      ATT_LDQ(cu, qreg[0][0], qreg[0][1]); ATT_LDQ(n1, qreg[1][0], qreg[1][1]);
      ATT_DMA_BLOCK(n1, n1.n, 1);
      if (tid < LUT_N) LUT[tid] = lutg[(cu.g * 8 + cu.h) * LUT_N + tid];
      asm volatile("s_waitcnt vmcnt(4)" : "+v"(qreg[0][0]), "+v"(qreg[0][1]) :: "memory");
      ATT_WAITBAR_Q(4, qreg[1][0], qreg[1][1]); }
    for (int U0 = u_lo; U0 < u_hi; U0 += 2) {
#pragma unroll
      for (int par = 0; par < 2; ++par) {
        const int U = U0 + par; if (U >= u_hi) break;
        const int ui = U - u_lo;
        const AU nx = att_decode(U + 1 < u_hi ? U + 1 : U), nx2 = att_decode(U + 2 < u_hi ? U + 2 : U);
        const int pbase = ((ui + 3) & 3) * A_SLOT, cbase = (ui & 3) * A_SLOT;
        const bf16x8 qf[2] = {__builtin_bit_cast(bf16x8, qreg[par][0]), __builtin_bit_cast(bf16x8, qreg[par][1])};
        if constexpr (VAR < 3) {
        ATT_DMA_BLOCK(nx2, nx2.n, (ui + 2) & 3);
        }
        f32x4 o[4]; float mx = 0.f, lsum = 1.f;
        if constexpr (VAR == 2) { _Pragma("unroll") for (int dt = 0; dt < 4; ++dt) { o[dt] = (f32x4){qf[0][0] * 1.0f, 0.f, 0.f, 0.f}; } } else {
        f32x4 s[9];
#pragma unroll
        for (int kt = 0; kt < 9; ++kt) { const int kk0 = 16 * w + 16 * kt, row = (kk0 & 127) + r16, sw = (row >> 1) & 7;
            const LAS unsigned char* kp = L + (kk0 < 128 ? pbase : cbase) + row * 128;
            const bf16x8 k0 = *(const LAS bf16x8*)(kp + ((qq ^ sw) << 4)), k1 = *(const LAS bf16x8*)(kp + (((qq + 4) ^ sw) << 4));
            f32x4 a = (f32x4){0.f, 0.f, 0.f, 0.f};
            a = __builtin_amdgcn_mfma_f32_16x16x32_bf16(k0, qf[0], a, 0, 0, 0);
            a = __builtin_amdgcn_mfma_f32_16x16x32_bf16(k1, qf[1], a, 0, 0, 0); s[kt] = a; }
        if constexpr (VAR < 3) { ATT_LDQ(nx2, qreg[par][0], qreg[par][1]); }
        const float SC = 0.125f * LOG2E, NEG = -1e30f;
        const LAS float* lp = LUT + (144 + r16 - 4 * qq);
#pragma unroll
        for (int kt = 0; kt < 9; ++kt)
#pragma unroll
            for (int j = 0; j < 4; ++j) { float t = s[kt][j] * SC + lp[-(16 * kt + j)];
                if (kt == 0) t = (4 * qq + j >= r16) ? t : NEG;
                if (kt == 8) t = (4 * qq + j <= r16) ? t : NEG;
                s[kt][j] = t; }
        if (cu.n == 0) {
#pragma unroll
            for (int kt = 0; kt < 8; ++kt) if (kt < 8 - w) { s[kt] = (f32x4){NEG, NEG, NEG, NEG}; asm volatile("" : "+v"(s[kt])); } }
        { float a_ = max3f(s[0][0], s[0][1], s[0][2]), b_ = max3f(s[0][3], s[1][0], s[1][1]);
#pragma unroll
          for (int kt = 1; kt < 9; ++kt) { if (kt & 1) { a_ = max3f(a_, s[kt][2], s[kt][3]); if (kt + 1 < 9) b_ = max3f(b_, s[kt + 1][0], s[kt + 1][1]); }
                                           else { a_ = max3f(a_, s[kt][2], s[kt][3]); if (kt + 1 < 9) b_ = max3f(b_, s[kt + 1][0], s[kt + 1][1]); } }
          mx = fmaxf(a_, b_); }
        mx = fmaxf(mx, __shfl_xor(mx, 16)); mx = fmaxf(mx, __shfl_xor(mx, 32));
#pragma unroll
        for (int kt = 0; kt < 9; ++kt)
#pragma unroll
            for (int j = 0; j < 4; ++j) s[kt][j] = __builtin_amdgcn_exp2f(s[kt][j] - mx);
        f32x4 osum = (f32x4){0.f, 0.f, 0.f, 0.f};
        const bf16x8 ones = (bf16x8){0x3F80, 0x3F80, 0x3F80, 0x3F80, 0x3F80, 0x3F80, 0x3F80, 0x3F80};
        const int vrow = 4 * qq + (r16 >> 2), vc = (r16 & 3) >> 1, vh = (r16 & 1) * 8;
#pragma unroll
        for (int dt = 0; dt < 4; ++dt) o[dt] = (f32x4){0.f, 0.f, 0.f, 0.f};
#pragma unroll
        for (int ks = 0; ks < 5; ++ks) {
            u32x4 pw; pw.x = cvtpk(s[2 * ks][0], s[2 * ks][1]); pw.y = cvtpk(s[2 * ks][2], s[2 * ks][3]);
            if (ks < 4) { pw.z = cvtpk(s[2 * ks + 1][0], s[2 * ks + 1][1]); pw.w = cvtpk(s[2 * ks + 1][2], s[2 * ks + 1][3]); } else { pw.z = 0u; pw.w = 0u; }
            const bf16x8 pf = __builtin_bit_cast(bf16x8, pw);
            osum = __builtin_amdgcn_mfma_f32_16x16x32_bf16(ones, pf, osum, 0, 0, 0);
            const int ka = 16 * w + 32 * ks, kb = ka + 16;
            const int rowa = (ka & 127) + vrow, rowb = (kb & 127) + vrow, swa = (rowa >> 1) & 7, swb = (rowb >> 1) & 7;
            const LAS unsigned char* pa = L + (ka < 128 ? pbase : cbase) + A_VOFF + rowa * 128 + vh; const LAS unsigned char* pb = L + (kb < 128 ? pbase : cbase) + A_VOFF + rowb * 128 + vh;
#pragma unroll
            for (int dt = 0; dt < 4; ++dt) {
                const u32x2v lo = tr16((const LAS bf16*)(pa + (((2 * dt + vc) ^ swa) << 4)));
                u32x2v hi = (u32x2v){0u, 0u}; if (ks < 4) hi = tr16((const LAS bf16*)(pb + (((2 * dt + vc) ^ swb) << 4)));
                const u32x4 vw = (u32x4){lo.x, lo.y, hi.x, hi.y};
                o[dt] = __builtin_amdgcn_mfma_f32_16x16x32_bf16(__builtin_bit_cast(bf16x8, vw), pf, o[dt], 0, 0, 0); } }
        lsum = osum[0]; }
        const float inv = 1.0f / lsum;
        bf16* op = ATT_SLICE(cu, 0) + (size_t)(cu.n * 128 + 16 * w + r16) * 64 + 4 * qq;
        if constexpr (VAR == 4) { asm volatile("" :: "v"(o[0]), "v"(o[1]), "v"(o[2]), "v"(o[3]), "v"(inv), "v"(mx)); } else {
#pragma unroll
        for (int dt = 0; dt < 4; ++dt)
            *(u32x2v*)(op + 16 * dt) = (u32x2v){cvtpk(o[dt][0] * inv, o[dt][1] * inv), cvtpk(o[dt][2] * inv, o[dt][3] * inv)};
        }
        if (VAR != 4 && qq == 0) lse[((size_t)cu.g * M + (size_t)cu.b * SEQ + (size_t)((cu.n * 128 + 16 * w + r16) * cu.dil + cu.r)) * NH + cu.h] = mx + log2f(lsum);
        if ((nx.g * 8 + nx.h) != (cu.g * 8 + cu.h)) {
            ATT_WAITBAR_Q(11, qreg[par ^ 1][0], qreg[par ^ 1][1]); if (tid < LUT_N) LUT[tid] = lutg[(nx.g * 8 + nx.h) * LUT_N + tid]; ATT_WAITBAR(0); }
        else ATT_WAITBAR_Q(11, qreg[par ^ 1][0], qreg[par ^ 1][1]);
        cu = nx;
      }
    }
    ATT_WAITBAR(0);
#undef ATT_SLICE
#undef ATT_GLDS
#undef ATT_DMA_BLOCK
#undef ATT_LDQ
#undef ATT_WAITBAR_Q
#undef ATT_WAITBAR
}
__device__ __forceinline__ void p8_merge(const Ctx& C, int row_lo, const bf16* QKV, const float* lse, bf16* OM) {
    for (int idx = row_lo * 64 + C.tid; idx < (row_lo + 128) * 64; idx += NWAVES * 64) { const int tok = idx >> 6, cch = idx & 63, h = cch >> 3;
        const float l0 = lse[((size_t)0 * M + tok) * NH + h], l1 = lse[((size_t)1 * M + tok) * NH + h], l2 = lse[((size_t)2 * M + tok) * NH + h];
        const float mx = fmaxf(l0, fmaxf(l1, l2)); float w0 = __builtin_amdgcn_exp2f(l0 - mx), w1 = __builtin_amdgcn_exp2f(l1 - mx), w2 = __builtin_amdgcn_exp2f(l2 - mx);
        const float inv = 1.0f / (w0 + w1 + w2); w0 *= inv; w1 *= inv; w2 *= inv;
        const int b = tok >> 13, pos = tok & (SEQ - 1);
        const size_t hs = (size_t)BATCH * SEQ * 64;
        const bf16* base = QKV + ((size_t)b * SEQ) * 64 + (cch & 7) * 8;
        const v4u a = *(const v4u*)(base + (size_t)(0 * 8 + h) * hs + (size_t)pos * 64);
        const v4u bb = *(const v4u*)(base + (size_t)(1 * 8 + h) * hs + ((size_t)(pos & 3) * (SEQ / 4) + (pos >> 2)) * 64);
        const v4u c = *(const v4u*)(base + (size_t)(2 * 8 + h) * hs + ((size_t)(pos & 15) * (SEQ / 16) + (pos >> 4)) * 64);
        v4u o;
        o.x = cvtpk(w0 * bflo(a.x) + w1 * bflo(bb.x) + w2 * bflo(c.x), w0 * bfhi(a.x) + w1 * bfhi(bb.x) + w2 * bfhi(c.x));
        o.y = cvtpk(w0 * bflo(a.y) + w1 * bflo(bb.y) + w2 * bflo(c.y), w0 * bfhi(a.y) + w1 * bfhi(bb.y) + w2 * bfhi(c.y));
        o.z = cvtpk(w0 * bflo(a.z) + w1 * bflo(bb.z) + w2 * bflo(c.z), w0 * bfhi(a.z) + w1 * bfhi(bb.z) + w2 * bfhi(c.z));
        o.w = cvtpk(w0 * bflo(a.w) + w1 * bflo(bb.w) + w2 * bflo(c.w), w0 * bfhi(a.w) + w1 * bfhi(bb.w) + w2 * bfhi(c.w));
        *(v4u*)(OM + (size_t)tok * AW + cch * 8) = o; }
}
__device__ __forceinline__ void p12_final(const Ctx& C, int row_lo, const bf16* hb, float* out, const float* ssq, const float* gfin) {
    f32x4 gv[4];
#pragma unroll
    for (int j = 0; j < 4; ++j) gv[j] = ((const f32x4*)gfin)[C.lane + 64 * j];
    for (int m = row_lo + C.wave; m < row_lo + 128; m += NWAVES) {
        float s = ssq[(size_t)m * 16 + (C.lane & 15)];
        const u32x2v* hr = (const u32x2v*)(hb + (size_t)m * D) + C.lane; u32x2v v[4];
#pragma unroll
        for (int j = 0; j < 4; ++j) v[j] = hr[64 * j];
        s += __shfl_xor(s, 1); s += __shfl_xor(s, 2); s += __shfl_xor(s, 4); s += __shfl_xor(s, 8);
        const float rs = __builtin_amdgcn_rsqf(s * (1.0f / 1024.0f) + EPS);
        f32x4* xr = (f32x4*)(out + (size_t)m * D) + C.lane;
#pragma unroll
        for (int j = 0; j < 4; ++j) xr[64 * j] = (f32x4){bflo(v[j].x), bfhi(v[j].x), bflo(v[j].y), bfhi(v[j].y)} * rs * gv[j]; }
}
__device__ __forceinline__ void gate_arrive(unsigned* cnt) { if (threadIdx.x == 0) (void)__hip_atomic_fetch_add(cnt, 1u, __ATOMIC_RELAXED, __HIP_MEMORY_SCOPE_AGENT); }
struct GrpBar { unsigned* cnt; unsigned phase; unsigned same; };
__device__ __forceinline__ void grp_barrier(GrpBar& b) {
    asm volatile("s_waitcnt vmcnt(0)" ::: "memory");
    __syncthreads();
    if (threadIdx.x == 0) {
        if (!b.same) { __builtin_amdgcn_fence(__ATOMIC_RELEASE, "agent"); asm volatile("s_waitcnt vmcnt(0)" ::: "memory"); }
        const unsigned target = (b.phase + 1u) * 4u;
        (void)__hip_atomic_fetch_add(b.cnt, 1u, __ATOMIC_RELAXED, __HIP_MEMORY_SCOPE_AGENT);
        unsigned sp = 0u;
        while (__hip_atomic_load(b.cnt, __ATOMIC_RELAXED, __HIP_MEMORY_SCOPE_AGENT) < target) { __builtin_amdgcn_s_sleep(1); if (++sp > (1u << 22)) break; }
        __builtin_amdgcn_fence(__ATOMIC_ACQUIRE, "agent"); asm volatile("s_waitcnt vmcnt(0)" ::: "memory");
    }
    __syncthreads();
    ++b.phase;
}
namespace pg8 {
struct EpiFinal {
    static constexpr bool PERM = true, AFTER_DRAIN = false;
    const bf16_t* hb; float* out; float* ssq; const float* gfin; int ldc; GrpBar* gb;
    __device__ __forceinline__ void operator()(f32x4 (&acc)[2][2][4][2], const Unit& u, int wr, int wc, int fr, int fq) const {
        const int row0 = u.pm * BM + wr * 64 + fr, col0 = u.pn * BM + wc * 32 + 8 * fq;
        { u32x4 r[2][4][2];
#pragma unroll
          for (int ai = 0; ai < 2; ++ai)
#pragma unroll
              for (int m = 0; m < 4; ++m)
#pragma unroll
                  for (int bj = 0; bj < 2; ++bj) r[ai][m][bj] = *(const u32x4*)(hb + (size_t)(row0 + ai * HALF + m * 16) * ldc + col0 + bj * HALF);
          asm volatile("s_waitcnt vmcnt(0)" ::: "memory");
#pragma unroll
          for (int ai = 0; ai < 2; ++ai)
#pragma unroll
              for (int m = 0; m < 4; ++m) { float q = 0.f;
#pragma unroll
                  for (int bj = 0; bj < 2; ++bj) { const u32x4 rr = r[ai][m][bj];
                      acc[ai][bj][m][0] += (f32x4){bf_lo(rr.x), bf_hi(rr.x), bf_lo(rr.y), bf_hi(rr.y)}; acc[ai][bj][m][1] += (f32x4){bf_lo(rr.z), bf_hi(rr.z), bf_lo(rr.w), bf_hi(rr.w)};
                      const f32x4 h0 = acc[ai][bj][m][0], h1 = acc[ai][bj][m][1];
                      q += ((h0[0] * h0[0] + h0[1] * h0[1]) + (h0[2] * h0[2] + h0[3] * h0[3])) + ((h1[0] * h1[0] + h1[1] * h1[1]) + (h1[2] * h1[2] + h1[3] * h1[3])); }
                  q += __shfl_xor(q, 16); q += __shfl_xor(q, 32);
                  if (fq == 0) ssq[(size_t)(row0 + ai * HALF + m * 16) * 16 + u.pn * 4 + wc] = q; } }
        f32x4 gv[2][2];
#pragma unroll
        for (int bj = 0; bj < 2; ++bj)
#pragma unroll
            for (int n = 0; n < 2; ++n) gv[bj][n] = *(const f32x4*)(gfin + col0 + bj * HALF + 4 * n);
        grp_barrier(*gb);
        f32x4 p[2][4];
#pragma unroll
        for (int ai = 0; ai < 2; ++ai)
#pragma unroll
            for (int m = 0; m < 4; ++m) p[ai][m] = *(const f32x4*)(ssq + (size_t)(row0 + ai * HALF + m * 16) * 16 + fq * 4);
#pragma unroll
        for (int ai = 0; ai < 2; ++ai)
#pragma unroll
            for (int m = 0; m < 4; ++m) { float s = (p[ai][m][0] + p[ai][m][1]) + (p[ai][m][2] + p[ai][m][3]);
                s += __shfl_xor(s, 16); s += __shfl_xor(s, 32);
                const float rs = __builtin_amdgcn_rsqf(s * (1.0f / 1024.0f) + 1e-6f);
                float* orow = out + (size_t)(row0 + ai * HALF + m * 16) * ldc + col0;
#pragma unroll
                for (int bj = 0; bj < 2; ++bj) { *(f32x4*)(orow + bj * HALF) = acc[ai][bj][m][0] * rs * gv[bj][0]; *(f32x4*)(orow + bj * HALF + 4) = acc[ai][bj][m][1] * rs * gv[bj][1]; } }
    }
};
}
struct Args { const float* in[15]; float* out; unsigned char* ws; int ph_lo, ph_hi; };
__global__ void __launch_bounds__(NWAVES * 64, 2) trunk_fwd(Args args) {
    extern __shared__ __attribute__((aligned(16))) unsigned char lds[];
    Ctx C;
    C.lds = (LAS unsigned char*)lds;
    volatile LAS unsigned* MISC = (volatile LAS unsigned*)(C.lds + MISC_OFF);
    C.tid = threadIdx.x; C.lane = C.tid & 63; C.wave = __builtin_amdgcn_readfirstlane(C.tid >> 6);
    C.G = gridDim.x; { const int bx = blockIdx.x; C.vcu = (C.G % 8 == 0) ? (bx % 8) * (C.G / 8) + bx / 8 : bx; }
    const int gx = (int)blockIdx.x % 8, k8 = ((int)blockIdx.x / 8) % 8, gz = (int)blockIdx.x / 64;
    const int item_row = (16 * gx + 8 * (gz >> 1) + k8) * 256 + (gz & 1) * 128;
    unsigned char* ws = args.ws;
    gu32* ctl = (gu32*)(ws + WS_CTL);
    if (C.tid == 0 && !MK_SPLIT) __hip_atomic_store((unsigned*)(ctl + CW_XCC) + blockIdx.x, xb_xcc_id() + 1u, __ATOMIC_RELAXED, __HIP_MEMORY_SCOPE_AGENT);
    unsigned* gate5 = (unsigned*)(ctl + CW_GATE); unsigned* gate8 = (unsigned*)(ctl + CW_GATE + 64);
    GrpBar gbr; gbr.cnt = (unsigned*)(ctl + CW_GRP) + (gx * 8 + k8) * 64; gbr.phase = 0u; gbr.same = 0u;
    const int cls = (gx >> 1) & 1, cwave = ((gz * 8 + k8) * 4 + ((gx & 1) | ((gx >> 2) << 1))) * NWAVES + C.wave;
    unsigned* s1cnt = (unsigned*)(ctl + CW_GATE + 128);
    for (int u = C.tid; u < (LDS_BYTES - LDSCTL_OFF) / 4; u += NWAVES * 64) ((LAS unsigned*)(C.lds + LDSCTL_OFF))[u] = 0u;
    __syncthreads();
    XcdBarrier bar; bar.bar = (unsigned*)(ctl + CW_BAR); bar.x = 0; bar.st = nullptr;
    if (!MK_SPLIT) bar = xcd_barrier_post((unsigned*)(ctl + CW_BAR), MISC + 8);
    const float* x = args.in[0]; const float* mixg = args.in[1]; const float* mlpg = args.in[2]; const float* fing = args.in[3];
    bf16* XN = (bf16*)(ws + WS_XN); unsigned char* big = ws + WS_BIG; bf16* OM = (bf16*)(ws + WS_OM);
    float* SSQ = (float*)(ws + WS_SSQ); float* VST = (float*)(ws + WS_VST); float* LSE = (float*)(ws + WS_LSE);
    float* out = args.out;
    const int lo = args.ph_lo, hi = args.ph_hi; int pos = 0;
#define GSTEP(BODY) do { if (lo <= pos && pos < hi) { BODY } if (lo <= pos && pos + 1 < hi) { for (int rb_ = 0; rb_ < BAR_REPS; ++rb_) xcd_barrier(bar); } ++pos; } while (0)
#define CSTEP(BODY) do { if (lo <= pos && pos < hi) { BODY } if (lo <= pos && pos + 1 < hi) { for (int rb_ = 0; rb_ < BAR_REPS; ++rb_) grp_barrier(gbr); } ++pos; } while (0)
#define STEP(BODY) do { if (lo <= pos && pos < hi) { BODY } if (lo <= pos && pos + 1 < hi) { for (int rb_ = 0; rb_ < BAR_REPS; ++rb_) xcd_barrier(bar); } ++pos; } while (0)
#define P0ARGS P0Args{x, mixg, mlpg, args.in[4], args.in[7], args.in[9], args.in[10], args.in[11], args.in[12], args.in[13], args.in[14], ws}
#define PH0 { const P0Args A = P0ARGS; p0_prologue(C, A); }
#define PH1 { pg8::Gemm g{XN, (const bf16*)(ws + WS_WIN), M, 2 * D, D, (size_t)256 * D * 2}; pg8::StaticOrder S; S.init(M, 2 * D, C.G, (int)blockIdx.x); pg8::EpiAct<1> E{(bf16*)big, 2 * D, BLK / 2, pg8::RsTable{SSQ, (LAS float*)(C.lds + RSTAB_OFF), -1}, VST, pg8::GateW{nullptr, 0u, 0}}; \
        pg8::gemm_phase<pg8::EpiAct<1>, pg8::StaticOrder, true, true>(C.lds + RING_OFF, g, S, E); }
#define PH2 { p2_gating(C, item_row / CHUNK, big, VST, (const bf16*)(ws + WS_WST), args.in[5], args.in[6], args.in[8]); }
#define S1WAIT { if (C.tid == 0) { unsigned sp = 0u; while (__hip_atomic_load(s1cnt, __ATOMIC_RELAXED, __HIP_MEMORY_SCOPE_AGENT) < 128u) { __builtin_amdgcn_s_sleep(2); if (++sp > (1u << 22)) break; } \
        __builtin_amdgcn_fence(__ATOMIC_ACQUIRE, "agent"); asm volatile("s_waitcnt vmcnt(0)" ::: "memory"); } __syncthreads(); }
#define PH3 { S1WAIT pg8::Gemm g{(const bf16*)(big + BLK_UG), (const bf16*)(ws + WS_WOA), M, D, D, BLK}; pg8::StaticOrder S; S.init(M, D, C.G, (int)blockIdx.x); pg8::EpiRes E{XN, SSQ, D}; \
        pg8::gemm_phase<pg8::EpiRes, pg8::StaticOrder, true, true>(C.lds + RING_OFF, g, S, E); }
#define PHUP(L) { pg8::Gemm g{XN, (const bf16*)(ws + WS_WUP + (L) * 8 * MiB), M, FF, D, (size_t)256 * D * 2}; pg8::StaticOrder S; S.init(M, FF, C.G, (int)blockIdx.x); S.columns_descending(); pg8::EpiAct<2> E{(bf16*)big, FF, BLK / 2, pg8::RsTable{SSQ, (LAS float*)(C.lds + RSTAB_OFF), -1}, nullptr, pg8::GateW{(L) ? gate8 : nullptr, (unsigned)C.G, 0}}; \
        pg8::gemm_phase<pg8::EpiAct<2>, pg8::StaticOrder, true, true>(C.lds + RING_OFF, g, S, E); }
#define PHDN(L) { pg8::Gemm g{(const bf16*)big, (const bf16*)(ws + WS_WDN + (L) * 8 * MiB), M, D, FF, BLK}; pg8::StaticOrder S; S.init(M, D, C.G, (int)blockIdx.x); S.reversed(); pg8::EpiRes E{XN, SSQ, D}; \
        pg8::gemm_phase<pg8::EpiRes, pg8::StaticOrder, true, true>(C.lds + RING_OFF, g, S, E); if ((L) == 0) gate_arrive(gate5); }
#define PHFIN { pg8::Gemm g{(const bf16*)big, (const bf16*)(ws + WS_WDN + 8 * MiB), M, D, FF, BLK}; pg8::StaticOrder S; S.init(M, D, C.G, (int)blockIdx.x); S.reversed(); pg8::EpiFinal E{XN, out, SSQ, fing, D, &gbr}; \
        pg8::gemm_phase<pg8::EpiFinal, pg8::StaticOrder, true, true>(C.lds + RING_OFF, g, S, E); }
#define PH6 { pg8::Gemm g{XN, (const bf16*)(ws + WS_WQKV), M, NQKV, D, (size_t)256 * D * 2}; pg8::StaticOrder S; S.init(M, NQKV, C.G, (int)blockIdx.x); pg8::EpiQKV E{(bf16*)big, pg8::RsTable{SSQ, (LAS float*)(C.lds + RSTAB_OFF), -1}, SEQ, BATCH, pg8::GateW{gate5, (unsigned)C.G, 0}}; \
        pg8::gemm_phase<pg8::EpiQKV, pg8::StaticOrder, true, true>(C.lds + RING_OFF, g, S, E); \
        if (cls == 0) { const P0Args A = P0ARGS; p0_items(C, A, cwave, 128 * NWAVES, P0_AT_UP1, P0_I_UP, P0_AT_DN1, P0_I_DN); } }
#define PH6N { pg8::Gemm g{XN, (const bf16*)(ws + WS_WQKV), M, NQKV, D, (size_t)256 * D * 2}; pg8::StaticOrder S; S.init(M, NQKV, C.G, (int)blockIdx.x); pg8::EpiNull E{}; \
        pg8::gemm_phase<pg8::EpiNull, pg8::StaticOrder, true, true>(C.lds + RING_OFF, g, S, E); }
#define PH6S { pg8::Gemm g{XN, (const bf16*)(ws + WS_WQKV), M, NQKV, D, (size_t)256 * D * 2}; pg8::StaticOrder S; S.init(M, NQKV, C.G, (int)blockIdx.x); pg8::EpiStoreOnly E{(bf16*)big, NQKV}; \
        pg8::gemm_phase<pg8::EpiStoreOnly, pg8::StaticOrder, true, true>(C.lds + RING_OFF, g, S, E); }
#define PH7V(v) { p7_attention<v>(C, (bf16*)big, LSE, (const float*)(ws + WS_LUT)); }
#define PH7 { p7_attention<0>(C, (bf16*)big, LSE, (const float*)(ws + WS_LUT)); }
#define PH8 { p8_merge(C, item_row, (const bf16*)big, LSE, OM); __syncthreads(); gate_arrive(gate8); }
#define PH9 { pg8::Gemm g{OM, (const bf16*)(ws + WS_WOB), M, D, AW, (size_t)256 * AW * 2}; pg8::StaticOrder S; S.init(M, D, C.G, (int)blockIdx.x); pg8::EpiRes E{XN, SSQ, D}; \
        pg8::gemm_phase<pg8::EpiRes, pg8::StaticOrder, true, true>(C.lds + RING_OFF, g, S, E); }
#define PH12 { p12_final(C, item_row, XN, out, SSQ, fing); }
#define DUPAT(k) do { if (DUP_AFTER == (k)) { DUP_BODY } } while (0)
    GSTEP(PH0); DUPAT(0);
    if (lo <= 0 && 1 < hi) {
        const unsigned* xw = (const unsigned*)(ctl + CW_XCC) + k8 * 8 + gx;
        const unsigned a0 = __hip_atomic_load(xw, __ATOMIC_RELAXED, __HIP_MEMORY_SCOPE_AGENT), a1 = __hip_atomic_load(xw + 64, __ATOMIC_RELAXED, __HIP_MEMORY_SCOPE_AGENT),
                       a2 = __hip_atomic_load(xw + 128, __ATOMIC_RELAXED, __HIP_MEMORY_SCOPE_AGENT), a3 = __hip_atomic_load(xw + 192, __ATOMIC_RELAXED, __HIP_MEMORY_SCOPE_AGENT);
        gbr.same = (a0 != 0u && a0 == a1 && a0 == a2 && a0 == a3) ? 1u : 0u; }
    if (lo <= 0 && 1 < hi && cls == 1) { const P0Args A = P0ARGS;
        p0_items(C, A, cwave, 128 * NWAVES, P0_AT_OA, P0_AT_UP1 - P0_AT_OA, P0_AT_DN0, P0_I_DN);
        asm volatile("s_waitcnt vmcnt(0)" ::: "memory"); __syncthreads();
        if (C.tid == 0) { __builtin_amdgcn_fence(__ATOMIC_RELEASE, "agent"); asm volatile("s_waitcnt vmcnt(0)" ::: "memory"); (void)__hip_atomic_fetch_add(s1cnt, 1u, __ATOMIC_RELAXED, __HIP_MEMORY_SCOPE_AGENT); } }
    CSTEP(PH1); DUPAT(1);
    CSTEP(PH2); DUPAT(2);
    CSTEP(PH3); DUPAT(3);
    CSTEP(PHUP(0)); DUPAT(4);
    CSTEP(PHDN(0)); DUPAT(5);
    GSTEP(PH6); DUPAT(6);
    GSTEP(PH7); DUPAT(7);
    CSTEP(PH8); DUPAT(8);
    CSTEP(PH9); DUPAT(9);
    CSTEP(PHUP(1)); DUPAT(10);
    CSTEP(PHFIN);
}

extern "C" void kernel_launch(void* const* d_in, const int* in_sizes, int n_in, void* d_out, int out_size, void* d_ws, size_t ws_size, hipStream_t stream) {
    static int grid = 0;
    if (grid == 0) {
        if (n_in != 15 || in_sizes[0] != M * D || out_size != M * D || ws_size < WS_END) { fprintf(stderr, "kernel_launch: shape/workspace mismatch (n_in %d, in0 %d, out %d, ws %zu); nothing launched\n", n_in, n_in > 0 ? in_sizes[0] : -1, out_size, ws_size); grid = -1; return; }
        int dev = 0, cus = 0, per_cu = 0;
        if (hipGetDevice(&dev) != hipSuccess || hipDeviceGetAttribute(&cus, hipDeviceAttributeMultiprocessorCount, dev) != hipSuccess) { grid = -1; return; }
        if (hipFuncSetAttribute((const void*)trunk_fwd, hipFuncAttributeMaxDynamicSharedMemorySize, LDS_BYTES) != hipSuccess) { fprintf(stderr, "kernel_launch: hipFuncSetAttribute failed\n"); grid = -1; return; }
        if (hipOccupancyMaxActiveBlocksPerMultiprocessor(&per_cu, (const void*)trunk_fwd, NWAVES * 64, LDS_BYTES) != hipSuccess || per_cu < 1)
            fprintf(stderr, "kernel_launch: note: occupancy query reports %d workgroups per CU\n", per_cu);
        (void)hipGetLastError();
        grid = cus;
        if (grid != 256) { fprintf(stderr, "kernel_launch: %d CUs: this kernel's group seams are derived for a 256-workgroup grid; nothing launched\n", grid); grid = -1; return; }
    }
    if (grid < 0) return;
    if (hipMemsetAsync((char*)d_ws + WS_CTL, 0, CTL_ZERO_BYTES, stream) != hipSuccess) return;
    Args a{};
    for (int i = 0; i < 15; ++i) a.in[i] = (const float*)d_in[i];
    a.out = (float*)d_out; a.ws = (unsigned char*)d_ws;
#if MK_SPLIT
    for (int p = 0; p < N_SEQ; ++p) { a.ph_lo = p; a.ph_hi = p + 1; hipLaunchKernelGGL(trunk_fwd, dim3(grid), dim3(NWAVES * 64), LDS_BYTES, stream, a); }
#else
    a.ph_lo = 0; a.ph_hi = N_SEQ;
    hipLaunchKernelGGL(trunk_fwd, dim3(grid), dim3(NWAVES * 64), LDS_BYTES, stream, a);
#endif
    const hipError_t le = hipPeekAtLastError();
    if (le != hipSuccess) fprintf(stderr, "kernel_launch: launch failed: %s\n", hipGetErrorName(le));
}
```

```cpp
#include <hip/hip_runtime.h>
#include <cstdio>
#include <cstdint>
namespace pg8 {
#define PG8_LAS __attribute__((address_space(3)))
typedef unsigned short bf16_t;
typedef short bf16x8 __attribute__((ext_vector_type(8)));
typedef float f32x4 __attribute__((ext_vector_type(4)));
typedef unsigned u32x4 __attribute__((ext_vector_type(4)));
constexpr int BM = 256, BK = 64, HALF = 128, HTB = HALF * BK * 2  , STAGE_BYTES = 8 * HTB, NXCD = 8, WGM = 8;

__host__ __device__ __forceinline__ int lds_byte(int r, int c) { const int st = (r >> 4) * 2 + (c >> 5), rr = r & 15, cc = c & 31, ob = rr * 64 + cc * 2; return st * 1024 + (ob ^ (((ob >> 9) & 1) << 5)); }
__host__ __device__ __forceinline__ void stage_rc(int b, int& R, int& C) { const int st = b / 1024, sb = b % 1024, swz = sb ^ (((sb >> 9) & 1) << 5); R = (st >> 1) * 16 + swz / 64; C = (st & 1) * 32 + (swz % 64) / 2; }
__host__ __device__ __forceinline__ int perm32(int rho) { const int n = rho >> 4, i = rho & 15; return 8 * (i >> 2) + 4 * n + (i & 3); }

struct Unit { int pm, pn; };
struct Gemm { const bf16_t* A; const bf16_t* Bt; int M, N, K; size_t tstepA; };

struct StaticOrder {
    int nM, nN, nwg, G, c, rev, pnrev;
    __host__ __device__ void init(int M, int N, int G_, int c_) { nM = M / BM; nN = N / BM; nwg = nM * nN; G = G_; c = c_; rev = 0; pnrev = 0; }
    __host__ __device__ void columns_descending() { pnrev = 1; }
    __host__ __device__ void reversed() { rev = (nwg + G - 1) / G; }
    __host__ __device__ bool next(int i, Unit& u) const {
        if (rev) { if (i >= rev) return false; i = rev - 1 - i; }
        const long L = (long)i * G + c; if (L >= nwg) return false;
        int wgid = (int)L; { const int q = nwg / NXCD, r = nwg % NXCD, xcd = wgid % NXCD, off = wgid / NXCD; wgid = (xcd < r ? xcd * (q + 1) : r * (q + 1) + (xcd - r) * q) + off; }
        const int nig = WGM * nN, gid = wgid / nig, fm = gid * WGM, gsz = (nM - fm) < WGM ? (nM - fm) : WGM;
        u.pm = fm + ((wgid % nig) % gsz); u.pn = (wgid % nig) / gsz; if (pnrev) u.pn = nN - 1 - u.pn; return true;
    }
    __device__ __forceinline__ void a_ready(const Unit&) const {}
    __device__ __forceinline__ void done(const Unit&) const {}
};

__device__ __forceinline__ unsigned cvt_pk_bf16(float lo, float hi) { unsigned r; asm volatile("v_cvt_pk_bf16_f32 %0, %1, %2" : "=v"(r) : "v"(lo), "v"(hi)); return r; }
typedef float f32x2 __attribute__((ext_vector_type(2)));
__device__ __forceinline__ f32x2 gelu_pk(f32x2 v) {
    f32x2 a; a.x = fminf(__builtin_fabsf(v.x), 5.3f); a.y = fminf(__builtin_fabsf(v.y), 5.3f);
    const f32x2 x = a * 0.377358496f + (-1.0f);
    f32x2 q = x * (-2.680665057e-04f) + (-4.321495537e-03f);
    q = q * x + 7.164665032e-03f; q = q * x + 1.980672404e-02f; q = q * x + (-4.157880694e-02f); q = q * x + (-2.189491689e-02f); q = q * x + 1.078988388e-01f;
    q = q * x + (-5.974620953e-02f); q = q * x + (-1.094131693e-01f); q = q * x + 2.026295662e-01f; q = q * x + (-8.957923949e-02f); q = q * x + (-1.324163824e-01f);
    q = q * x + 2.609098256e-01f; q = q * x + (-2.224893272e-01f); q = q * x + 1.108414084e-01f; q = q * x + (-3.156794980e-02f); q = q * x + 4.024588503e-03f;
    const f32x2 m = v * q, r = v - m;
    f32x2 o; o.x = v.x < 0.f ? m.x : r.x; o.y = v.y < 0.f ? m.y : r.y; return o;
}

struct RsTable {
    const float* ssq; PG8_LAS float* tab; mutable int pm_cached;
    __device__ __forceinline__ void get(const Unit& u, int wr, int fr, float (&rs)[2][4]) const {
        if (u.pm != pm_cached) {
            const int t = threadIdx.x, row = t >> 1, half = t & 1;
            const f32x4 a = *(const f32x4*)(ssq + (size_t)(u.pm * BM + row) * 16 + half * 8), b = *(const f32x4*)(ssq + (size_t)(u.pm * BM + row) * 16 + half * 8 + 4);
            float s = ((a[0] + a[1]) + (a[2] + a[3])) + ((b[0] + b[1]) + (b[2] + b[3]));
            s += __shfl_xor(s, 1);
            if (half == 0) tab[row] = __builtin_amdgcn_rsqf(s * (1.0f / 1024.0f) + 1e-6f);
            asm volatile("s_waitcnt lgkmcnt(0)" ::: "memory"); __builtin_amdgcn_s_barrier(); asm volatile("" ::: "memory");
            pm_cached = u.pm;
        }
#pragma unroll
        for (int ai = 0; ai < 2; ++ai)
#pragma unroll
            for (int m = 0; m < 4; ++m) rs[ai][m] = tab[ai * HALF + wr * 64 + m * 16 + fr];
    }
};
struct GateW { const unsigned* cnt; unsigned target; mutable int passed;
    __device__ __forceinline__ void wait() const { if (cnt && !passed) { unsigned sp = 0u; while (__hip_atomic_load(cnt, __ATOMIC_RELAXED, __HIP_MEMORY_SCOPE_AGENT) < target) { __builtin_amdgcn_s_sleep(2); if (++sp > (1u << 22)) break; } passed = 1; } } };
template <int ACT> struct EpiAct {
    static constexpr bool PERM = true, AFTER_DRAIN = false;
    bf16_t* O; int ldc; size_t pstride; RsTable rt; float* vst; GateW gate;
    __device__ __forceinline__ void operator()(const f32x4 (&acc)[2][2][4][2], const Unit& u, int wr, int wc, int fr, int fq) const {
        const int row0 = u.pm * BM + wr * 64 + fr, col0 = u.pn * BM + wc * 32 + 8 * fq;
        const bool vhalf = (ACT == 1) && (u.pn >= 4);
        float rsv[2][4]; rt.get(u, wr, fr, rsv); gate.wait();
#pragma unroll
        for (int ai = 0; ai < 2; ++ai)
#pragma unroll
            for (int m = 0; m < 4; ++m) {
                const int row = row0 + ai * HALF + m * 16;
                const float rs = rsv[ai][m];
                bf16_t* rowp = O + (size_t)u.pm * pstride + (size_t)(row - u.pm * BM) * ldc + col0;
                float s1 = 0.f, s2 = 0.f;
#pragma unroll
                for (int bj = 0; bj < 2; ++bj) {
                    f32x4 v0 = acc[ai][bj][m][0] * rs, v1 = acc[ai][bj][m][1] * rs;
                    if (ACT == 1) { f32x2 a = gelu_pk((f32x2){v0[0], v0[1]}), b = gelu_pk((f32x2){v0[2], v0[3]}), c = gelu_pk((f32x2){v1[0], v1[1]}), d = gelu_pk((f32x2){v1[2], v1[3]});
                        v0 = (f32x4){a.x, a.y, b.x, b.y}; v1 = (f32x4){c.x, c.y, d.x, d.y};
                        s1 += ((v0[0] + v0[1]) + (v0[2] + v0[3])) + ((v1[0] + v1[1]) + (v1[2] + v1[3]));
                        s2 += ((v0[0] * v0[0] + v0[1] * v0[1]) + (v0[2] * v0[2] + v0[3] * v0[3])) + ((v1[0] * v1[0] + v1[1] * v1[1]) + (v1[2] * v1[2] + v1[3] * v1[3])); }
                    if (ACT == 2) {
#pragma unroll
                        for (int e = 0; e < 4; ++e) { const float a = fmaxf(v0[e], 0.f), b = fmaxf(v1[e], 0.f); v0[e] = a * a; v1[e] = b * b; } }
                    u32x4 w; w.x = cvt_pk_bf16(v0[0], v0[1]); w.y = cvt_pk_bf16(v0[2], v0[3]); w.z = cvt_pk_bf16(v1[0], v1[1]); w.w = cvt_pk_bf16(v1[2], v1[3]);
                    *(u32x4*)(rowp + bj * HALF) = w; }
                if (ACT == 1) { if (vhalf) { s1 += __shfl_xor(s1, 16); s1 += __shfl_xor(s1, 32); s2 += __shfl_xor(s2, 16); s2 += __shfl_xor(s2, 32);
                        if (fq == 0) *(f32x2*)(vst + ((size_t)row * 16 + (u.pn - 4) * 4 + wc) * 2) = (f32x2){s1, s2}; } }
            }
    }
};
struct EpiQKV {
    static constexpr bool PERM = true, AFTER_DRAIN = false;
    bf16_t* O; RsTable rt; int seq, nb; GateW gate;
    __device__ __forceinline__ void operator()(const f32x4 (&acc)[2][2][4][2], const Unit& u, int wr, int wc, int fr, int fq) const {
        const int row0 = u.pm * BM + wr * 64 + fr, col0 = u.pn * BM + wc * 32 + 8 * fq;
        const int g = ((u.pn * BM) / 512) % 3, lg = 2 * g, dm = (1 << lg) - 1;
        float rsv[2][4]; rt.get(u, wr, fr, rsv); gate.wait();
#pragma unroll
        for (int ai = 0; ai < 2; ++ai)
#pragma unroll
            for (int m = 0; m < 4; ++m) {
                const int row = row0 + ai * HALF + m * 16, b = row / seq, pos = row - b * seq;
                const size_t prow = (size_t)b * seq + (size_t)(pos & dm) * (seq >> lg) + (pos >> lg);
                const float rs = rsv[ai][m];
#pragma unroll
                for (int bj = 0; bj < 2; ++bj) { const int col = col0 + bj * HALF, hd = col >> 6;
                    const f32x4 v0 = acc[ai][bj][m][0] * rs, v1 = acc[ai][bj][m][1] * rs;
                    u32x4 w; w.x = cvt_pk_bf16(v0[0], v0[1]); w.y = cvt_pk_bf16(v0[2], v0[3]); w.z = cvt_pk_bf16(v1[0], v1[1]); w.w = cvt_pk_bf16(v1[2], v1[3]);
                    *(u32x4*)(O + ((size_t)hd * nb * seq + prow) * 64 + (col & 63)) = w; } }
    }
};
__device__ __forceinline__ float bf_lo(unsigned w) { return __builtin_bit_cast(float, w << 16); }
__device__ __forceinline__ float bf_hi(unsigned w) { return __builtin_bit_cast(float, w & 0xffff0000u); }
struct EpiRes {
    static constexpr bool PERM = true, AFTER_DRAIN = false;
    bf16_t* hb; float* ssq; int ldc;
    __device__ __forceinline__ void operator()(const f32x4 (&acc)[2][2][4][2], const Unit& u, int wr, int wc, int fr, int fq) const {
        const int row0 = u.pm * BM + wr * 64 + fr, col0 = u.pn * BM + wc * 32 + 8 * fq;
        u32x4 r[2][4][2];
#pragma unroll
        for (int ai = 0; ai < 2; ++ai)
#pragma unroll
            for (int m = 0; m < 4; ++m)
#pragma unroll
                for (int bj = 0; bj < 2; ++bj) r[ai][m][bj] = *(const u32x4*)(hb + (size_t)(row0 + ai * HALF + m * 16) * ldc + col0 + bj * HALF);
        asm volatile("" ::: "memory");
#pragma unroll
        for (int ai = 0; ai < 2; ++ai)
#pragma unroll
            for (int m = 0; m < 4; ++m) {
                const int row = row0 + ai * HALF + m * 16;
                float q = 0.f;
#pragma unroll
                for (int bj = 0; bj < 2; ++bj) { const u32x4 rr = r[ai][m][bj];
                    const f32x4 h0 = (f32x4){bf_lo(rr.x), bf_hi(rr.x), bf_lo(rr.y), bf_hi(rr.y)} + acc[ai][bj][m][0], h1 = (f32x4){bf_lo(rr.z), bf_hi(rr.z), bf_lo(rr.w), bf_hi(rr.w)} + acc[ai][bj][m][1];
                    u32x4 w; w.x = cvt_pk_bf16(h0[0], h0[1]); w.y = cvt_pk_bf16(h0[2], h0[3]); w.z = cvt_pk_bf16(h1[0], h1[1]); w.w = cvt_pk_bf16(h1[2], h1[3]);
                    *(u32x4*)(hb + (size_t)row * ldc + col0 + bj * HALF) = w;
                    q += ((h0[0] * h0[0] + h0[1] * h0[1]) + (h0[2] * h0[2] + h0[3] * h0[3])) + ((h1[0] * h1[0] + h1[1] * h1[1]) + (h1[2] * h1[2] + h1[3] * h1[3])); }
                q += __shfl_xor(q, 16); q += __shfl_xor(q, 32);
                if (fq == 0) ssq[(size_t)row * 16 + u.pn * 4 + wc] = q;
            }
    }
};
struct EpiNull {
    static constexpr bool PERM = true, AFTER_DRAIN = false;
    __device__ __forceinline__ void operator()(const f32x4 (&acc)[2][2][4][2], const Unit& u, int wr, int wc, int fr, int fq) const {
#pragma unroll
        for (int ai = 0; ai < 2; ++ai)
#pragma unroll
            for (int bj = 0; bj < 2; ++bj)
#pragma unroll
                for (int m = 0; m < 4; ++m)
#pragma unroll
                    for (int n = 0; n < 2; ++n) asm volatile("" :: "v"(acc[ai][bj][m][n]));
    }
};
struct EpiStoreOnly {
    static constexpr bool PERM = true, AFTER_DRAIN = false;
    bf16_t* O; int ldc;
    __device__ __forceinline__ void operator()(const f32x4 (&acc)[2][2][4][2], const Unit& u, int wr, int wc, int fr, int fq) const {
        const int row0 = u.pm * BM + wr * 64 + fr, col0 = u.pn * BM + wc * 32 + 8 * fq;
#pragma unroll
        for (int ai = 0; ai < 2; ++ai)
#pragma unroll
            for (int m = 0; m < 4; ++m) {
                bf16_t* rowp = O + (size_t)(row0 + ai * HALF + m * 16) * ldc + col0;
#pragma unroll
                for (int bj = 0; bj < 2; ++bj) { const f32x4 v0 = acc[ai][bj][m][0], v1 = acc[ai][bj][m][1];
                    u32x4 w; w.x = cvt_pk_bf16(v0[0], v0[1]); w.y = cvt_pk_bf16(v0[2], v0[3]); w.z = cvt_pk_bf16(v1[0], v1[1]); w.w = cvt_pk_bf16(v1[2], v1[3]);
                    *(u32x4*)(rowp + bj * HALF) = w; } }
    }
};
template <class Epi, class Sched, bool ALIGN_EPI = false, bool SP2 = false, bool KDESC = false>
__device__ __forceinline__ void gemm_phase(PG8_LAS unsigned char* lds, const Gemm g, const Sched& S, const Epi& E) {
    const int tid = threadIdx.x, wid = __builtin_amdgcn_readfirstlane(tid >> 6), lane = tid & 63, wr = wid >> 2, wc = wid & 3, fr = lane & 15, fq = lane >> 4;
    const int K = g.K, nt = K / BK;
    unsigned voffA[2], voffB[2];
#pragma unroll
    for (int i = 0; i < 2; ++i) { int R, C; stage_rc(tid * 16 + i * 8192, R, C); const int Rb = Epi::PERM ? ((R & ~31) + perm32(R & 31)) : R;
        voffA[i] = (unsigned)(R * K + C) * 2u; voffB[i] = (unsigned)(Rb * K + C) * 2u; }
    const size_t kstep = KDESC ? (size_t)0 - (size_t)(BK * 2) : (size_t)(BK * 2);
    const size_t kfirst = KDESC ? (size_t)(nt - 1) * (size_t)(BK * 2) : (size_t)0;
    const size_t hstep = (size_t)HALF * K * 2;
    const size_t tstep = 2 * hstep;
    const unsigned ldsw = (unsigned)wid * 1024u;
    const int aoff = lds_byte(wr * 64 + fr, fq * 8), boff = lds_byte(wc * 32 + fr, fq * 8);
#define PG8_SA(b, h) (((b) * 2 + (h)) * HTB)
#define PG8_SB(b, h) ((4 + (b) * 2 + (h)) * HTB)
#define PG8_STAGE(bufoff, gbase, voff) do { _Pragma("unroll") for (int _i = 0; _i < 2; ++_i) \
        __builtin_amdgcn_global_load_lds((const unsigned*)((const char*)(gbase) + (voff)[_i]), (PG8_LAS unsigned*)(lds + (bufoff) + ldsw + _i * 8192), 16, 0, 0); } while (0)
#define PG8_LDA(dst, b, h) do { _Pragma("unroll") for (int m = 0; m < 4; ++m) _Pragma("unroll") for (int k = 0; k < 2; ++k) dst[m][k] = *(const PG8_LAS bf16x8*)(lds + PG8_SA(b, h) + aoff + m * 2048 + k * 1024); } while (0)
#define PG8_LDB(dst, b, h) do { _Pragma("unroll") for (int n = 0; n < 2; ++n) _Pragma("unroll") for (int k = 0; k < 2; ++k) dst[n][k] = *(const PG8_LAS bf16x8*)(lds + PG8_SB(b, h) + boff + n * 2048 + k * 1024); } while (0)
#define PG8_MMA(ai, bj, At, Bt) do { __builtin_amdgcn_s_setprio(1); _Pragma("unroll") for (int m = 0; m < 4; ++m) _Pragma("unroll") for (int n = 0; n < 2; ++n) _Pragma("unroll") for (int k = 0; k < 2; ++k) \
        acc[ai][bj][m][n] = __builtin_amdgcn_mfma_f32_16x16x32_bf16(Bt[n][k], At[m][k], acc[ai][bj][m][n], 0, 0, 0); __builtin_amdgcn_s_setprio(0); } while (0)
#define PG8_WAIT_V(n) asm volatile("s_waitcnt vmcnt(" #n ")" ::: "memory")
#define PG8_WAIT_L(n) asm volatile("s_waitcnt lgkmcnt(" #n ")" ::: "memory")
#define PG8_BAR __builtin_amdgcn_s_barrier()
#define PG8_SCHED __builtin_amdgcn_sched_barrier(0)
    Unit cur, nxt; int ui = 0;
    if (!S.next(0, cur)) return;
    f32x4 acc[2][2][4][2];
#pragma unroll
    for (int a = 0; a < 2; ++a)
#pragma unroll
        for (int b = 0; b < 2; ++b)
#pragma unroll
            for (int m = 0; m < 4; ++m)
#pragma unroll
                for (int n = 0; n < 2; ++n) acc[a][b][m][n] = (f32x4){0.f, 0.f, 0.f, 0.f};
    bf16x8 At[4][2], B0[2][2], B1[2][2];
    const char* cA = (const char*)g.A + (size_t)cur.pm * g.tstepA + kfirst; const char* cB = (const char*)g.Bt + (size_t)cur.pn * tstep + kfirst;
    S.a_ready(cur);
    if constexpr (SP2) {
        PG8_STAGE(PG8_SB(0, 0), cB, voffB); PG8_STAGE(PG8_SB(0, 1), cB + hstep, voffB); PG8_STAGE(PG8_SA(0, 0), cA, voffA); PG8_STAGE(PG8_SA(0, 1), cA + hstep, voffA);
        if (wr == 1) PG8_BAR;
        PG8_WAIT_V(2); PG8_BAR;
        PG8_STAGE(PG8_SB(1, 0), cB + kstep, voffB); PG8_STAGE(PG8_SA(1, 0), cA + kstep, voffA); PG8_STAGE(PG8_SB(1, 1), cB + hstep + kstep, voffB);
        PG8_WAIT_V(6); PG8_BAR;
    } else {
        PG8_STAGE(PG8_SB(0, 0), cB, voffB); PG8_STAGE(PG8_SA(0, 0), cA, voffA); PG8_STAGE(PG8_SB(0, 1), cB + hstep, voffB); PG8_STAGE(PG8_SA(0, 1), cA + hstep, voffA);
        if (wr == 1) PG8_BAR;
        PG8_WAIT_V(4); PG8_BAR;
        PG8_STAGE(PG8_SB(1, 0), cB + kstep, voffB); PG8_STAGE(PG8_SA(1, 0), cA + kstep, voffA); PG8_STAGE(PG8_SB(1, 1), cB + hstep + kstep, voffB);
        PG8_WAIT_V(6); PG8_BAR;
    }
    for (;;) {
        const bool has_next = S.next(ui + 1, nxt);
        const char* nA = has_next ? (const char*)g.A + (size_t)nxt.pm * g.tstepA + kfirst : cA; const char* nB = has_next ? (const char*)g.Bt + (size_t)nxt.pn * tstep + kfirst : cB;
        for (int t = 0; t < nt; t += 2) {
            const bool last = (t == nt - 2);
            const char* a1 = cA + (size_t)(t + 1) * kstep;
            const char* a2 = last ? nA : cA + (size_t)(t + 2) * kstep; const char* b2 = last ? nB : cB + (size_t)(t + 2) * kstep;
            const char* a3 = a2 + kstep; const char* b3 = b2 + kstep;
            if (last && has_next) S.a_ready(nxt);
            if constexpr (SP2) {
            PG8_LDB(B0, 0, 0); PG8_LDB(B1, 0, 1); PG8_SCHED; PG8_LDA(At, 0, 0); PG8_STAGE(PG8_SA(1, 1), a1 + hstep, voffA);
            PG8_WAIT_V(8); PG8_WAIT_L(0); PG8_BAR; PG8_MMA(0, 0, At, B0); PG8_MMA(0, 1, At, B1); PG8_BAR; PG8_SCHED;
            PG8_LDA(At, 0, 1); PG8_STAGE(PG8_SB(0, 0), b2, voffB); PG8_STAGE(PG8_SB(0, 1), b2 + hstep, voffB); PG8_STAGE(PG8_SA(0, 0), a2, voffA);
            PG8_WAIT_V(8); PG8_WAIT_L(0); PG8_BAR; PG8_MMA(1, 0, At, B0); PG8_MMA(1, 1, At, B1); PG8_BAR; PG8_SCHED;
            PG8_LDB(B0, 1, 0); PG8_LDB(B1, 1, 1); PG8_SCHED; PG8_LDA(At, 1, 0); PG8_STAGE(PG8_SA(0, 1), a2 + hstep, voffA);
            PG8_WAIT_V(8); PG8_WAIT_L(0); PG8_BAR; PG8_MMA(0, 0, At, B0); PG8_MMA(0, 1, At, B1); PG8_BAR; PG8_SCHED;
            PG8_LDA(At, 1, 1); PG8_STAGE(PG8_SB(1, 0), b3, voffB); PG8_STAGE(PG8_SB(1, 1), b3 + hstep, voffB); PG8_STAGE(PG8_SA(1, 0), a3, voffA);
            PG8_WAIT_V(8); PG8_WAIT_L(0); PG8_BAR; PG8_MMA(1, 0, At, B0); PG8_MMA(1, 1, At, B1); PG8_BAR; PG8_SCHED;
            } else {
            PG8_LDB(B0, 0, 0); PG8_SCHED; PG8_LDA(At, 0, 0); PG8_STAGE(PG8_SA(1, 1), a1 + hstep, voffA);
            PG8_WAIT_L(8); PG8_BAR; PG8_WAIT_L(0); PG8_MMA(0, 0, At, B0); PG8_BAR; PG8_SCHED;
            PG8_LDB(B1, 0, 1); PG8_STAGE(PG8_SB(0, 0), b2, voffB);
            PG8_BAR; PG8_WAIT_L(0); PG8_MMA(0, 1, At, B1); PG8_BAR;
            PG8_LDA(At, 0, 1); PG8_STAGE(PG8_SA(0, 0), a2, voffA);
            PG8_BAR; PG8_WAIT_L(0); PG8_MMA(1, 0, At, B0); PG8_BAR; PG8_SCHED;
            PG8_STAGE(PG8_SB(0, 1), b2 + hstep, voffB);
            PG8_WAIT_V(6); PG8_BAR; PG8_MMA(1, 1, At, B1); PG8_BAR;
            PG8_LDB(B0, 1, 0); PG8_SCHED; PG8_LDA(At, 1, 0); PG8_STAGE(PG8_SA(0, 1), a2 + hstep, voffA);
            PG8_WAIT_L(8); PG8_BAR; PG8_WAIT_L(0); PG8_MMA(0, 0, At, B0); PG8_BAR; PG8_SCHED;
            PG8_LDB(B1, 1, 1); PG8_STAGE(PG8_SB(1, 0), b3, voffB);
            PG8_BAR; PG8_WAIT_L(0); PG8_MMA(0, 1, At, B1); PG8_BAR;
            PG8_LDA(At, 1, 1); PG8_STAGE(PG8_SA(1, 0), a3, voffA);
            PG8_BAR; PG8_WAIT_L(0); PG8_MMA(1, 0, At, B0); PG8_BAR; PG8_SCHED;
            PG8_STAGE(PG8_SB(1, 1), b3 + hstep, voffB);
            PG8_WAIT_V(6); PG8_BAR; PG8_MMA(1, 1, At, B1); PG8_BAR;
            }
        }
        if constexpr (ALIGN_EPI) { if (wr == 0) PG8_BAR; }
        if constexpr (!Epi::AFTER_DRAIN) { E(acc, cur, wr, wc, fr, fq); S.done(cur); }
        if (!has_next) break;
#pragma unroll
        for (int a = 0; a < 2; ++a)
#pragma unroll
            for (int b = 0; b < 2; ++b)
#pragma unroll
                for (int m = 0; m < 4; ++m)
#pragma unroll
                    for (int n = 0; n < 2; ++n) acc[a][b][m][n] = (f32x4){0.f, 0.f, 0.f, 0.f};
        cur = nxt; cA = nA; cB = nB; ++ui;
        if constexpr (ALIGN_EPI) { if (wr == 1) PG8_BAR; }
    }
    PG8_WAIT_V(0);
    if constexpr (!ALIGN_EPI) { if (wr == 0) PG8_BAR; }
    PG8_BAR;
    if constexpr (Epi::AFTER_DRAIN) { E.fused(acc, cur, wr, wc, fr, fq, lds, wid, lane); S.done(cur); }
#undef PG8_SA
#undef PG8_SB
#undef PG8_STAGE
#undef PG8_LDA
#undef PG8_LDB
#undef PG8_MMA
#undef PG8_WAIT_V
#undef PG8_WAIT_L
#undef PG8_BAR
#undef PG8_SCHED
}
}
constexpr int NWAVES = 8;
constexpr int BATCH = 4, SEQ = 8192, D = 1024, FF = 4096, NQKV = 4608, AW = 512, NH = 8, HD = 64;
constexpr int M = BATCH * SEQ;
constexpr int CHUNK = 128, NCHUNK = M / CHUNK, NGRP = 8;
constexpr float EPS = 1e-6f;
constexpr float LOG2E = 1.4426950408889634f;
constexpr int LUT_N = 176;
#ifndef MK_SPLIT
#define MK_SPLIT 0
#endif
constexpr int N_PHASES = 12;
#define DUP_AFTER (-1)
#define DUP_N 0
#define DUP_BODY
#define BAR_REPS 1
constexpr int N_SEQ = N_PHASES + DUP_N;

constexpr size_t MiB = 1u << 20;
constexpr size_t WS_CTL = 0, CTL_ZERO_BYTES = 128 * 1024;
constexpr size_t WS_WIN = 2 * MiB, WS_WOA = 6 * MiB, WS_WQKV = 8 * MiB, WS_WOB = 17 * MiB, WS_WUP = 18 * MiB, WS_WDN = 34 * MiB;
constexpr size_t WS_WST = 50 * MiB;
constexpr size_t WS_LUT = 50 * MiB + 512 * 1024;
constexpr size_t WS_SSQ = 51 * MiB;
constexpr size_t WS_VST = 53 * MiB;
constexpr size_t WS_LSE = 57 * MiB;
constexpr size_t WS_XN = 64 * MiB;
constexpr size_t WS_BIG = 128 * MiB;
constexpr size_t BLK = 2304 * 1024;
constexpr size_t BLK_UG = 1 * MiB, QSLICE = 256 * 64;
constexpr size_t WS_OM = 416 * MiB;
constexpr size_t WS_END = 448 * MiB;
constexpr int CW_TMO = 0, CW_CODE = 1, CW_BAR = 4096, CW_GRP = 8192, CW_XCC = 16384, CW_GATE = 20480;
static_assert((size_t)(CW_GATE + 256) * 4 <= CTL_ZERO_BYTES, "control words inside the per-call memset");

constexpr int RING_OFF = 0, RING_BYTES = 131072;
constexpr int LDSCTL_OFF = 159744  , MISC_OFF = LDSCTL_OFF + 320, RSTAB_OFF = LDSCTL_OFF + 1024;
constexpr int LDS_BYTES = 163840;

#define GAS __attribute__((address_space(1)))
#define LAS __attribute__((address_space(3)))
typedef unsigned short bf16;
typedef unsigned v4u __attribute__((ext_vector_type(4)));
typedef float f32x4 __attribute__((ext_vector_type(4)));
typedef short bf16x8 __attribute__((ext_vector_type(8)));
typedef GAS unsigned gu32;
typedef GAS unsigned long long gu64;
#define RLX_AGENT __ATOMIC_RELAXED, __HIP_MEMORY_SCOPE_AGENT
#define LDS_WAIT() asm volatile("s_waitcnt lgkmcnt(0)" ::: "memory")
#define VM_WAIT() asm volatile("s_waitcnt vmcnt(0)" ::: "memory")
__device__ __forceinline__ unsigned long long rt() { return __builtin_amdgcn_s_memrealtime(); }
__device__ __forceinline__ unsigned f2bf(float f) { unsigned u = __builtin_bit_cast(unsigned, f); return (u + 0x7fffu + ((u >> 16) & 1u)) >> 16; }
__device__ __forceinline__ unsigned pk2(float lo, float hi) { return f2bf(lo) | (f2bf(hi) << 16); }

#define XB_TMO      128
#define XB_XCNT(j)  (256  + 64 * (j))
#define XB_XSUB(j)  (1280 + 64 * (j))
#define XB_XGEN(j)  (2304 + 64 * (j))
#define XB_TOP      3328
#define XB_TOPGEN   3392
#define XCD_BAR_WORDS 3456
#define XB_SPIN_CAP (1u << 18)

__device__ __forceinline__ unsigned xb_ld(unsigned* p)              { return __hip_atomic_load(p, __ATOMIC_RELAXED, __HIP_MEMORY_SCOPE_AGENT); }
__device__ __forceinline__ unsigned xb_add(unsigned* p, unsigned v) { return __hip_atomic_fetch_add(p, v, __ATOMIC_RELAXED, __HIP_MEMORY_SCOPE_AGENT); }
__device__ __forceinline__ unsigned xb_xcc_id() { return (unsigned)__builtin_amdgcn_s_getreg((3 << 11) | 20) & 0xFu; }
#define XB_SPIN(cond, bar) do { unsigned _sp = 0; while (cond) { __builtin_amdgcn_s_sleep(1); \
    if ((++_sp & 255u) == 0u) { if (xb_ld(&(bar)[XB_TMO])) break; if (_sp > XB_SPIN_CAP) { atomicAdd(&(bar)[XB_TMO], 1u); break; } } } } while (0)

struct XcdBarrier {
    unsigned* bar; unsigned x;
    volatile LAS unsigned* st;
};

__device__ __forceinline__ XcdBarrier xcd_barrier_post(unsigned* bar, volatile LAS unsigned* st) {
    XcdBarrier b; b.bar = bar; b.x = xb_xcc_id(); b.st = st;
    if (threadIdx.x == 0) (void)xb_add(&bar[XB_XCNT(b.x)], 1u);
    return b;
}
__device__ __forceinline__ void xcd_barrier_complete(unsigned* bar, unsigned x, unsigned& nloc, unsigned& nx) {
    const unsigned G = gridDim.x * gridDim.y * gridDim.z;
    unsigned sum, cnt, mine, sp = 0u;
    for (;;) {
        sum = 0u; cnt = 0u; mine = 0u;
#pragma unroll
        for (unsigned j = 0; j < 16; ++j) { const unsigned c = xb_ld(&bar[XB_XCNT(j)]); sum += c; cnt += (c > 0u) ? 1u : 0u; mine = (j == x) ? c : mine; }
        if (sum == G) break;
        __builtin_amdgcn_s_sleep(1);
        if ((++sp & 255u) == 0u) { if (xb_ld(&bar[XB_TMO])) break; if (sp > XB_SPIN_CAP) { atomicAdd(&bar[XB_TMO], 1u); break; } }
    }
    nloc = mine > 0u ? mine : 1u; nx = cnt > 0u ? cnt : 1u;
}

__device__ __forceinline__ void xcd_barrier(const XcdBarrier& b) {
    asm volatile("s_waitcnt vmcnt(0)" ::: "memory");
    __syncthreads();
    if (threadIdx.x == 0) {
        unsigned* bar = b.bar;
        __builtin_amdgcn_s_waitcnt(0);
        unsigned nloc = b.st[0], nx = b.st[1];
        if (nloc == 0u) { xcd_barrier_complete(bar, b.x, nloc, nx); b.st[0] = nloc; b.st[1] = nx; }
        const unsigned old = xb_add(&bar[XB_XSUB(b.x)], 1u);
        const unsigned gen = old / nloc;
        if (old + 1u == (gen + 1u) * nloc) {
            __builtin_amdgcn_fence(__ATOMIC_RELEASE, "agent");
            asm volatile("s_waitcnt vmcnt(0)" ::: "memory");
            const unsigned og = xb_add(&bar[XB_TOP], 1u);
            const unsigned tg = og / nx;
            if (og + 1u == (tg + 1u) * nx) xb_add(&bar[XB_TOPGEN], 1u);
            else XB_SPIN(xb_ld(&bar[XB_TOPGEN]) == tg, bar);
            __builtin_amdgcn_fence(__ATOMIC_ACQUIRE, "agent");
            xb_add(&bar[XB_XGEN(b.x)], 1u);
            asm volatile("s_waitcnt vmcnt(0)" ::: "memory");
        } else {
            XB_SPIN(xb_ld(&bar[XB_XGEN(b.x)]) == gen, bar);
            __builtin_amdgcn_fence(__ATOMIC_ACQUIRE, "agent");
            asm volatile("s_waitcnt vmcnt(0)" ::: "memory");
        }
    }
    __syncthreads();
}
typedef float f32x2v __attribute__((ext_vector_type(2)));
typedef pg8::u32x4 u32x4;
typedef unsigned u32x2v __attribute__((ext_vector_type(2)));
typedef unsigned short bf16x8us __attribute__((ext_vector_type(8)));
__device__ __forceinline__ unsigned cvtpk(float lo, float hi) { unsigned r; asm volatile("v_cvt_pk_bf16_f32 %0, %1, %2" : "=v"(r) : "v"(lo), "v"(hi)); return r; }
__device__ __forceinline__ float bf2f(unsigned short b) { return __builtin_bit_cast(float, (unsigned)b << 16); }
__device__ __forceinline__ float bflo(unsigned w) { return __builtin_bit_cast(float, w << 16); }
__device__ __forceinline__ float bfhi(unsigned w) { return __builtin_bit_cast(float, w & 0xffff0000u); }
__device__ __forceinline__ float wave_sum(float v) {
#pragma unroll
    for (int o = 1; o < 64; o <<= 1) v += __shfl_xor(v, o);
    return v;
}
struct Ctx { LAS unsigned char* lds; int tid, lane, wave, vcu, G; };

struct P0Item { const float* W; const float* gsc; bf16* WT; int K, N, item; };
__device__ __forceinline__ void p0_item_load(const P0Item& I, int lane, f32x4 (&v)[8]) {
    const int nblk = I.N / 32, kb = I.item / nblk, nb = I.item % nblk, k0 = 64 * kb, n0 = 32 * nb, kr = lane >> 3, c4 = (lane & 7) * 4;
#pragma unroll
    for (int i = 0; i < 8; ++i) v[i] = __builtin_nontemporal_load((const f32x4*)(I.W + (size_t)(k0 + 8 * i + kr) * I.N + n0 + c4));
}
__device__ __forceinline__ void p0_item_store(const P0Item& I, int lane, f32x4 (&v)[8], LAS float* scr) {
    const int nblk = I.N / 32, kb = I.item / nblk, nb = I.item % nblk, k0 = 64 * kb, n0 = 32 * nb, kr = lane >> 3, c4 = (lane & 7) * 4;
    if (I.gsc) {
#pragma unroll
        for (int i = 0; i < 8; ++i) v[i] = v[i] * I.gsc[k0 + 8 * i + kr]; }
#pragma unroll
    for (int i = 0; i < 8; ++i) { LAS float* d = scr + (8 * i + kr) * 33 + c4; d[0] = v[i][0]; d[1] = v[i][1]; d[2] = v[i][2]; d[3] = v[i][3]; }
    LDS_WAIT(); asm volatile("" ::: "memory");
    const int c = lane & 7;
#pragma unroll
    for (int j = 0; j < 4; ++j) { const int n = (lane >> 3) + 8 * j; const LAS float* s = scr + (8 * c) * 33 + n;
        v4u o; o.x = cvtpk(s[0 * 33], s[1 * 33]); o.y = cvtpk(s[2 * 33], s[3 * 33]); o.z = cvtpk(s[4 * 33], s[5 * 33]); o.w = cvtpk(s[6 * 33], s[7 * 33]);
        *(v4u*)(I.WT + (size_t)(n0 + n) * I.K + k0 + 8 * c) = o; }
    LDS_WAIT(); asm volatile("" ::: "memory");
}
struct P0Args { const float *x, *mixg, *mlpg, *w_in, *w_s, *w_outa, *w_qkv, *w_outb, *relb, *w_up, *w_dn; unsigned char* ws; };
__device__ __forceinline__ P0Item p0_item(const P0Args& A, int it) {
    constexpr int I0 = (D / 64) * (2 * D / 32), I1 = (D / 64) * (D / 32), I2 = (D / 64) * (NQKV / 32), I3 = (AW / 64) * (D / 32), I4 = (D / 64) * (FF / 32), I6 = (FF / 64) * (D / 32);
    unsigned char* ws = A.ws; int r = it;
    if (r < I0) return P0Item{A.w_in, A.mixg, (bf16*)(ws + WS_WIN), D, 2 * D, r}; r -= I0;
    if (r < I1) return P0Item{A.w_outa, nullptr, (bf16*)(ws + WS_WOA), D, D, r}; r -= I1;
    if (r < I2) return P0Item{A.w_qkv, A.mixg + D, (bf16*)(ws + WS_WQKV), D, NQKV, r}; r -= I2;
    if (r < I3) return P0Item{A.w_outb, nullptr, (bf16*)(ws + WS_WOB), AW, D, r}; r -= I3;
    if (r < I4) return P0Item{A.w_up, A.mlpg, (bf16*)(ws + WS_WUP), D, FF, r}; r -= I4;
    if (r < I4) return P0Item{A.w_up + (size_t)D * FF, A.mlpg + D, (bf16*)(ws + WS_WUP + 8 * MiB), D, FF, r}; r -= I4;
    if (r < I6) return P0Item{A.w_dn, nullptr, (bf16*)(ws + WS_WDN), FF, D, r}; r -= I6;
    return P0Item{A.w_dn + (size_t)FF * D, nullptr, (bf16*)(ws + WS_WDN + 8 * MiB), FF, D, r};
}
constexpr int P0_I_IN = (D / 64) * (2 * D / 32), P0_I_OA = (D / 64) * (D / 32), P0_I_QKV = (D / 64) * (NQKV / 32), P0_I_OB = (AW / 64) * (D / 32), P0_I_UP = (D / 64) * (FF / 32), P0_I_DN = (FF / 64) * (D / 32);
constexpr int P0_AT_OA = P0_I_IN, P0_AT_UP0 = P0_AT_OA + P0_I_OA + P0_I_QKV + P0_I_OB, P0_AT_UP1 = P0_AT_UP0 + P0_I_UP, P0_AT_DN0 = P0_AT_UP1 + P0_I_UP, P0_AT_DN1 = P0_AT_DN0 + P0_I_DN;
__device__ __forceinline__ void p0_items(const Ctx& C, const P0Args& A, int widx, int wcnt, int a0, int n0, int a1, int n1) {
    LAS float* scr = (LAS float*)(C.lds + RING_OFF + C.wave * 16384);
    const int n = n0 + n1;
#define P0_MAP(j_) ((j_) < n0 ? a0 + (j_) : a1 + ((j_) - n0))
    if (widx < n) {
        f32x4 va[8], vb[8]; P0Item ia = p0_item(A, P0_MAP(widx)); p0_item_load(ia, C.lane, va);
        for (int it = widx; it < n; it += 2 * wcnt) {
            const bool hb = it + wcnt < n; P0Item ib = ia; if (hb) { ib = p0_item(A, P0_MAP(it + wcnt)); p0_item_load(ib, C.lane, vb); }
            p0_item_store(ia, C.lane, va, scr);
            const bool ha = it + 2 * wcnt < n; if (ha) { ia = p0_item(A, P0_MAP(it + 2 * wcnt)); p0_item_load(ia, C.lane, va); }
            if (hb) p0_item_store(ib, C.lane, vb, scr);
        }
    }
#undef P0_MAP
}
__device__ __forceinline__ void p0_prologue(const Ctx& C, const P0Args& A) {
    const int gw = C.vcu * NWAVES + C.wave, NGW = C.G * NWAVES;
    unsigned char* ws = A.ws;
    p0_items(C, A, gw, NGW, 0, P0_I_IN, 0, 0);
    const int gt = (C.vcu * NWAVES + C.wave) * 64 + C.lane, NGT = NGW * 64;
    { bf16* wst = (bf16*)(ws + WS_WST);
      for (int i = gt; i < NGRP * CHUNK * CHUNK; i += NGT) { const int t = (i >> 7) & 127, s = i & 127; const float w = (s <= t) ? A.w_s[i] : 0.f; wst[i] = (bf16)(cvtpk(w, 0.f) & 0xffffu); } }
    { float* lut = (float*)(ws + WS_LUT);
      for (int i = gt; i < 24 * LUT_N; i += NGT) { const int gh = i / LUT_N, idx = i % LUT_N, g = gh >> 3, rel = idx - 16; float v = 0.f;
          if (rel >= 0 && rel <= 128) { const int dil = (g == 0) ? 1 : (g == 1) ? 4 : 16; const int dist = rel * dil; int bucket;
              if (dist < 16) bucket = dist; else { const float nf = (float)dist; int lg = 16 + (int)(logf(nf / 16.0f) / 4.852030263919617f * 16.0f); bucket = lg < 31 ? lg : 31; }
              v = A.relb[bucket * 24 + gh] * LOG2E; }
          lut[i] = v; } }
    { bf16* xn = (bf16*)(ws + WS_XN); float* ssq = (float*)(ws + WS_SSQ);
      f32x4 v0[4], v1[4];
      if (gw < M) {
#pragma unroll
          for (int j = 0; j < 4; ++j) v0[j] = __builtin_nontemporal_load(((const f32x4*)(A.x + (size_t)gw * D) + C.lane) + 64 * j); }
#define P0_ROW(m_, v_) do { float s_ = 0.f; _Pragma("unroll") for (int j = 0; j < 4; ++j) s_ += (v_[j][0] * v_[j][0] + v_[j][1] * v_[j][1]) + (v_[j][2] * v_[j][2] + v_[j][3] * v_[j][3]); \
          u32x2v* o_ = (u32x2v*)(xn + (size_t)(m_) * D) + C.lane; _Pragma("unroll") for (int j = 0; j < 4; ++j) o_[64 * j] = (u32x2v){cvtpk(v_[j][0], v_[j][1]), cvtpk(v_[j][2], v_[j][3])}; \
          s_ = wave_sum(s_); if (C.lane < 16) ssq[(size_t)(m_) * 16 + C.lane] = (C.lane == 0) ? s_ : 0.f; } while (0)
      for (int m = gw; m < M; m += 2 * NGW) {
          const bool hb = m + NGW < M;
          if (hb) {
#pragma unroll
              for (int j = 0; j < 4; ++j) v1[j] = __builtin_nontemporal_load(((const f32x4*)(A.x + (size_t)(m + NGW) * D) + C.lane) + 64 * j); }
          P0_ROW(m, v0);
          if (m + 2 * NGW < M) {
#pragma unroll
              for (int j = 0; j < 4; ++j) v0[j] = __builtin_nontemporal_load(((const f32x4*)(A.x + (size_t)(m + 2 * NGW) * D) + C.lane) + 64 * j); }
          if (hb) P0_ROW(m + NGW, v1);
      }
#undef P0_ROW
    }
}

constexpr int G_VT = 0, G_WS = 32768, G_BS = G_WS + 128 * 136 * 2, G_BUF = G_BS + 512, G_STAT = 2 * G_BUF, G_LN = G_STAT + 1024;
static_assert(G_LN + 12288 <= LDSCTL_OFF, "gating LDS map");
__device__ __forceinline__ int vt_off(int c, int s) { return c * 128 + ((((s >> 3) ^ (c & 7) ^ ((c >> 3) & 15)) & 15) << 3) + (s & 7); }
__device__ __forceinline__ void p2_gating(const Ctx& C, int chunk0, unsigned char* big, const float* vst, const bf16* wst, const float* lng, const float* lnb, const float* bs) {
    LAS f32x2v* STAT = (LAS f32x2v*)(C.lds + G_STAT); LAS float* LNP = (LAS float*)(C.lds + G_LN);
    const int tid = C.tid, lane = C.lane, w = C.wave, r16 = lane & 15, qq = lane >> 4;
    const int cc = tid & 15;
    for (int chunk = chunk0; chunk < chunk0 + 1; ++chunk) {
        const size_t tok0 = (size_t)chunk * CHUNK;
        const bf16* UVc = (const bf16*)(big + (size_t)(chunk >> 1) * BLK) + (size_t)(chunk & 1) * CHUNK * (2 * D);
        bf16* UGc = (bf16*)(big + (size_t)(chunk >> 1) * BLK + BLK_UG) + (size_t)(chunk & 1) * CHUNK * D;
        __syncthreads();
        { const int row = tid >> 2, part = tid & 3; const f32x4* pp = (const f32x4*)(vst + ((tok0 + row) * 16 + part * 4) * 2);
          const f32x4 a = pp[0], b = pp[1]; float s1 = (a[0] + a[2]) + (b[0] + b[2]), s2 = (a[1] + a[3]) + (b[1] + b[3]);
          s1 += __shfl_xor(s1, 1); s1 += __shfl_xor(s1, 2); s2 += __shfl_xor(s2, 1); s2 += __shfl_xor(s2, 2);
          const float mean = s1 * (1.0f / 1024.0f), var = s2 * (1.0f / 1024.0f) - mean * mean;
          if (part == 0) STAT[row] = (f32x2v){mean, __builtin_amdgcn_rsqf(fmaxf(var, 0.f) + EPS)}; }
        { *(LAS f32x2v*)(LNP + tid * 2) = *(const f32x2v*)(lng + tid * 2); *(LAS f32x2v*)(LNP + 1024 + tid * 2) = *(const f32x2v*)(lnb + tid * 2); *(LAS f32x2v*)(LNP + 2048 + tid * 2) = *(const f32x2v*)(bs + tid * 2); }
        v4u vraw[2][4], wraw[4]; u32x2v uu[2][8];
#define P2_LOADW(g) do { _Pragma("unroll") for (int i = 0; i < 4; ++i) { const int id_ = tid + 512 * i; wraw[i] = *(const v4u*)(wst + (size_t)(g) * 16384 + (id_ >> 4) * 128 + (id_ & 15) * 8); } } while (0)
#define P2_LOADV(g, set) do { _Pragma("unroll") for (int i = 0; i < 4; ++i) vraw[set][i] = *(const v4u*)(UVc + (size_t)((tid >> 4) + 32 * i) * (2 * D) + D + (g) * 128 + cc * 8); } while (0)
#define P2_LOADU(g, set) do { _Pragma("unroll") for (int tt = 0; tt < 8; ++tt) uu[set][tt] = *(const u32x2v*)(UVc + (size_t)(16 * tt + r16) * (2 * D) + (g) * 128 + 16 * w + 4 * qq); } while (0)
#define P2_WRITE(g, buf, set) do { LAS bf16* VT_ = (LAS bf16*)(C.lds + (buf) * G_BUF + G_VT); LAS bf16* WS_ = (LAS bf16*)(C.lds + (buf) * G_BUF + G_WS); \
        const LAS f32x4* lp_ = (const LAS f32x4*)(LNP + (g) * 128 + cc * 8); const f32x4 g0 = lp_[0], g1 = lp_[1], b0 = lp_[256], b1 = lp_[257]; \
        _Pragma("unroll") for (int i = 0; i < 4; ++i) { const int s = (tid >> 4) + 32 * i; const f32x2v st = STAT[s]; const v4u raw = vraw[set][i]; \
            const float v[8] = {bflo(raw.x), bfhi(raw.x), bflo(raw.y), bfhi(raw.y), bflo(raw.z), bfhi(raw.z), bflo(raw.w), bfhi(raw.w)}; \
            _Pragma("unroll") for (int j = 0; j < 8; ++j) { const float gg = j < 4 ? g0[j & 3] : g1[j & 3], bb = j < 4 ? b0[j & 3] : b1[j & 3]; \
                const float y = (v[j] - st.x) * st.y * gg + bb; VT_[vt_off(cc * 8 + j, s)] = (bf16)(cvtpk(y, 0.f) & 0xffffu); } \
            const int id_ = tid + 512 * i; *(LAS v4u*)(WS_ + (id_ >> 4) * 136 + (id_ & 15) * 8) = wraw[i]; } } while (0)
        P2_LOADW(0); P2_LOADV(0, 0); P2_LOADV(1, 1); P2_LOADU(0, 0);
        __syncthreads();
        P2_WRITE(0, 0, 0);
        P2_LOADW(1); P2_LOADV(2, 0); P2_LOADU(1, 1);
        __syncthreads();
#define P2_BODY(g, PAR) do { \
            const LAS bf16* VT = (const LAS bf16*)(C.lds + (PAR) * G_BUF + G_VT); const LAS bf16* WS = (const LAS bf16*)(C.lds + (PAR) * G_BUF + G_WS); const LAS float* BS = LNP + 2048 + (g) * 128; \
              \
            bf16x8 xf[4]; \
            _Pragma("unroll") for (int ks = 0; ks < 4; ++ks) xf[ks] = *(const LAS bf16x8*)(VT + vt_off(16 * w + r16, 32 * ks + 8 * qq)); \
            _Pragma("unroll") for (int tt = 0; tt < 8; ++tt) { \
                f32x4 acc = (f32x4){0.f, 0.f, 0.f, 0.f}; \
                _Pragma("unroll") for (int ks = 0; ks <= tt / 2; ++ks) { const bf16x8 yf = *(const LAS bf16x8*)(WS + (16 * tt + r16) * 136 + 32 * ks + 8 * qq); \
                    acc = __builtin_amdgcn_mfma_f32_16x16x32_bf16(xf[ks], yf, acc, 0, 0, 0); } \
                const int t = 16 * tt + r16; const float bsv = BS[t]; const u32x2v uv_ = uu[PAR][tt]; \
                const float o0 = bflo(uv_.x) * (acc[0] + bsv), o1 = bfhi(uv_.x) * (acc[1] + bsv), o2 = bflo(uv_.y) * (acc[2] + bsv), o3 = bfhi(uv_.y) * (acc[3] + bsv); \
                *(u32x2v*)(UGc + (size_t)t * D + (g) * 128 + 16 * w + 4 * qq) = (u32x2v){cvtpk(o0, o1), cvtpk(o2, o3)}; \
            } \
            if ((g) + 1 < NGRP) P2_WRITE((g) + 1, (PAR) ^ 1, (PAR) ^ 1);        \
            if ((g) + 2 < NGRP) P2_LOADW((g) + 2); \
            if ((g) + 3 < NGRP) P2_LOADV((g) + 3, (PAR) ^ 1); \
            if ((g) + 2 < NGRP) P2_LOADU((g) + 2, PAR); \
            __syncthreads(); } while (0)
        for (int g = 0; g < NGRP; g += 2) { P2_BODY(g, 0); P2_BODY(g + 1, 1); }
#undef P2_BODY
#undef P2_LOADW
#undef P2_LOADV
#undef P2_LOADU
#undef P2_WRITE
    }
    __syncthreads();
}
constexpr int A_SLOT = 32768, A_VOFF = 16384, A_QOFF = 4 * A_SLOT, A_LUT = A_QOFF + 16384;
static_assert(A_LUT + 1024 <= LDSCTL_OFF, "attention LDS map");
constexpr int ATT_UNITS = 3 * BATCH * NH * 64;
typedef short v4i16_t __attribute__((ext_vector_type(4)));
__device__ __forceinline__ u32x2v tr16(const LAS bf16* p) { return __builtin_bit_cast(u32x2v, __builtin_amdgcn_ds_read_tr16_b64_v4i16((LAS v4i16_t*)p)); }
__device__ __forceinline__ float max3f(float a, float b, float c) { float r; asm("v_max3_f32 %0, %1, %2, %3" : "=v"(r) : "v"(a), "v"(b), "v"(c)); return r; }
struct AU { int g, b, h, r, n, dil; };
__device__ __forceinline__ AU att_decode(int U) { AU a; a.g = U >> 11; const int rem = U & 2047; a.b = rem >> 9; a.h = (rem >> 6) & 7; const int rn = rem & 63;
    a.dil = (a.g == 0) ? 1 : (a.g == 1) ? 4 : 16; const int nb = 64 / a.dil; a.r = rn / nb; a.n = rn % nb; return a; }
template <int VAR> __device__ __forceinline__ void p7_attention(const Ctx& C, bf16* QKV, float* lse, const float* lutg) {
    LAS unsigned char* L = C.lds; LAS float* LUT = (LAS float*)(L + A_LUT);
    const int tid = C.tid, lane = C.lane, w = C.wave, r16 = lane & 15, qq = lane >> 4;
    const int per = (ATT_UNITS + C.G - 1) / C.G;
    const int u_lo = C.vcu * per, u_hi = (u_lo + per < ATT_UNITS) ? u_lo + per : ATT_UNITS;
    if (u_lo >= u_hi) return;
#define ATT_SLICE(a, t) (QKV + ((size_t)((((t) * 3 + (a).g) * 8 + (a).h) * BATCH + (a).b) * SEQ + (size_t)(a).r * (SEQ / (a).dil)) * 64)
    const int drow = lane >> 3, dch = lane & 7;
#define ATT_GLDS(gsrc, ldsoff) do { unsigned keep_; const unsigned ldst_ = (unsigned)__builtin_amdgcn_readfirstlane((int)((unsigned)(uintptr_t)L + (unsigned)(ldsoff))); const bf16* gs_ = (gsrc); \
        asm volatile("s_mov_b32 %0, m0\n\ts_mov_b32 m0, %2\n\ts_nop 0\n\tglobal_load_lds_dwordx4 %1, off\n\ts_mov_b32 m0, %0" : "=&s"(keep_) : "v"(gs_), "s"(ldst_) : "memory"); } while (0)
#define ATT_DMA_BLOCK(a, nblk, slot) do { _Pragma("unroll") for (int j_ = 0; j_ < 2; ++j_) { const int row_ = 16 * w + 8 * j_ + drow; \
        const size_t go_ = (size_t)((nblk) * 128 + row_) * 64 + ((dch ^ ((row_ >> 1) & 7)) << 3); const int lo_ = (slot) * A_SLOT + (16 * w + 8 * j_) * 128; \
        ATT_GLDS(ATT_SLICE(a, 1) + go_, lo_); ATT_GLDS(ATT_SLICE(a, 2) + go_, lo_ + A_VOFF); } } while (0)
#define ATT_LDQ(a, q0, q1) do { const bf16* qp_ = ATT_SLICE(a, 0) + (size_t)((a).n * 128 + 16 * w + r16) * 64 + 8 * qq; \
        asm volatile("global_load_dwordx4 %0, %2, off\n\tglobal_load_dwordx4 %1, %2, off offset:64" : "=&v"(q0), "=&v"(q1) : "v"(qp_) : "memory"); } while (0)
#define ATT_WAITBAR_Q(N, q0, q1) do { asm volatile("s_waitcnt vmcnt(" #N ") lgkmcnt(0)" : "+v"(q0), "+v"(q1) :: "memory"); __builtin_amdgcn_s_barrier(); asm volatile("" ::: "memory"); } while (0)
#define ATT_WAITBAR(N) do { asm volatile("s_waitcnt vmcnt(" #N ") lgkmcnt(0)" ::: "memory"); __builtin_amdgcn_s_barrier(); asm volatile("" ::: "memory"); } while (0)
    AU cu = att_decode(u_lo);
    u32x4 qreg[2][2];
    {
      __builtin_amdgcn_s_waitcnt(0x0F70);
      __builtin_amdgcn_s_barrier();
      if (cu.n > 0) { ATT_DMA_BLOCK(cu, cu.n - 1, 3); }
      else { _Pragma("unroll") for (int i = 0; i < 4; ++i) *(LAS v4u*)(L + 3 * A_SLOT + (tid + 512 * i) * 16) = (v4u){0u, 0u, 0u, 0u};
             _Pragma("unroll") for (int j_ = 0; j_ < 4; ++j_) ATT_GLDS(ATT_SLICE(cu, 1) + (size_t)lane * 8, 2 * A_SLOT + (16 * w + 8 * (j_ & 1)) * 128 + (j_ >> 1) * A_VOFF); }
      ATT_DMA_BLOCK(cu, cu.n, 0);
      const AU n1 = att_decode(u_lo + 1 < u_hi ? u_lo + 1 : u_lo);
      ATT_LDQ(cu, qreg[0][0], qreg[0][1]); ATT_LDQ(n1, qreg[1][0], qreg[1][1]);
      ATT_DMA_BLOCK(n1, n1.n, 1);
      if (tid < LUT_N) LUT[tid] = lutg[(cu.g * 8 + cu.h) * LUT_N + tid];
      asm volatile("s_waitcnt vmcnt(4)" : "+v"(qreg[0][0]), "+v"(qreg[0][1]) :: "memory");
      ATT_WAITBAR_Q(4, qreg[1][0], qreg[1][1]); }
    for (int U0 = u_lo; U0 < u_hi; U0 += 2) {
#pragma unroll
      for (int par = 0; par < 2; ++par) {
        const int U = U0 + par; if (U >= u_hi) break;
        const int ui = U - u_lo;
        const AU nx = att_decode(U + 1 < u_hi ? U + 1 : U), nx2 = att_decode(U + 2 < u_hi ? U + 2 : U);
        const int pbase = ((ui + 3) & 3) * A_SLOT, cbase = (ui & 3) * A_SLOT;
        const bf16x8 qf[2] = {__builtin_bit_cast(bf16x8, qreg[par][0]), __builtin_bit_cast(bf16x8, qreg[par][1])};
        if constexpr (VAR < 3) {
        ATT_DMA_BLOCK(nx2, nx2.n, (ui + 2) & 3);
        }
        f32x4 o[4]; float mx = 0.f, lsum = 1.f;
        if constexpr (VAR == 2) { _Pragma("unroll") for (int dt = 0; dt < 4; ++dt) { o[dt] = (f32x4){qf[0][0] * 1.0f, 0.f, 0.f, 0.f}; } } else {
        f32x4 s[9];
#pragma unroll
        for (int kt = 0; kt < 9; ++kt) { const int kk0 = 16 * w + 16 * kt, row = (kk0 & 127) + r16, sw = (row >> 1) & 7;
            const LAS unsigned char* kp = L + (kk0 < 128 ? pbase : cbase) + row * 128;
            const bf16x8 k0 = *(const LAS bf16x8*)(kp + ((qq ^ sw) << 4)), k1 = *(const LAS bf16x8*)(kp + (((qq + 4) ^ sw) << 4));
            f32x4 a = (f32x4){0.f, 0.f, 0.f, 0.f};
            a = __builtin_amdgcn_mfma_f32_16x16x32_bf16(k0, qf[0], a, 0, 0, 0);
            a = __builtin_amdgcn_mfma_f32_16x16x32_bf16(k1, qf[1], a, 0, 0, 0); s[kt] = a; }
        if constexpr (VAR < 3) { ATT_LDQ(nx2, qreg[par][0], qreg[par][1]); }
        const float SC = 0.125f * LOG2E, NEG = -1e30f;
        const LAS float* lp = LUT + (144 + r16 - 4 * qq);
#pragma unroll
        for (int kt = 0; kt < 9; ++kt)
#pragma unroll
            for (int j = 0; j < 4; ++j) { float t = s[kt][j] * SC + lp[-(16 * kt + j)];
                if (kt == 0) t = (4 * qq + j >= r16) ? t : NEG;
                if (kt == 8) t = (4 * qq + j <= r16) ? t : NEG;
                s[kt][j] = t; }
        if (cu.n == 0) {
#pragma unroll
            for (int kt = 0; kt < 8; ++kt) if (kt < 8 - w) { s[kt] = (f32x4){NEG, NEG, NEG, NEG}; asm volatile("" : "+v"(s[kt])); } }
        { float a_ = max3f(s[0][0], s[0][1], s[0][2]), b_ = max3f(s[0][3], s[1][0], s[1][1]);
#pragma unroll
          for (int kt = 1; kt < 9; ++kt) { if (kt & 1) { a_ = max3f(a_, s[kt][2], s[kt][3]); if (kt + 1 < 9) b_ = max3f(b_, s[kt + 1][0], s[kt + 1][1]); }
                                           else { a_ = max3f(a_, s[kt][2], s[kt][3]); if (kt + 1 < 9) b_ = max3f(b_, s[kt + 1][0], s[kt + 1][1]); } }
          mx = fmaxf(a_, b_); }
        mx = fmaxf(mx, __shfl_xor(mx, 16)); mx = fmaxf(mx, __shfl_xor(mx, 32));
#pragma unroll
        for (int kt = 0; kt < 9; ++kt)
#pragma unroll
            for (int j = 0; j < 4; ++j) s[kt][j] = __builtin_amdgcn_exp2f(s[kt][j] - mx);
        f32x4 osum = (f32x4){0.f, 0.f, 0.f, 0.f};
        const bf16x8 ones = (bf16x8){0x3F80, 0x3F80, 0x3F80, 0x3F80, 0x3F80, 0x3F80, 0x3F80, 0x3F80};
        const int vrow = 4 * qq + (r16 >> 2), vc = (r16 & 3) >> 1, vh = (r16 & 1) * 8;
#pragma unroll
        for (int dt = 0; dt < 4; ++dt) o[dt] = (f32x4){0.f, 0.f, 0.f, 0.f};
#pragma unroll
        for (int ks = 0; ks < 5; ++ks) {
            u32x4 pw; pw.x = cvtpk(s[2 * ks][0], s[2 * ks][1]); pw.y = cvtpk(s[2 * ks][2], s[2 * ks][3]);
            if (ks < 4) { pw.z = cvtpk(s[2 * ks + 1][0], s[2 * ks + 1][1]); pw.w = cvtpk(s[2 * ks + 1][2], s[2 * ks + 1][3]); } else { pw.z = 0u; pw.w = 0u; }
            const bf16x8 pf = __builtin_bit_cast(bf16x8, pw);
            osum = __builtin_amdgcn_mfma_f32_16x16x32_bf16(ones, pf, osum, 0, 0, 0);
            const int ka = 16 * w + 32 * ks, kb = ka + 16;
            const int rowa = (ka & 127) + vrow, rowb = (kb & 127) + vrow, swa = (rowa >> 1) & 7, swb = (rowb >> 1) & 7;
            const LAS unsigned char* pa = L + (ka < 128 ? pbase : cbase) + A_VOFF + rowa * 128 + vh; const LAS unsigned char* pb = L + (kb < 128 ? pbase : cbase) + A_VOFF + rowb * 128 + vh;
#pragma unroll
            for (int dt = 0; dt < 4; ++dt) {
                const u32x2v lo = tr16((const LAS bf16*)(pa + (((2 * dt + vc) ^ swa) << 4)));
                u32x2v hi = (u32x2v){0u, 0u}; if (ks < 4) hi = tr16((const LAS bf16*)(pb + (((2 * dt + vc) ^ swb) << 4)));
                const u32x4 vw = (u32x4){lo.x, lo.y, hi.x, hi.y};
                o[dt] = __builtin_amdgcn_mfma_f32_16x16x32_bf16(__builtin_bit_cast(bf16x8, vw), pf, o[dt], 0, 0, 0); } }
        lsum = osum[0]; }
        const float inv = 1.0f / lsum;
        bf16* op = ATT_SLICE(cu, 0) + (size_t)(cu.n * 128 + 16 * w + r16) * 64 + 4 * qq;
        if constexpr (VAR == 4) { asm volatile("" :: "v"(o[0]), "v"(o[1]), "v"(o[2]), "v"(o[3]), "v"(inv), "v"(mx)); } else {
#pragma unroll
        for (int dt = 0; dt < 4; ++dt)
            *(u32x2v*)(op + 16 * dt) = (u32x2v){cvtpk(o[dt][0] * inv, o[dt][1] * inv), cvtpk(o[dt][2] * inv, o[dt][3] * inv)};
        }
        if (VAR != 4 && qq == 0) lse[((size_t)cu.g * M + (size_t)cu.b * SEQ + (size_t)((cu.n * 128 + 16 * w + r16) * cu.dil + cu.r)) * NH + cu.h] = mx + log2f(lsum);
        if ((nx.g * 8 + nx.h) != (cu.g * 8 + cu.h)) {
            ATT_WAITBAR_Q(11, qreg[par ^ 1][0], qreg[par ^ 1][1]); if (tid < LUT_N) LUT[tid] = lutg[(nx.g * 8 + nx.h) * LUT_N + tid]; ATT_WAITBAR(0); }
        else ATT_WAITBAR_Q(11, qreg[par ^ 1][0], qreg[par ^ 1][1]);
        cu = nx;
      }
    }
    ATT_WAITBAR(0);
#undef ATT_SLICE
#undef ATT_GLDS
#undef ATT_DMA_BLOCK
#undef ATT_LDQ
#undef ATT_WAITBAR_Q
#undef ATT_WAITBAR
}
__device__ __forceinline__ void p8_merge(const Ctx& C, int row_lo, const bf16* QKV, const float* lse, bf16* OM) {
    for (int idx = row_lo * 64 + C.tid; idx < (row_lo + 128) * 64; idx += NWAVES * 64) { const int tok = idx >> 6, cch = idx & 63, h = cch >> 3;
        const float l0 = lse[((size_t)0 * M + tok) * NH + h], l1 = lse[((size_t)1 * M + tok) * NH + h], l2 = lse[((size_t)2 * M + tok) * NH + h];
        const float mx = fmaxf(l0, fmaxf(l1, l2)); float w0 = __builtin_amdgcn_exp2f(l0 - mx), w1 = __builtin_amdgcn_exp2f(l1 - mx), w2 = __builtin_amdgcn_exp2f(l2 - mx);
        const float inv = 1.0f / (w0 + w1 + w2); w0 *= inv; w1 *= inv; w2 *= inv;
        const int b = tok >> 13, pos = tok & (SEQ - 1);
        const size_t hs = (size_t)BATCH * SEQ * 64;
        const bf16* base = QKV + ((size_t)b * SEQ) * 64 + (cch & 7) * 8;
        const v4u a = *(const v4u*)(base + (size_t)(0 * 8 + h) * hs + (size_t)pos * 64);
        const v4u bb = *(const v4u*)(base + (size_t)(1 * 8 + h) * hs + ((size_t)(pos & 3) * (SEQ / 4) + (pos >> 2)) * 64);
        const v4u c = *(const v4u*)(base + (size_t)(2 * 8 + h) * hs + ((size_t)(pos & 15) * (SEQ / 16) + (pos >> 4)) * 64);
        v4u o;
        o.x = cvtpk(w0 * bflo(a.x) + w1 * bflo(bb.x) + w2 * bflo(c.x), w0 * bfhi(a.x) + w1 * bfhi(bb.x) + w2 * bfhi(c.x));
        o.y = cvtpk(w0 * bflo(a.y) + w1 * bflo(bb.y) + w2 * bflo(c.y), w0 * bfhi(a.y) + w1 * bfhi(bb.y) + w2 * bfhi(c.y));
        o.z = cvtpk(w0 * bflo(a.z) + w1 * bflo(bb.z) + w2 * bflo(c.z), w0 * bfhi(a.z) + w1 * bfhi(bb.z) + w2 * bfhi(c.z));
        o.w = cvtpk(w0 * bflo(a.w) + w1 * bflo(bb.w) + w2 * bflo(c.w), w0 * bfhi(a.w) + w1 * bfhi(bb.w) + w2 * bfhi(c.w));
        *(v4u*)(OM + (size_t)tok * AW + cch * 8) = o; }
}
__device__ __forceinline__ void p12_final(const Ctx& C, int row_lo, const bf16* hb, float* out, const float* ssq, const float* gfin) {
    f32x4 gv[4];
#pragma unroll
    for (int j = 0; j < 4; ++j) gv[j] = ((const f32x4*)gfin)[C.lane + 64 * j];
    for (int m = row_lo + C.wave; m < row_lo + 128; m += NWAVES) {
        float s = ssq[(size_t)m * 16 + (C.lane & 15)];
        const u32x2v* hr = (const u32x2v*)(hb + (size_t)m * D) + C.lane; u32x2v v[4];
#pragma unroll
        for (int j = 0; j < 4; ++j) v[j] = hr[64 * j];
        s += __shfl_xor(s, 1); s += __shfl_xor(s, 2); s += __shfl_xor(s, 4); s += __shfl_xor(s, 8);
        const float rs = __builtin_amdgcn_rsqf(s * (1.0f / 1024.0f) + EPS);
        f32x4* xr = (f32x4*)(out + (size_t)m * D) + C.lane;
#pragma unroll
        for (int j = 0; j < 4; ++j) xr[64 * j] = (f32x4){bflo(v[j].x), bfhi(v[j].x), bflo(v[j].y), bfhi(v[j].y)} * rs * gv[j]; }
}
__device__ __forceinline__ void gate_arrive(unsigned* cnt) { if (threadIdx.x == 0) (void)__hip_atomic_fetch_add(cnt, 1u, __ATOMIC_RELAXED, __HIP_MEMORY_SCOPE_AGENT); }
struct GrpBar { unsigned* cnt; unsigned phase; unsigned same; };
__device__ __forceinline__ void grp_barrier(GrpBar& b) {
    asm volatile("s_waitcnt vmcnt(0)" ::: "memory");
    __syncthreads();
    if (threadIdx.x == 0) {
        if (!b.same) { __builtin_amdgcn_fence(__ATOMIC_RELEASE, "agent"); asm volatile("s_waitcnt vmcnt(0)" ::: "memory"); }
        const unsigned target = (b.phase + 1u) * 4u;
        (void)__hip_atomic_fetch_add(b.cnt, 1u, __ATOMIC_RELAXED, __HIP_MEMORY_SCOPE_AGENT);
        unsigned sp = 0u;
        while (__hip_atomic_load(b.cnt, __ATOMIC_RELAXED, __HIP_MEMORY_SCOPE_AGENT) < target) { __builtin_amdgcn_s_sleep(1); if (++sp > (1u << 22)) break; }
        __builtin_amdgcn_fence(__ATOMIC_ACQUIRE, "agent"); asm volatile("s_waitcnt vmcnt(0)" ::: "memory");
    }
    __syncthreads();
    ++b.phase;
}
namespace pg8 {
struct EpiFinal {
    static constexpr bool PERM = true, AFTER_DRAIN = false;
    const bf16_t* hb; float* out; float* ssq; const float* gfin; int ldc; GrpBar* gb;
    __device__ __forceinline__ void operator()(f32x4 (&acc)[2][2][4][2], const Unit& u, int wr, int wc, int fr, int fq) const {
        const int row0 = u.pm * BM + wr * 64 + fr, col0 = u.pn * BM + wc * 32 + 8 * fq;
        { u32x4 r[2][4][2];
#pragma unroll
          for (int ai = 0; ai < 2; ++ai)
#pragma unroll
              for (int m = 0; m < 4; ++m)
#pragma unroll
                  for (int bj = 0; bj < 2; ++bj) r[ai][m][bj] = *(const u32x4*)(hb + (size_t)(row0 + ai * HALF + m * 16) * ldc + col0 + bj * HALF);
          asm volatile("s_waitcnt vmcnt(0)" ::: "memory");
#pragma unroll
          for (int ai = 0; ai < 2; ++ai)
#pragma unroll
              for (int m = 0; m < 4; ++m) { float q = 0.f;
#pragma unroll
                  for (int bj = 0; bj < 2; ++bj) { const u32x4 rr = r[ai][m][bj];
                      acc[ai][bj][m][0] += (f32x4){bf_lo(rr.x), bf_hi(rr.x), bf_lo(rr.y), bf_hi(rr.y)}; acc[ai][bj][m][1] += (f32x4){bf_lo(rr.z), bf_hi(rr.z), bf_lo(rr.w), bf_hi(rr.w)};
                      const f32x4 h0 = acc[ai][bj][m][0], h1 = acc[ai][bj][m][1];
                      q += ((h0[0] * h0[0] + h0[1] * h0[1]) + (h0[2] * h0[2] + h0[3] * h0[3])) + ((h1[0] * h1[0] + h1[1] * h1[1]) + (h1[2] * h1[2] + h1[3] * h1[3])); }
                  q += __shfl_xor(q, 16); q += __shfl_xor(q, 32);
                  if (fq == 0) ssq[(size_t)(row0 + ai * HALF + m * 16) * 16 + u.pn * 4 + wc] = q; } }
        f32x4 gv[2][2];
#pragma unroll
        for (int bj = 0; bj < 2; ++bj)
#pragma unroll
            for (int n = 0; n < 2; ++n) gv[bj][n] = *(const f32x4*)(gfin + col0 + bj * HALF + 4 * n);
        grp_barrier(*gb);
        f32x4 p[2][4];
#pragma unroll
        for (int ai = 0; ai < 2; ++ai)
#pragma unroll
            for (int m = 0; m < 4; ++m) p[ai][m] = *(const f32x4*)(ssq + (size_t)(row0 + ai * HALF + m * 16) * 16 + fq * 4);
#pragma unroll
        for (int ai = 0; ai < 2; ++ai)
#pragma unroll
            for (int m = 0; m < 4; ++m) { float s = (p[ai][m][0] + p[ai][m][1]) + (p[ai][m][2] + p[ai][m][3]);
                s += __shfl_xor(s, 16); s += __shfl_xor(s, 32);
                const float rs = __builtin_amdgcn_rsqf(s * (1.0f / 1024.0f) + 1e-6f);
                float* orow = out + (size_t)(row0 + ai * HALF + m * 16) * ldc + col0;
#pragma unroll
                for (int bj = 0; bj < 2; ++bj) { *(f32x4*)(orow + bj * HALF) = acc[ai][bj][m][0] * rs * gv[bj][0]; *(f32x4*)(orow + bj * HALF + 4) = acc[ai][bj][m][1] * rs * gv[bj][1]; } }
    }
};
}
struct Args { const float* in[15]; float* out; unsigned char* ws; int ph_lo, ph_hi; };
__global__ void __launch_bounds__(NWAVES * 64, 2) trunk_fwd(Args args) {
    extern __shared__ __attribute__((aligned(16))) unsigned char lds[];
    Ctx C;
    C.lds = (LAS unsigned char*)lds;
    volatile LAS unsigned* MISC = (volatile LAS unsigned*)(C.lds + MISC_OFF);
    C.tid = threadIdx.x; C.lane = C.tid & 63; C.wave = __builtin_amdgcn_readfirstlane(C.tid >> 6);
    C.G = gridDim.x; { const int bx = blockIdx.x; C.vcu = (C.G % 8 == 0) ? (bx % 8) * (C.G / 8) + bx / 8 : bx; }
    const int gx = (int)blockIdx.x % 8, k8 = ((int)blockIdx.x / 8) % 8, gz = (int)blockIdx.x / 64;
    const int item_row = (16 * gx + 8 * (gz >> 1) + k8) * 256 + (gz & 1) * 128;
    unsigned char* ws = args.ws;
    gu32* ctl = (gu32*)(ws + WS_CTL);
    if (C.tid == 0 && !MK_SPLIT) __hip_atomic_store((unsigned*)(ctl + CW_XCC) + blockIdx.x, xb_xcc_id() + 1u, __ATOMIC_RELAXED, __HIP_MEMORY_SCOPE_AGENT);
    unsigned* gate5 = (unsigned*)(ctl + CW_GATE); unsigned* gate8 = (unsigned*)(ctl + CW_GATE + 64);
    GrpBar gbr; gbr.cnt = (unsigned*)(ctl + CW_GRP) + (gx * 8 + k8) * 64; gbr.phase = 0u; gbr.same = 0u;
    const int cls = (gx >> 1) & 1, cwave = ((gz * 8 + k8) * 4 + ((gx & 1) | ((gx >> 2) << 1))) * NWAVES + C.wave;
    unsigned* s1cnt = (unsigned*)(ctl + CW_GATE + 128);
    for (int u = C.tid; u < (LDS_BYTES - LDSCTL_OFF) / 4; u += NWAVES * 64) ((LAS unsigned*)(C.lds + LDSCTL_OFF))[u] = 0u;
    __syncthreads();
    XcdBarrier bar; bar.bar = (unsigned*)(ctl + CW_BAR); bar.x = 0; bar.st = nullptr;
    if (!MK_SPLIT) bar = xcd_barrier_post((unsigned*)(ctl + CW_BAR), MISC + 8);
    const float* x = args.in[0]; const float* mixg = args.in[1]; const float* mlpg = args.in[2]; const float* fing = args.in[3];
    bf16* XN = (bf16*)(ws + WS_XN); unsigned char* big = ws + WS_BIG; bf16* OM = (bf16*)(ws + WS_OM);
    float* SSQ = (float*)(ws + WS_SSQ); float* VST = (float*)(ws + WS_VST); float* LSE = (float*)(ws + WS_LSE);
    float* out = args.out;
    const int lo = args.ph_lo, hi = args.ph_hi; int pos = 0;
#define GSTEP(BODY) do { if (lo <= pos && pos < hi) { BODY } if (lo <= pos && pos + 1 < hi) { for (int rb_ = 0; rb_ < BAR_REPS; ++rb_) xcd_barrier(bar); } ++pos; } while (0)
#define CSTEP(BODY) do { if (lo <= pos && pos < hi) { BODY } if (lo <= pos && pos + 1 < hi) { for (int rb_ = 0; rb_ < BAR_REPS; ++rb_) grp_barrier(gbr); } ++pos; } while (0)
#define STEP(BODY) do { if (lo <= pos && pos < hi) { BODY } if (lo <= pos && pos + 1 < hi) { for (int rb_ = 0; rb_ < BAR_REPS; ++rb_) xcd_barrier(bar); } ++pos; } while (0)
#define P0ARGS P0Args{x, mixg, mlpg, args.in[4], args.in[7], args.in[9], args.in[10], args.in[11], args.in[12], args.in[13], args.in[14], ws}
#define PH0 { const P0Args A = P0ARGS; p0_prologue(C, A); }
#define PH1 { pg8::Gemm g{XN, (const bf16*)(ws + WS_WIN), M, 2 * D, D, (size_t)256 * D * 2}; pg8::StaticOrder S; S.init(M, 2 * D, C.G, (int)blockIdx.x); pg8::EpiAct<1> E{(bf16*)big, 2 * D, BLK / 2, pg8::RsTable{SSQ, (LAS float*)(C.lds + RSTAB_OFF), -1}, VST, pg8::GateW{nullptr, 0u, 0}}; \
        pg8::gemm_phase<pg8::EpiAct<1>, pg8::StaticOrder, true, true>(C.lds + RING_OFF, g, S, E); }
#define PH2 { p2_gating(C, item_row / CHUNK, big, VST, (const bf16*)(ws + WS_WST), args.in[5], args.in[6], args.in[8]); }
#define S1WAIT { if (C.tid == 0) { unsigned sp = 0u; while (__hip_atomic_load(s1cnt, __ATOMIC_RELAXED, __HIP_MEMORY_SCOPE_AGENT) < 128u) { __builtin_amdgcn_s_sleep(2); if (++sp > (1u << 22)) break; } \
        __builtin_amdgcn_fence(__ATOMIC_ACQUIRE, "agent"); asm volatile("s_waitcnt vmcnt(0)" ::: "memory"); } __syncthreads(); }
#define PH3 { S1WAIT pg8::Gemm g{(const bf16*)(big + BLK_UG), (const bf16*)(ws + WS_WOA), M, D, D, BLK}; pg8::StaticOrder S; S.init(M, D, C.G, (int)blockIdx.x); pg8::EpiRes E{XN, SSQ, D}; \
        pg8::gemm_phase<pg8::EpiRes, pg8::StaticOrder, true, true>(C.lds + RING_OFF, g, S, E); }
#define PHUP(L) { pg8::Gemm g{XN, (const bf16*)(ws + WS_WUP + (L) * 8 * MiB), M, FF, D, (size_t)256 * D * 2}; pg8::StaticOrder S; S.init(M, FF, C.G, (int)blockIdx.x); pg8::EpiAct<2> E{(bf16*)big, FF, BLK / 2, pg8::RsTable{SSQ, (LAS float*)(C.lds + RSTAB_OFF), -1}, nullptr, pg8::GateW{(L) ? gate8 : nullptr, (unsigned)C.G, 0}}; \
        pg8::gemm_phase<pg8::EpiAct<2>, pg8::StaticOrder, true, true>(C.lds + RING_OFF, g, S, E); }
#define PHDN(L) { pg8::Gemm g{(const bf16*)big, (const bf16*)(ws + WS_WDN + (L) * 8 * MiB), M, D, FF, BLK}; pg8::StaticOrder S; S.init(M, D, C.G, (int)blockIdx.x); S.reversed(); pg8::EpiRes E{XN, SSQ, D}; \
        pg8::gemm_phase<pg8::EpiRes, pg8::StaticOrder, true, true>(C.lds + RING_OFF, g, S, E); if ((L) == 0) gate_arrive(gate5); }
#define PHFIN { pg8::Gemm g{(const bf16*)big, (const bf16*)(ws + WS_WDN + 8 * MiB), M, D, FF, BLK}; pg8::StaticOrder S; S.init(M, D, C.G, (int)blockIdx.x); S.reversed(); pg8::EpiFinal E{XN, out, SSQ, fing, D, &gbr}; \
        pg8::gemm_phase<pg8::EpiFinal, pg8::StaticOrder, true, true>(C.lds + RING_OFF, g, S, E); }
#define PH6 { pg8::Gemm g{XN, (const bf16*)(ws + WS_WQKV), M, NQKV, D, (size_t)256 * D * 2}; pg8::StaticOrder S; S.init(M, NQKV, C.G, (int)blockIdx.x); pg8::EpiQKV E{(bf16*)big, pg8::RsTable{SSQ, (LAS float*)(C.lds + RSTAB_OFF), -1}, SEQ, BATCH, pg8::GateW{gate5, (unsigned)C.G, 0}}; \
        pg8::gemm_phase<pg8::EpiQKV, pg8::StaticOrder, true, true>(C.lds + RING_OFF, g, S, E); \
        if (cls == 0) { const P0Args A = P0ARGS; p0_items(C, A, cwave, 128 * NWAVES, P0_AT_UP1, P0_I_UP, P0_AT_DN1, P0_I_DN); } }
#define PH6N { pg8::Gemm g{XN, (const bf16*)(ws + WS_WQKV), M, NQKV, D, (size_t)256 * D * 2}; pg8::StaticOrder S; S.init(M, NQKV, C.G, (int)blockIdx.x); pg8::EpiNull E{}; \
        pg8::gemm_phase<pg8::EpiNull, pg8::StaticOrder, true, true>(C.lds + RING_OFF, g, S, E); }
#define PH6S { pg8::Gemm g{XN, (const bf16*)(ws + WS_WQKV), M, NQKV, D, (size_t)256 * D * 2}; pg8::StaticOrder S; S.init(M, NQKV, C.G, (int)blockIdx.x); pg8::EpiStoreOnly E{(bf16*)big, NQKV}; \
        pg8::gemm_phase<pg8::EpiStoreOnly, pg8::StaticOrder, true, true>(C.lds + RING_OFF, g, S, E); }
#define PH7V(v) { p7_attention<v>(C, (bf16*)big, LSE, (const float*)(ws + WS_LUT)); }
#define PH7 { p7_attention<0>(C, (bf16*)big, LSE, (const float*)(ws + WS_LUT)); }
#define PH8 { p8_merge(C, item_row, (const bf16*)big, LSE, OM); __syncthreads(); gate_arrive(gate8); }
#define PH9 { pg8::Gemm g{OM, (const bf16*)(ws + WS_WOB), M, D, AW, (size_t)256 * AW * 2}; pg8::StaticOrder S; S.init(M, D, C.G, (int)blockIdx.x); pg8::EpiRes E{XN, SSQ, D}; \
        pg8::gemm_phase<pg8::EpiRes, pg8::StaticOrder, true, true>(C.lds + RING_OFF, g, S, E); }
#define PH12 { p12_final(C, item_row, XN, out, SSQ, fing); }
#define DUPAT(k) do { if (DUP_AFTER == (k)) { DUP_BODY } } while (0)
    GSTEP(PH0); DUPAT(0);
    if (lo <= 0 && 1 < hi) {
        const unsigned* xw = (const unsigned*)(ctl + CW_XCC) + k8 * 8 + gx;
        const unsigned a0 = __hip_atomic_load(xw, __ATOMIC_RELAXED, __HIP_MEMORY_SCOPE_AGENT), a1 = __hip_atomic_load(xw + 64, __ATOMIC_RELAXED, __HIP_MEMORY_SCOPE_AGENT),
                       a2 = __hip_atomic_load(xw + 128, __ATOMIC_RELAXED, __HIP_MEMORY_SCOPE_AGENT), a3 = __hip_atomic_load(xw + 192, __ATOMIC_RELAXED, __HIP_MEMORY_SCOPE_AGENT);
        gbr.same = (a0 != 0u && a0 == a1 && a0 == a2 && a0 == a3) ? 1u : 0u; }
    if (lo <= 0 && 1 < hi && cls == 1) { const P0Args A = P0ARGS;
        p0_items(C, A, cwave, 128 * NWAVES, P0_AT_OA, P0_AT_UP1 - P0_AT_OA, P0_AT_DN0, P0_I_DN);
        asm volatile("s_waitcnt vmcnt(0)" ::: "memory"); __syncthreads();
        if (C.tid == 0) { __builtin_amdgcn_fence(__ATOMIC_RELEASE, "agent"); asm volatile("s_waitcnt vmcnt(0)" ::: "memory"); (void)__hip_atomic_fetch_add(s1cnt, 1u, __ATOMIC_RELAXED, __HIP_MEMORY_SCOPE_AGENT); } }
    CSTEP(PH1); DUPAT(1);
    CSTEP(PH2); DUPAT(2);
    CSTEP(PH3); DUPAT(3);
    CSTEP(PHUP(0)); DUPAT(4);
    CSTEP(PHDN(0)); DUPAT(5);
    GSTEP(PH6); DUPAT(6);
    GSTEP(PH7); DUPAT(7);
    CSTEP(PH8); DUPAT(8);
    CSTEP(PH9); DUPAT(9);
    CSTEP(PHUP(1)); DUPAT(10);
    CSTEP(PHFIN);
}

extern "C" void kernel_launch(void* const* d_in, const int* in_sizes, int n_in, void* d_out, int out_size, void* d_ws, size_t ws_size, hipStream_t stream) {
    static int grid = 0;
    if (grid == 0) {
        if (n_in != 15 || in_sizes[0] != M * D || out_size != M * D || ws_size < WS_END) { fprintf(stderr, "kernel_launch: shape/workspace mismatch (n_in %d, in0 %d, out %d, ws %zu); nothing launched\n", n_in, n_in > 0 ? in_sizes[0] : -1, out_size, ws_size); grid = -1; return; }
        int dev = 0, cus = 0, per_cu = 0;
        if (hipGetDevice(&dev) != hipSuccess || hipDeviceGetAttribute(&cus, hipDeviceAttributeMultiprocessorCount, dev) != hipSuccess) { grid = -1; return; }
        if (hipFuncSetAttribute((const void*)trunk_fwd, hipFuncAttributeMaxDynamicSharedMemorySize, LDS_BYTES) != hipSuccess) { fprintf(stderr, "kernel_launch: hipFuncSetAttribute failed\n"); grid = -1; return; }
        if (hipOccupancyMaxActiveBlocksPerMultiprocessor(&per_cu, (const void*)trunk_fwd, NWAVES * 64, LDS_BYTES) != hipSuccess || per_cu < 1)
            fprintf(stderr, "kernel_launch: note: occupancy query reports %d workgroups per CU\n", per_cu);
        (void)hipGetLastError();
        grid = cus;
        if (grid != 256) { fprintf(stderr, "kernel_launch: %d CUs: this kernel's group seams are derived for a 256-workgroup grid; nothing launched\n", grid); grid = -1; return; }
    }
    if (grid < 0) return;
    if (hipMemsetAsync((char*)d_ws + WS_CTL, 0, CTL_ZERO_BYTES, stream) != hipSuccess) return;
    Args a{};
    for (int i = 0; i < 15; ++i) a.in[i] = (const float*)d_in[i];
    a.out = (float*)d_out; a.ws = (unsigned char*)d_ws;
#if MK_SPLIT
    for (int p = 0; p < N_SEQ; ++p) { a.ph_lo = p; a.ph_hi = p + 1; hipLaunchKernelGGL(trunk_fwd, dim3(grid), dim3(NWAVES * 64), LDS_BYTES, stream, a); }
#else
    a.ph_lo = 0; a.ph_hi = N_SEQ;
    hipLaunchKernelGGL(trunk_fwd, dim3(grid), dim3(NWAVES * 64), LDS_BYTES, stream, a);
#endif
    const hipError_t le = hipPeekAtLastError();
    if (le != hipSuccess) fprintf(stderr, "kernel_launch: launch failed: %s\n", hipGetErrorName(le));
}
```

```cpp
#include <hip/hip_runtime.h>
#include <cstdio>
#include <cstdint>
namespace pg8 {
#define PG8_LAS __attribute__((address_space(3)))
typedef unsigned short bf16_t;
typedef short bf16x8 __attribute__((ext_vector_type(8)));
typedef float f32x4 __attribute__((ext_vector_type(4)));
typedef unsigned u32x4 __attribute__((ext_vector_type(4)));
constexpr int BM = 256, BK = 64, HALF = 128, HTB = HALF * BK * 2  , STAGE_BYTES = 8 * HTB, NXCD = 8, WGM = 8;

__host__ __device__ __forceinline__ int lds_byte(int r, int c) { const int st = (r >> 4) * 2 + (c >> 5), rr = r & 15, cc = c & 31, ob = rr * 64 + cc * 2; return st * 1024 + (ob ^ (((ob >> 9) & 1) << 5)); }
__host__ __device__ __forceinline__ void stage_rc(int b, int& R, int& C) { const int st = b / 1024, sb = b % 1024, swz = sb ^ (((sb >> 9) & 1) << 5); R = (st >> 1) * 16 + swz / 64; C = (st & 1) * 32 + (swz % 64) / 2; }
__host__ __device__ __forceinline__ int perm32(int rho) { const int n = rho >> 4, i = rho & 15; return 8 * (i >> 2) + 4 * n + (i & 3); }

struct Unit { int pm, pn; };
struct Gemm { const bf16_t* A; const bf16_t* Bt; int M, N, K; size_t tstepA; };

struct StaticOrder {
    int nM, nN, nwg, G, c, rev, pnrev;
    __host__ __device__ void init(int M, int N, int G_, int c_) { nM = M / BM; nN = N / BM; nwg = nM * nN; G = G_; c = c_; rev = 0; pnrev = 0; }
    __host__ __device__ void columns_descending() { pnrev = 1; }
    __host__ __device__ void reversed() { rev = (nwg + G - 1) / G; }
    __host__ __device__ bool next(int i, Unit& u) const {
        if (rev) { if (i >= rev) return false; i = rev - 1 - i; }
        const long L = (long)i * G + c; if (L >= nwg) return false;
        int wgid = (int)L; { const int q = nwg / NXCD, r = nwg % NXCD, xcd = wgid % NXCD, off = wgid / NXCD; wgid = (xcd < r ? xcd * (q + 1) : r * (q + 1) + (xcd - r) * q) + off; }
        const int nig = WGM * nN, gid = wgid / nig, fm = gid * WGM, gsz = (nM - fm) < WGM ? (nM - fm) : WGM;
        u.pm = fm + ((wgid % nig) % gsz); u.pn = (wgid % nig) / gsz; if (pnrev) u.pn = nN - 1 - u.pn; return true;
    }
    __device__ __forceinline__ void a_ready(const Unit&) const {}
    __device__ __forceinline__ void done(const Unit&) const {}
};

__device__ __forceinline__ unsigned cvt_pk_bf16(float lo, float hi) { unsigned r; asm volatile("v_cvt_pk_bf16_f32 %0, %1, %2" : "=v"(r) : "v"(lo), "v"(hi)); return r; }
typedef float f32x2 __attribute__((ext_vector_type(2)));
__device__ __forceinline__ f32x2 gelu_pk(f32x2 v) {
    f32x2 a; a.x = fminf(__builtin_fabsf(v.x), 5.3f); a.y = fminf(__builtin_fabsf(v.y), 5.3f);
    const f32x2 x = a * 0.377358496f + (-1.0f);
    f32x2 q = x * (-2.680665057e-04f) + (-4.321495537e-03f);
    q = q * x + 7.164665032e-03f; q = q * x + 1.980672404e-02f; q = q * x + (-4.157880694e-02f); q = q * x + (-2.189491689e-02f); q = q * x + 1.078988388e-01f;
    q = q * x + (-5.974620953e-02f); q = q * x + (-1.094131693e-01f); q = q * x + 2.026295662e-01f; q = q * x + (-8.957923949e-02f); q = q * x + (-1.324163824e-01f);
    q = q * x + 2.609098256e-01f; q = q * x + (-2.224893272e-01f); q = q * x + 1.108414084e-01f; q = q * x + (-3.156794980e-02f); q = q * x + 4.024588503e-03f;
    const f32x2 m = v * q, r = v - m;
    f32x2 o; o.x = v.x < 0.f ? m.x : r.x; o.y = v.y < 0.f ? m.y : r.y; return o;
}

struct RsTable {
    const float* ssq; PG8_LAS float* tab; mutable int pm_cached;
    __device__ __forceinline__ void get(const Unit& u, int wr, int fr, float (&rs)[2][4]) const {
        if (u.pm != pm_cached) {
            const int t = threadIdx.x, row = t >> 1, half = t & 1;
            const f32x4 a = *(const f32x4*)(ssq + (size_t)(u.pm * BM + row) * 16 + half * 8), b = *(const f32x4*)(ssq + (size_t)(u.pm * BM + row) * 16 + half * 8 + 4);
            float s = ((a[0] + a[1]) + (a[2] + a[3])) + ((b[0] + b[1]) + (b[2] + b[3]));
            s += __shfl_xor(s, 1);
            if (half == 0) tab[row] = __builtin_amdgcn_rsqf(s * (1.0f / 1024.0f) + 1e-6f);
            asm volatile("s_waitcnt lgkmcnt(0)" ::: "memory"); __builtin_amdgcn_s_barrier(); asm volatile("" ::: "memory");
            pm_cached = u.pm;
        }
#pragma unroll
        for (int ai = 0; ai < 2; ++ai)
#pragma unroll
            for (int m = 0; m < 4; ++m) rs[ai][m] = tab[ai * HALF + wr * 64 + m * 16 + fr];
    }
};
struct GateW { const unsigned* cnt; unsigned target; mutable int passed;
    __device__ __forceinline__ void wait() const { if (cnt && !passed) { unsigned sp = 0u; while (__hip_atomic_load(cnt, __ATOMIC_RELAXED, __HIP_MEMORY_SCOPE_AGENT) < target) { __builtin_amdgcn_s_sleep(2); if (++sp > (1u << 22)) break; } passed = 1; } } };
template <int ACT> struct EpiAct {
    static constexpr bool PERM = true, AFTER_DRAIN = false;
    bf16_t* O; int ldc; size_t pstride; RsTable rt; float* vst; GateW gate;
    __device__ __forceinline__ void operator()(const f32x4 (&acc)[2][2][4][2], const Unit& u, int wr, int wc, int fr, int fq) const {
        const int row0 = u.pm * BM + wr * 64 + fr, col0 = u.pn * BM + wc * 32 + 8 * fq;
        const bool vhalf = (ACT == 1) && (u.pn >= 4);
        float rsv[2][4]; rt.get(u, wr, fr, rsv); gate.wait();
#pragma unroll
        for (int ai = 0; ai < 2; ++ai)
#pragma unroll
            for (int m = 0; m < 4; ++m) {
                const int row = row0 + ai * HALF + m * 16;
                const float rs = rsv[ai][m];
                bf16_t* rowp = O + (size_t)u.pm * pstride + (size_t)(row - u.pm * BM) * ldc + col0;
                float s1 = 0.f, s2 = 0.f;
#pragma unroll
                for (int bj = 0; bj < 2; ++bj) {
                    f32x4 v0 = acc[ai][bj][m][0] * rs, v1 = acc[ai][bj][m][1] * rs;
                    if (ACT == 1) { f32x2 a = gelu_pk((f32x2){v0[0], v0[1]}), b = gelu_pk((f32x2){v0[2], v0[3]}), c = gelu_pk((f32x2){v1[0], v1[1]}), d = gelu_pk((f32x2){v1[2], v1[3]});
                        v0 = (f32x4){a.x, a.y, b.x, b.y}; v1 = (f32x4){c.x, c.y, d.x, d.y};
                        s1 += ((v0[0] + v0[1]) + (v0[2] + v0[3])) + ((v1[0] + v1[1]) + (v1[2] + v1[3]));
                        s2 += ((v0[0] * v0[0] + v0[1] * v0[1]) + (v0[2] * v0[2] + v0[3] * v0[3])) + ((v1[0] * v1[0] + v1[1] * v1[1]) + (v1[2] * v1[2] + v1[3] * v1[3])); }
                    if (ACT == 2) {
#pragma unroll
                        for (int e = 0; e < 4; ++e) { const float a = fmaxf(v0[e], 0.f), b = fmaxf(v1[e], 0.f); v0[e] = a * a; v1[e] = b * b; } }
                    u32x4 w; w.x = cvt_pk_bf16(v0[0], v0[1]); w.y = cvt_pk_bf16(v0[2], v0[3]); w.z = cvt_pk_bf16(v1[0], v1[1]); w.w = cvt_pk_bf16(v1[2], v1[3]);
                    *(u32x4*)(rowp + bj * HALF) = w; }
                if (ACT == 1) { if (vhalf) { s1 += __shfl_xor(s1, 16); s1 += __shfl_xor(s1, 32); s2 += __shfl_xor(s2, 16); s2 += __shfl_xor(s2, 32);
                        if (fq == 0) *(f32x2*)(vst + ((size_t)row * 16 + (u.pn - 4) * 4 + wc) * 2) = (f32x2){s1, s2}; } }
            }
    }
};
struct EpiQKV {
    static constexpr bool PERM = true, AFTER_DRAIN = false;
    bf16_t* O; RsTable rt; int seq, nb; GateW gate;
    __device__ __forceinline__ void operator()(const f32x4 (&acc)[2][2][4][2], const Unit& u, int wr, int wc, int fr, int fq) const {
        const int row0 = u.pm * BM + wr * 64 + fr, col0 = u.pn * BM + wc * 32 + 8 * fq;
        const int g = ((u.pn * BM) / 512) % 3, lg = 2 * g, dm = (1 << lg) - 1;
        float rsv[2][4]; rt.get(u, wr, fr, rsv); gate.wait();
#pragma unroll
        for (int ai = 0; ai < 2; ++ai)
#pragma unroll
            for (int m = 0; m < 4; ++m) {
                const int row = row0 + ai * HALF + m * 16, b = row / seq, pos = row - b * seq;
                const size_t prow = (size_t)b * seq + (size_t)(pos & dm) * (seq >> lg) + (pos >> lg);
                const float rs = rsv[ai][m];
#pragma unroll
                for (int bj = 0; bj < 2; ++bj) { const int col = col0 + bj * HALF, hd = col >> 6;
                    const f32x4 v0 = acc[ai][bj][m][0] * rs, v1 = acc[ai][bj][m][1] * rs;
                    u32x4 w; w.x = cvt_pk_bf16(v0[0], v0[1]); w.y = cvt_pk_bf16(v0[2], v0[3]); w.z = cvt_pk_bf16(v1[0], v1[1]); w.w = cvt_pk_bf16(v1[2], v1[3]);
                    *(u32x4*)(O + ((size_t)hd * nb * seq + prow) * 64 + (col & 63)) = w; } }
    }
};
__device__ __forceinline__ float bf_lo(unsigned w) { return __builtin_bit_cast(float, w << 16); }
__device__ __forceinline__ float bf_hi(unsigned w) { return __builtin_bit_cast(float, w & 0xffff0000u); }
struct EpiRes {
    static constexpr bool PERM = true, AFTER_DRAIN = false;
    bf16_t* hb; float* ssq; int ldc;
    __device__ __forceinline__ void operator()(const f32x4 (&acc)[2][2][4][2], const Unit& u, int wr, int wc, int fr, int fq) const {
        const int row0 = u.pm * BM + wr * 64 + fr, col0 = u.pn * BM + wc * 32 + 8 * fq;
        u32x4 r[2][4][2];
#pragma unroll
        for (int ai = 0; ai < 2; ++ai)
#pragma unroll
            for (int m = 0; m < 4; ++m)
#pragma unroll
                for (int bj = 0; bj < 2; ++bj) r[ai][m][bj] = *(const u32x4*)(hb + (size_t)(row0 + ai * HALF + m * 16) * ldc + col0 + bj * HALF);
        asm volatile("" ::: "memory");
#pragma unroll
        for (int ai = 0; ai < 2; ++ai)
#pragma unroll
            for (int m = 0; m < 4; ++m) {
                const int row = row0 + ai * HALF + m * 16;
                float q = 0.f;
#pragma unroll
                for (int bj = 0; bj < 2; ++bj) { const u32x4 rr = r[ai][m][bj];
                    const f32x4 h0 = (f32x4){bf_lo(rr.x), bf_hi(rr.x), bf_lo(rr.y), bf_hi(rr.y)} + acc[ai][bj][m][0], h1 = (f32x4){bf_lo(rr.z), bf_hi(rr.z), bf_lo(rr.w), bf_hi(rr.w)} + acc[ai][bj][m][1];
                    u32x4 w; w.x = cvt_pk_bf16(h0[0], h0[1]); w.y = cvt_pk_bf16(h0[2], h0[3]); w.z = cvt_pk_bf16(h1[0], h1[1]); w.w = cvt_pk_bf16(h1[2], h1[3]);
                    *(u32x4*)(hb + (size_t)row * ldc + col0 + bj * HALF) = w;
                    q += ((h0[0] * h0[0] + h0[1] * h0[1]) + (h0[2] * h0[2] + h0[3] * h0[3])) + ((h1[0] * h1[0] + h1[1] * h1[1]) + (h1[2] * h1[2] + h1[3] * h1[3])); }
                q += __shfl_xor(q, 16); q += __shfl_xor(q, 32);
                if (fq == 0) ssq[(size_t)row * 16 + u.pn * 4 + wc] = q;
            }
    }
};
struct EpiNull {
    static constexpr bool PERM = true, AFTER_DRAIN = false;
    __device__ __forceinline__ void operator()(const f32x4 (&acc)[2][2][4][2], const Unit& u, int wr, int wc, int fr, int fq) const {
#pragma unroll
        for (int ai = 0; ai < 2; ++ai)
#pragma unroll
            for (int bj = 0; bj < 2; ++bj)
#pragma unroll
                for (int m = 0; m < 4; ++m)
#pragma unroll
                    for (int n = 0; n < 2; ++n) asm volatile("" :: "v"(acc[ai][bj][m][n]));
    }
};
struct EpiStoreOnly {
    static constexpr bool PERM = true, AFTER_DRAIN = false;
    bf16_t* O; int ldc;
    __device__ __forceinline__ void operator()(const f32x4 (&acc)[2][2][4][2], const Unit& u, int wr, int wc, int fr, int fq) const {
        const int row0 = u.pm * BM + wr * 64 + fr, col0 = u.pn * BM + wc * 32 + 8 * fq;
#pragma unroll
        for (int ai = 0; ai < 2; ++ai)
#pragma unroll
            for (int m = 0; m < 4; ++m) {
                bf16_t* rowp = O + (size_t)(row0 + ai * HALF + m * 16) * ldc + col0;
#pragma unroll
                for (int bj = 0; bj < 2; ++bj) { const f32x4 v0 = acc[ai][bj][m][0], v1 = acc[ai][bj][m][1];
                    u32x4 w; w.x = cvt_pk_bf16(v0[0], v0[1]); w.y = cvt_pk_bf16(v0[2], v0[3]); w.z = cvt_pk_bf16(v1[0], v1[1]); w.w = cvt_pk_bf16(v1[2], v1[3]);
                    *(u32x4*)(rowp + bj * HALF) = w; } }
    }
};
template <class Epi, class Sched, bool ALIGN_EPI = false, bool SP2 = false, bool KDESC = false>
__device__ __forceinline__ void gemm_phase(PG8_LAS unsigned char* lds, const Gemm g, const Sched& S, const Epi& E) {
    const int tid = threadIdx.x, wid = __builtin_amdgcn_readfirstlane(tid >> 6), lane = tid & 63, wr = wid >> 2, wc = wid & 3, fr = lane & 15, fq = lane >> 4;
    const int K = g.K, nt = K / BK;
    unsigned voffA[2], voffB[2];
#pragma unroll
    for (int i = 0; i < 2; ++i) { int R, C; stage_rc(tid * 16 + i * 8192, R, C); const int Rb = Epi::PERM ? ((R & ~31) + perm32(R & 31)) : R;
        voffA[i] = (unsigned)(R * K + C) * 2u; voffB[i] = (unsigned)(Rb * K + C) * 2u; }
    const size_t kstep = KDESC ? (size_t)0 - (size_t)(BK * 2) : (size_t)(BK * 2);
    const size_t kfirst = KDESC ? (size_t)(nt - 1) * (size_t)(BK * 2) : (size_t)0;
    const size_t hstep = (size_t)HALF * K * 2;
    const size_t tstep = 2 * hstep;
    const unsigned ldsw = (unsigned)wid * 1024u;
    const int aoff = lds_byte(wr * 64 + fr, fq * 8), boff = lds_byte(wc * 32 + fr, fq * 8);
#define PG8_SA(b, h) (((b) * 2 + (h)) * HTB)
#define PG8_SB(b, h) ((4 + (b) * 2 + (h)) * HTB)
#define PG8_STAGE(bufoff, gbase, voff) do { _Pragma("unroll") for (int _i = 0; _i < 2; ++_i) \
        __builtin_amdgcn_global_load_lds((const unsigned*)((const char*)(gbase) + (voff)[_i]), (PG8_LAS unsigned*)(lds + (bufoff) + ldsw + _i * 8192), 16, 0, 0); } while (0)
#define PG8_LDA(dst, b, h) do { _Pragma("unroll") for (int m = 0; m < 4; ++m) _Pragma("unroll") for (int k = 0; k < 2; ++k) dst[m][k] = *(const PG8_LAS bf16x8*)(lds + PG8_SA(b, h) + aoff + m * 2048 + k * 1024); } while (0)
#define PG8_LDB(dst, b, h) do { _Pragma("unroll") for (int n = 0; n < 2; ++n) _Pragma("unroll") for (int k = 0; k < 2; ++k) dst[n][k] = *(const PG8_LAS bf16x8*)(lds + PG8_SB(b, h) + boff + n * 2048 + k * 1024); } while (0)
#define PG8_MMA(ai, bj, At, Bt) do { __builtin_amdgcn_s_setprio(1); _Pragma("unroll") for (int m = 0; m < 4; ++m) _Pragma("unroll") for (int n = 0; n < 2; ++n) _Pragma("unroll") for (int k = 0; k < 2; ++k) \
        acc[ai][bj][m][n] = __builtin_amdgcn_mfma_f32_16x16x32_bf16(Bt[n][k], At[m][k], acc[ai][bj][m][n], 0, 0, 0); __builtin_amdgcn_s_setprio(0); } while (0)
#define PG8_WAIT_V(n) asm volatile("s_waitcnt vmcnt(" #n ")" ::: "memory")
#define PG8_WAIT_L(n) asm volatile("s_waitcnt lgkmcnt(" #n ")" ::: "memory")
#define PG8_BAR __builtin_amdgcn_s_barrier()
#define PG8_SCHED __builtin_amdgcn_sched_barrier(0)
    Unit cur, nxt; int ui = 0;
    if (!S.next(0, cur)) return;
    f32x4 acc[2][2][4][2];
#pragma unroll
    for (int a = 0; a < 2; ++a)
#pragma unroll
        for (int b = 0; b < 2; ++b)
#pragma unroll
            for (int m = 0; m < 4; ++m)
#pragma unroll
                for (int n = 0; n < 2; ++n) acc[a][b][m][n] = (f32x4){0.f, 0.f, 0.f, 0.f};
    bf16x8 At[4][2], B0[2][2], B1[2][2];
    const char* cA = (const char*)g.A + (size_t)cur.pm * g.tstepA + kfirst; const char* cB = (const char*)g.Bt + (size_t)cur.pn * tstep + kfirst;
    S.a_ready(cur);
    if constexpr (SP2) {
        PG8_STAGE(PG8_SB(0, 0), cB, voffB); PG8_STAGE(PG8_SB(0, 1), cB + hstep, voffB); PG8_STAGE(PG8_SA(0, 0), cA, voffA); PG8_STAGE(PG8_SA(0, 1), cA + hstep, voffA);
        if (wr == 1) PG8_BAR;
        PG8_WAIT_V(2); PG8_BAR;
        PG8_STAGE(PG8_SB(1, 0), cB + kstep, voffB); PG8_STAGE(PG8_SA(1, 0), cA + kstep, voffA); PG8_STAGE(PG8_SB(1, 1), cB + hstep + kstep, voffB);
        PG8_WAIT_V(6); PG8_BAR;
    } else {
        PG8_STAGE(PG8_SB(0, 0), cB, voffB); PG8_STAGE(PG8_SA(0, 0), cA, voffA); PG8_STAGE(PG8_SB(0, 1), cB + hstep, voffB); PG8_STAGE(PG8_SA(0, 1), cA + hstep, voffA);
        if (wr == 1) PG8_BAR;
        PG8_WAIT_V(4); PG8_BAR;
        PG8_STAGE(PG8_SB(1, 0), cB + kstep, voffB); PG8_STAGE(PG8_SA(1, 0), cA + kstep, voffA); PG8_STAGE(PG8_SB(1, 1), cB + hstep + kstep, voffB);
        PG8_WAIT_V(6); PG8_BAR;
    }
    for (;;) {
        const bool has_next = S.next(ui + 1, nxt);
        const char* nA = has_next ? (const char*)g.A + (size_t)nxt.pm * g.tstepA + kfirst : cA; const char* nB = has_next ? (const char*)g.Bt + (size_t)nxt.pn * tstep + kfirst : cB;
        for (int t = 0; t < nt; t += 2) {
            const bool last = (t == nt - 2);
            const char* a1 = cA + (size_t)(t + 1) * kstep;
            const char* a2 = last ? nA : cA + (size_t)(t + 2) * kstep; const char* b2 = last ? nB : cB + (size_t)(t + 2) * kstep;
            const char* a3 = a2 + kstep; const char* b3 = b2 + kstep;
            if (last && has_next) S.a_ready(nxt);
            if constexpr (SP2) {
            PG8_LDB(B0, 0, 0); PG8_LDB(B1, 0, 1); PG8_SCHED; PG8_LDA(At, 0, 0); PG8_STAGE(PG8_SA(1, 1), a1 + hstep, voffA);
            PG8_WAIT_V(8); PG8_WAIT_L(0); PG8_BAR; PG8_MMA(0, 0, At, B0); PG8_MMA(0, 1, At, B1); PG8_BAR; PG8_SCHED;
            PG8_LDA(At, 0, 1); PG8_STAGE(PG8_SB(0, 0), b2, voffB); PG8_STAGE(PG8_SB(0, 1), b2 + hstep, voffB); PG8_STAGE(PG8_SA(0, 0), a2, voffA);
            PG8_WAIT_V(8); PG8_WAIT_L(0); PG8_BAR; PG8_MMA(1, 0, At, B0); PG8_MMA(1, 1, At, B1); PG8_BAR; PG8_SCHED;
            PG8_LDB(B0, 1, 0); PG8_LDB(B1, 1, 1); PG8_SCHED; PG8_LDA(At, 1, 0); PG8_STAGE(PG8_SA(0, 1), a2 + hstep, voffA);
            PG8_WAIT_V(8); PG8_WAIT_L(0); PG8_BAR; PG8_MMA(0, 0, At, B0); PG8_MMA(0, 1, At, B1); PG8_BAR; PG8_SCHED;
            PG8_LDA(At, 1, 1); PG8_STAGE(PG8_SB(1, 0), b3, voffB); PG8_STAGE(PG8_SB(1, 1), b3 + hstep, voffB); PG8_STAGE(PG8_SA(1, 0), a3, voffA);
            PG8_WAIT_V(8); PG8_WAIT_L(0); PG8_BAR; PG8_MMA(1, 0, At, B0); PG8_MMA(1, 1, At, B1); PG8_BAR; PG8_SCHED;
            } else {
            PG8_LDB(B0, 0, 0); PG8_SCHED; PG8_LDA(At, 0, 0); PG8_STAGE(PG8_SA(1, 1), a1 + hstep, voffA);
            PG8_WAIT_L(8); PG8_BAR; PG8_WAIT_L(0); PG8_MMA(0, 0, At, B0); PG8_BAR; PG8_SCHED;
            PG8_LDB(B1, 0, 1); PG8_STAGE(PG8_SB(0, 0), b2, voffB);
            PG8_BAR; PG8_WAIT_L(0); PG8_MMA(0, 1, At, B1); PG8_BAR;
            PG8_LDA(At, 0, 1); PG8_STAGE(PG8_SA(0, 0), a2, voffA);
            PG8_BAR; PG8_WAIT_L(0); PG8_MMA(1, 0, At, B0); PG8_BAR; PG8_SCHED;
            PG8_STAGE(PG8_SB(0, 1), b2 + hstep, voffB);
            PG8_WAIT_V(6); PG8_BAR; PG8_MMA(1, 1, At, B1); PG8_BAR;
            PG8_LDB(B0, 1, 0); PG8_SCHED; PG8_LDA(At, 1, 0); PG8_STAGE(PG8_SA(0, 1), a2 + hstep, voffA);
            PG8_WAIT_L(8); PG8_BAR; PG8_WAIT_L(0); PG8_MMA(0, 0, At, B0); PG8_BAR; PG8_SCHED;
            PG8_LDB(B1, 1, 1); PG8_STAGE(PG8_SB(1, 0), b3, voffB);
            PG8_BAR; PG8_WAIT_L(0); PG8_MMA(0, 1, At, B1); PG8_BAR;
            PG8_LDA(At, 1, 1); PG8_STAGE(PG8_SA(1, 0), a3, voffA);
            PG8_BAR; PG8_WAIT_L(0); PG8_MMA(1, 0, At, B0); PG8_BAR; PG8_SCHED;
            PG8_STAGE(PG8_SB(1, 1), b3 + hstep, voffB);
            PG8_WAIT_V(6); PG8_BAR; PG8_MMA(1, 1, At, B1); PG8_BAR;
            }
        }
        if constexpr (ALIGN_EPI) { if (wr == 0) PG8_BAR; }
        if constexpr (!Epi::AFTER_DRAIN) { E(acc, cur, wr, wc, fr, fq); S.done(cur); }
        if (!has_next) break;
#pragma unroll
        for (int a = 0; a < 2; ++a)
#pragma unroll
            for (int b = 0; b < 2; ++b)
#pragma unroll
                for (int m = 0; m < 4; ++m)
#pragma unroll
                    for (int n = 0; n < 2; ++n) acc[a][b][m][n] = (f32x4){0.f, 0.f, 0.f, 0.f};
        cur = nxt; cA = nA; cB = nB; ++ui;
        if constexpr (ALIGN_EPI) { if (wr == 1) PG8_BAR; }
    }
    PG8_WAIT_V(0);
    if constexpr (!ALIGN_EPI) { if (wr == 0) PG8_BAR; }
    PG8_BAR;
    if constexpr (Epi::AFTER_DRAIN) { E.fused(acc, cur, wr, wc, fr, fq, lds, wid, lane); S.done(cur); }
#undef PG8_SA
#undef PG8_SB
#undef PG8_STAGE
#undef PG8_LDA
#undef PG8_LDB
#undef PG8_MMA
#undef PG8_WAIT_V
#undef PG8_WAIT_L
#undef PG8_BAR
#undef PG8_SCHED
}
}
constexpr int NWAVES = 8;
constexpr int BATCH = 4, SEQ = 8192, D = 1024, FF = 4096, NQKV = 4608, AW = 512, NH = 8, HD = 64;
constexpr int M = BATCH * SEQ;
constexpr int CHUNK = 128, NCHUNK = M / CHUNK, NGRP = 8;
constexpr float EPS = 1e-6f;
constexpr float LOG2E = 1.4426950408889634f;
constexpr int LUT_N = 176;
#ifndef MK_SPLIT
#define MK_SPLIT 0
#endif
constexpr int N_PHASES = 12;
#define DUP_AFTER (-1)
#define DUP_N 0
#define DUP_BODY
#define BAR_REPS 1
constexpr int N_SEQ = N_PHASES + DUP_N;

constexpr size_t MiB = 1u << 20;
constexpr size_t WS_CTL = 0, CTL_ZERO_BYTES = 128 * 1024;
constexpr size_t WS_WIN = 2 * MiB, WS_WOA = 6 * MiB, WS_WQKV = 8 * MiB, WS_WOB = 17 * MiB, WS_WUP = 18 * MiB, WS_WDN = 34 * MiB;
constexpr size_t WS_WST = 50 * MiB;
constexpr size_t WS_LUT = 50 * MiB + 512 * 1024;
constexpr size_t WS_SSQ = 51 * MiB;
constexpr size_t WS_VST = 53 * MiB;
constexpr size_t WS_LSE = 57 * MiB;
constexpr size_t WS_XN = 64 * MiB;
constexpr size_t WS_BIG = 128 * MiB;
constexpr size_t BLK = 2304 * 1024;
constexpr size_t BLK_UG = 1 * MiB, QSLICE = 256 * 64;
constexpr size_t WS_OM = 416 * MiB;
constexpr size_t WS_END = 448 * MiB;
constexpr int CW_TMO = 0, CW_CODE = 1, CW_BAR = 4096, CW_GRP = 8192, CW_XCC = 16384, CW_GATE = 20480;
static_assert((size_t)(CW_GATE + 256) * 4 <= CTL_ZERO_BYTES, "control words inside the per-call memset");

constexpr int RING_OFF = 0, RING_BYTES = 131072;
constexpr int LDSCTL_OFF = 159744  , MISC_OFF = LDSCTL_OFF + 320, RSTAB_OFF = LDSCTL_OFF + 1024;
constexpr int LDS_BYTES = 163840;

#define GAS __attribute__((address_space(1)))
#define LAS __attribute__((address_space(3)))
typedef unsigned short bf16;
typedef unsigned v4u __attribute__((ext_vector_type(4)));
typedef float f32x4 __attribute__((ext_vector_type(4)));
typedef short bf16x8 __attribute__((ext_vector_type(8)));
typedef GAS unsigned gu32;
typedef GAS unsigned long long gu64;
#define RLX_AGENT __ATOMIC_RELAXED, __HIP_MEMORY_SCOPE_AGENT
#define LDS_WAIT() asm volatile("s_waitcnt lgkmcnt(0)" ::: "memory")
#define VM_WAIT() asm volatile("s_waitcnt vmcnt(0)" ::: "memory")
__device__ __forceinline__ unsigned long long rt() { return __builtin_amdgcn_s_memrealtime(); }
__device__ __forceinline__ unsigned f2bf(float f) { unsigned u = __builtin_bit_cast(unsigned, f); return (u + 0x7fffu + ((u >> 16) & 1u)) >> 16; }
__device__ __forceinline__ unsigned pk2(float lo, float hi) { return f2bf(lo) | (f2bf(hi) << 16); }

#define XB_TMO      128
#define XB_XCNT(j)  (256  + 64 * (j))
#define XB_XSUB(j)  (1280 + 64 * (j))
#define XB_XGEN(j)  (2304 + 64 * (j))
#define XB_TOP      3328
#define XB_TOPGEN   3392
#define XCD_BAR_WORDS 3456
#define XB_SPIN_CAP (1u << 18)

__device__ __forceinline__ unsigned xb_ld(unsigned* p)              { return __hip_atomic_load(p, __ATOMIC_RELAXED, __HIP_MEMORY_SCOPE_AGENT); }
__device__ __forceinline__ unsigned xb_add(unsigned* p, unsigned v) { return __hip_atomic_fetch_add(p, v, __ATOMIC_RELAXED, __HIP_MEMORY_SCOPE_AGENT); }
__device__ __forceinline__ unsigned xb_xcc_id() { return (unsigned)__builtin_amdgcn_s_getreg((3 << 11) | 20) & 0xFu; }
#define XB_SPIN(cond, bar) do { unsigned _sp = 0; while (cond) { __builtin_amdgcn_s_sleep(1); \
    if ((++_sp & 255u) == 0u) { if (xb_ld(&(bar)[XB_TMO])) break; if (_sp > XB_SPIN_CAP) { atomicAdd(&(bar)[XB_TMO], 1u); break; } } } } while (0)

struct XcdBarrier {
    unsigned* bar; unsigned x;
    volatile LAS unsigned* st;
};

__device__ __forceinline__ XcdBarrier xcd_barrier_post(unsigned* bar, volatile LAS unsigned* st) {
    XcdBarrier b; b.bar = bar; b.x = xb_xcc_id(); b.st = st;
    if (threadIdx.x == 0) (void)xb_add(&bar[XB_XCNT(b.x)], 1u);
    return b;
}
__device__ __forceinline__ void xcd_barrier_complete(unsigned* bar, unsigned x, unsigned& nloc, unsigned& nx) {
    const unsigned G = gridDim.x * gridDim.y * gridDim.z;
    unsigned sum, cnt, mine, sp = 0u;
    for (;;) {
        sum = 0u; cnt = 0u; mine = 0u;
#pragma unroll
        for (unsigned j = 0; j < 16; ++j) { const unsigned c = xb_ld(&bar[XB_XCNT(j)]); sum += c; cnt += (c > 0u) ? 1u : 0u; mine = (j == x) ? c : mine; }
        if (sum == G) break;
        __builtin_amdgcn_s_sleep(1);
        if ((++sp & 255u) == 0u) { if (xb_ld(&bar[XB_TMO])) break; if (sp > XB_SPIN_CAP) { atomicAdd(&bar[XB_TMO], 1u); break; } }
    }
    nloc = mine > 0u ? mine : 1u; nx = cnt > 0u ? cnt : 1u;
}

__device__ __forceinline__ void xcd_barrier(const XcdBarrier& b) {
    asm volatile("s_waitcnt vmcnt(0)" ::: "memory");
    __syncthreads();
    if (threadIdx.x == 0) {
        unsigned* bar = b.bar;
        __builtin_amdgcn_s_waitcnt(0);
        unsigned nloc = b.st[0], nx = b.st[1];
        if (nloc == 0u) { xcd_barrier_complete(bar, b.x, nloc, nx); b.st[0] = nloc; b.st[1] = nx; }
        const unsigned old = xb_add(&bar[XB_XSUB(b.x)], 1u);
        const unsigned gen = old / nloc;
        if (old + 1u == (gen + 1u) * nloc) {
            __builtin_amdgcn_fence(__ATOMIC_RELEASE, "agent");
            asm volatile("s_waitcnt vmcnt(0)" ::: "memory");
            const unsigned og = xb_add(&bar[XB_TOP], 1u);
            const unsigned tg = og / nx;
            if (og + 1u == (tg + 1u) * nx) xb_add(&bar[XB_TOPGEN], 1u);
            else XB_SPIN(xb_ld(&bar[XB_TOPGEN]) == tg, bar);
            __builtin_amdgcn_fence(__ATOMIC_ACQUIRE, "agent");
            xb_add(&bar[XB_XGEN(b.x)], 1u);
            asm volatile("s_waitcnt vmcnt(0)" ::: "memory");
        } else {
            XB_SPIN(xb_ld(&bar[XB_XGEN(b.x)]) == gen, bar);
            __builtin_amdgcn_fence(__ATOMIC_ACQUIRE, "agent");
            asm volatile("s_waitcnt vmcnt(0)" ::: "memory");
        }
    }
    __syncthreads();
}
typedef float f32x2v __attribute__((ext_vector_type(2)));
typedef pg8::u32x4 u32x4;
typedef unsigned u32x2v __attribute__((ext_vector_type(2)));
typedef unsigned short bf16x8us __attribute__((ext_vector_type(8)));
__device__ __forceinline__ unsigned cvtpk(float lo, float hi) { unsigned r; asm volatile("v_cvt_pk_bf16_f32 %0, %1, %2" : "=v"(r) : "v"(lo), "v"(hi)); return r; }
__device__ __forceinline__ float bf2f(unsigned short b) { return __builtin_bit_cast(float, (unsigned)b << 16); }
__device__ __forceinline__ float bflo(unsigned w) { return __builtin_bit_cast(float, w << 16); }
__device__ __forceinline__ float bfhi(unsigned w) { return __builtin_bit_cast(float, w & 0xffff0000u); }
__device__ __forceinline__ float wave_sum(float v) {
#pragma unroll
    for (int o = 1; o < 64; o <<= 1) v += __shfl_xor(v, o);
    return v;
}
struct Ctx { LAS unsigned char* lds; int tid, lane, wave, vcu, G; };

struct P0Item { const float* W; const float* gsc; bf16* WT; int K, N, item; };
__device__ __forceinline__ void p0_item_load(const P0Item& I, int lane, f32x4 (&v)[8]) {
    const int nblk = I.N / 32, kb = I.item / nblk, nb = I.item % nblk, k0 = 64 * kb, n0 = 32 * nb, kr = lane >> 3, c4 = (lane & 7) * 4;
#pragma unroll
    for (int i = 0; i < 8; ++i) v[i] = __builtin_nontemporal_load((const f32x4*)(I.W + (size_t)(k0 + 8 * i + kr) * I.N + n0 + c4));
}
__device__ __forceinline__ void p0_item_store(const P0Item& I, int lane, f32x4 (&v)[8], LAS float* scr) {
    const int nblk = I.N / 32, kb = I.item / nblk, nb = I.item % nblk, k0 = 64 * kb, n0 = 32 * nb, kr = lane >> 3, c4 = (lane & 7) * 4;
    if (I.gsc) {
#pragma unroll
        for (int i = 0; i < 8; ++i) v[i] = v[i] * I.gsc[k0 + 8 * i + kr]; }
#pragma unroll
    for (int i = 0; i < 8; ++i) { LAS float* d = scr + (8 * i + kr) * 33 + c4; d[0] = v[i][0]; d[1] = v[i][1]; d[2] = v[i][2]; d[3] = v[i][3]; }
    LDS_WAIT(); asm volatile("" ::: "memory");
    const int c = lane & 7;
#pragma unroll
    for (int j = 0; j < 4; ++j) { const int n = (lane >> 3) + 8 * j; const LAS float* s = scr + (8 * c) * 33 + n;
        v4u o; o.x = cvtpk(s[0 * 33], s[1 * 33]); o.y = cvtpk(s[2 * 33], s[3 * 33]); o.z = cvtpk(s[4 * 33], s[5 * 33]); o.w = cvtpk(s[6 * 33], s[7 * 33]);
        *(v4u*)(I.WT + (size_t)(n0 + n) * I.K + k0 + 8 * c) = o; }
    LDS_WAIT(); asm volatile("" ::: "memory");
}
struct P0Args { const float *x, *mixg, *mlpg, *w_in, *w_s, *w_outa, *w_qkv, *w_outb, *relb, *w_up, *w_dn; unsigned char* ws; };
__device__ __forceinline__ P0Item p0_item(const P0Args& A, int it) {
    constexpr int I0 = (D / 64) * (2 * D / 32), I1 = (D / 64) * (D / 32), I2 = (D / 64) * (NQKV / 32), I3 = (AW / 64) * (D / 32), I4 = (D / 64) * (FF / 32), I6 = (FF / 64) * (D / 32);
    unsigned char* ws = A.ws; int r = it;
    if (r < I0) return P0Item{A.w_in, A.mixg, (bf16*)(ws + WS_WIN), D, 2 * D, r}; r -= I0;
    if (r < I1) return P0Item{A.w_outa, nullptr, (bf16*)(ws + WS_WOA), D, D, r}; r -= I1;
    if (r < I2) return P0Item{A.w_qkv, A.mixg + D, (bf16*)(ws + WS_WQKV), D, NQKV, r}; r -= I2;
    if (r < I3) return P0Item{A.w_outb, nullptr, (bf16*)(ws + WS_WOB), AW, D, r}; r -= I3;
    if (r < I4) return P0Item{A.w_up, A.mlpg, (bf16*)(ws + WS_WUP), D, FF, r}; r -= I4;
    if (r < I4) return P0Item{A.w_up + (size_t)D * FF, A.mlpg + D, (bf16*)(ws + WS_WUP + 8 * MiB), D, FF, r}; r -= I4;
    if (r < I6) return P0Item{A.w_dn, nullptr, (bf16*)(ws + WS_WDN), FF, D, r}; r -= I6;
    return P0Item{A.w_dn + (size_t)FF * D, nullptr, (bf16*)(ws + WS_WDN + 8 * MiB), FF, D, r};
}
constexpr int P0_I_IN = (D / 64) * (2 * D / 32), P0_I_OA = (D / 64) * (D / 32), P0_I_QKV = (D / 64) * (NQKV / 32), P0_I_OB = (AW / 64) * (D / 32), P0_I_UP = (D / 64) * (FF / 32), P0_I_DN = (FF / 64) * (D / 32);
constexpr int P0_AT_OA = P0_I_IN, P0_AT_UP0 = P0_AT_OA + P0_I_OA + P0_I_QKV + P0_I_OB, P0_AT_UP1 = P0_AT_UP0 + P0_I_UP, P0_AT_DN0 = P0_AT_UP1 + P0_I_UP, P0_AT_DN1 = P0_AT_DN0 + P0_I_DN;
__device__ __forceinline__ void p0_items(const Ctx& C, const P0Args& A, int widx, int wcnt, int a0, int n0, int a1, int n1) {
    LAS float* scr = (LAS float*)(C.lds + RING_OFF + C.wave * 16384);
    const int n = n0 + n1;
#define P0_MAP(j_) ((j_) < n0 ? a0 + (j_) : a1 + ((j_) - n0))
    if (widx < n) {
        f32x4 va[8], vb[8]; P0Item ia = p0_item(A, P0_MAP(widx)); p0_item_load(ia, C.lane, va);
        for (int it = widx; it < n; it += 2 * wcnt) {
            const bool hb = it + wcnt < n; P0Item ib = ia; if (hb) { ib = p0_item(A, P0_MAP(it + wcnt)); p0_item_load(ib, C.lane, vb); }
            p0_item_store(ia, C.lane, va, scr);
            const bool ha = it + 2 * wcnt < n; if (ha) { ia = p0_item(A, P0_MAP(it + 2 * wcnt)); p0_item_load(ia, C.lane, va); }
            if (hb) p0_item_store(ib, C.lane, vb, scr);
        }
    }
#undef P0_MAP
}
__device__ __forceinline__ void p0_prologue(const Ctx& C, const P0Args& A) {
    const int gw = C.vcu * NWAVES + C.wave, NGW = C.G * NWAVES;
    unsigned char* ws = A.ws;
    p0_items(C, A, gw, NGW, 0, P0_I_IN, 0, 0);
    const int gt = (C.vcu * NWAVES + C.wave) * 64 + C.lane, NGT = NGW * 64;
    { bf16* wst = (bf16*)(ws + WS_WST);
      for (int i = gt; i < NGRP * CHUNK * CHUNK; i += NGT) { const int t = (i >> 7) & 127, s = i & 127; const float w = (s <= t) ? A.w_s[i] : 0.f; wst[i] = (bf16)(cvtpk(w, 0.f) & 0xffffu); } }
    { float* lut = (float*)(ws + WS_LUT);
      for (int i = gt; i < 24 * LUT_N; i += NGT) { const int gh = i / LUT_N, idx = i % LUT_N, g = gh >> 3, rel = idx - 16; float v = 0.f;
          if (rel >= 0 && rel <= 128) { const int dil = (g == 0) ? 1 : (g == 1) ? 4 : 16; const int dist = rel * dil; int bucket;
              if (dist < 16) bucket = dist; else { const float nf = (float)dist; int lg = 16 + (int)(logf(nf / 16.0f) / 4.852030263919617f * 16.0f); bucket = lg < 31 ? lg : 31; }
              v = A.relb[bucket * 24 + gh] * LOG2E; }
          lut[i] = v; } }
    { bf16* xn = (bf16*)(ws + WS_XN); float* ssq = (float*)(ws + WS_SSQ);
      f32x4 v0[4], v1[4];
      if (gw < M) {
#pragma unroll
          for (int j = 0; j < 4; ++j) v0[j] = __builtin_nontemporal_load(((const f32x4*)(A.x + (size_t)gw * D) + C.lane) + 64 * j); }
#define P0_ROW(m_, v_) do { float s_ = 0.f; _Pragma("unroll") for (int j = 0; j < 4; ++j) s_ += (v_[j][0] * v_[j][0] + v_[j][1] * v_[j][1]) + (v_[j][2] * v_[j][2] + v_[j][3] * v_[j][3]); \
          u32x2v* o_ = (u32x2v*)(xn + (size_t)(m_) * D) + C.lane; _Pragma("unroll") for (int j = 0; j < 4; ++j) o_[64 * j] = (u32x2v){cvtpk(v_[j][0], v_[j][1]), cvtpk(v_[j][2], v_[j][3])}; \
          s_ = wave_sum(s_); if (C.lane < 16) ssq[(size_t)(m_) * 16 + C.lane] = (C.lane == 0) ? s_ : 0.f; } while (0)
      for (int m = gw; m < M; m += 2 * NGW) {
          const bool hb = m + NGW < M;
          if (hb) {
#pragma unroll
              for (int j = 0; j < 4; ++j) v1[j] = __builtin_nontemporal_load(((const f32x4*)(A.x + (size_t)(m + NGW) * D) + C.lane) + 64 * j); }
          P0_ROW(m, v0);
          if (m + 2 * NGW < M) {
#pragma unroll
              for (int j = 0; j < 4; ++j) v0[j] = __builtin_nontemporal_load(((const f32x4*)(A.x + (size_t)(m + 2 * NGW) * D) + C.lane) + 64 * j); }
          if (hb) P0_ROW(m + NGW, v1);
      }
#undef P0_ROW
    }
}

constexpr int G_VT = 0, G_WS = 32768, G_BS = G_WS + 128 * 136 * 2, G_BUF = G_BS + 512, G_STAT = 2 * G_BUF, G_LN = G_STAT + 1024;
static_assert(G_LN + 12288 <= LDSCTL_OFF, "gating LDS map");
__device__ __forceinline__ int vt_off(int c, int s) { return c * 128 + ((((s >> 3) ^ (c & 7) ^ ((c >> 3) & 15)) & 15) << 3) + (s & 7); }
__device__ __forceinline__ void p2_gating(const Ctx& C, int chunk0, unsigned char* big, const float* vst, const bf16* wst, const float* lng, const float* lnb, const float* bs) {
    LAS f32x2v* STAT = (LAS f32x2v*)(C.lds + G_STAT); LAS float* LNP = (LAS float*)(C.lds + G_LN);
    const int tid = C.tid, lane = C.lane, w = C.wave, r16 = lane & 15, qq = lane >> 4;
    const int cc = tid & 15;
    for (int chunk = chunk0; chunk < chunk0 + 1; ++chunk) {
        const size_t tok0 = (size_t)chunk * CHUNK;
        const bf16* UVc = (const bf16*)(big + (size_t)(chunk >> 1) * BLK) + (size_t)(chunk & 1) * CHUNK * (2 * D);
        bf16* UGc = (bf16*)(big + (size_t)(chunk >> 1) * BLK + BLK_UG) + (size_t)(chunk & 1) * CHUNK * D;
        __syncthreads();
        { const int row = tid >> 2, part = tid & 3; const f32x4* pp = (const f32x4*)(vst + ((tok0 + row) * 16 + part * 4) * 2);
          const f32x4 a = pp[0], b = pp[1]; float s1 = (a[0] + a[2]) + (b[0] + b[2]), s2 = (a[1] + a[3]) + (b[1] + b[3]);
          s1 += __shfl_xor(s1, 1); s1 += __shfl_xor(s1, 2); s2 += __shfl_xor(s2, 1); s2 += __shfl_xor(s2, 2);
          const float mean = s1 * (1.0f / 1024.0f), var = s2 * (1.0f / 1024.0f) - mean * mean;
          if (part == 0) STAT[row] = (f32x2v){mean, __builtin_amdgcn_rsqf(fmaxf(var, 0.f) + EPS)}; }
        { *(LAS f32x2v*)(LNP + tid * 2) = *(const f32x2v*)(lng + tid * 2); *(LAS f32x2v*)(LNP + 1024 + tid * 2) = *(const f32x2v*)(lnb + tid * 2); *(LAS f32x2v*)(LNP + 2048 + tid * 2) = *(const f32x2v*)(bs + tid * 2); }
        v4u vraw[2][4], wraw[4]; u32x2v uu[2][8];
#define P2_LOADW(g) do { _Pragma("unroll") for (int i = 0; i < 4; ++i) { const int id_ = tid + 512 * i; wraw[i] = *(const v4u*)(wst + (size_t)(g) * 16384 + (id_ >> 4) * 128 + (id_ & 15) * 8); } } while (0)
#define P2_LOADV(g, set) do { _Pragma("unroll") for (int i = 0; i < 4; ++i) vraw[set][i] = __builtin_nontemporal_load((const v4u*)(UVc + (size_t)((tid >> 4) + 32 * i) * (2 * D) + D + (g) * 128 + cc * 8)); } while (0)
#define P2_LOADU(g, set) do { _Pragma("unroll") for (int tt = 0; tt < 8; ++tt) uu[set][tt] = __builtin_nontemporal_load((const u32x2v*)(UVc + (size_t)(16 * tt + r16) * (2 * D) + (g) * 128 + 16 * w + 4 * qq)); } while (0)
#define P2_WRITE(g, buf, set) do { LAS bf16* VT_ = (LAS bf16*)(C.lds + (buf) * G_BUF + G_VT); LAS bf16* WS_ = (LAS bf16*)(C.lds + (buf) * G_BUF + G_WS); \
        const LAS f32x4* lp_ = (const LAS f32x4*)(LNP + (g) * 128 + cc * 8); const f32x4 g0 = lp_[0], g1 = lp_[1], b0 = lp_[256], b1 = lp_[257]; \
        _Pragma("unroll") for (int i = 0; i < 4; ++i) { const int s = (tid >> 4) + 32 * i; const f32x2v st = STAT[s]; const v4u raw = vraw[set][i]; \
            const float v[8] = {bflo(raw.x), bfhi(raw.x), bflo(raw.y), bfhi(raw.y), bflo(raw.z), bfhi(raw.z), bflo(raw.w), bfhi(raw.w)}; \
            _Pragma("unroll") for (int j = 0; j < 8; ++j) { const float gg = j < 4 ? g0[j & 3] : g1[j & 3], bb = j < 4 ? b0[j & 3] : b1[j & 3]; \
                const float y = (v[j] - st.x) * st.y * gg + bb; VT_[vt_off(cc * 8 + j, s)] = (bf16)(cvtpk(y, 0.f) & 0xffffu); } \
            const int id_ = tid + 512 * i; *(LAS v4u*)(WS_ + (id_ >> 4) * 136 + (id_ & 15) * 8) = wraw[i]; } } while (0)
        P2_LOADW(0); P2_LOADV(0, 0); P2_LOADV(1, 1); P2_LOADU(0, 0);
        __syncthreads();
        P2_WRITE(0, 0, 0);
        P2_LOADW(1); P2_LOADV(2, 0); P2_LOADU(1, 1);
        __syncthreads();
#define P2_BODY(g, PAR) do { \
            const LAS bf16* VT = (const LAS bf16*)(C.lds + (PAR) * G_BUF + G_VT); const LAS bf16* WS = (const LAS bf16*)(C.lds + (PAR) * G_BUF + G_WS); const LAS float* BS = LNP + 2048 + (g) * 128; \
              \
            bf16x8 xf[4]; \
            _Pragma("unroll") for (int ks = 0; ks < 4; ++ks) xf[ks] = *(const LAS bf16x8*)(VT + vt_off(16 * w + r16, 32 * ks + 8 * qq)); \
            _Pragma("unroll") for (int tt = 0; tt < 8; ++tt) { \
                f32x4 acc = (f32x4){0.f, 0.f, 0.f, 0.f}; \
                _Pragma("unroll") for (int ks = 0; ks <= tt / 2; ++ks) { const bf16x8 yf = *(const LAS bf16x8*)(WS + (16 * tt + r16) * 136 + 32 * ks + 8 * qq); \
                    acc = __builtin_amdgcn_mfma_f32_16x16x32_bf16(xf[ks], yf, acc, 0, 0, 0); } \
                const int t = 16 * tt + r16; const float bsv = BS[t]; const u32x2v uv_ = uu[PAR][tt]; \
                const float o0 = bflo(uv_.x) * (acc[0] + bsv), o1 = bfhi(uv_.x) * (acc[1] + bsv), o2 = bflo(uv_.y) * (acc[2] + bsv), o3 = bfhi(uv_.y) * (acc[3] + bsv); \
                *(u32x2v*)(UGc + (size_t)t * D + (g) * 128 + 16 * w + 4 * qq) = (u32x2v){cvtpk(o0, o1), cvtpk(o2, o3)}; \
            } \
            if ((g) + 1 < NGRP) P2_WRITE((g) + 1, (PAR) ^ 1, (PAR) ^ 1);        \
            if ((g) + 2 < NGRP) P2_LOADW((g) + 2); \
            if ((g) + 3 < NGRP) P2_LOADV((g) + 3, (PAR) ^ 1); \
            if ((g) + 2 < NGRP) P2_LOADU((g) + 2, PAR); \
            __syncthreads(); } while (0)
        for (int g = 0; g < NGRP; g += 2) { P2_BODY(g, 0); P2_BODY(g + 1, 1); }
#undef P2_BODY
#undef P2_LOADW
#undef P2_LOADV
#undef P2_LOADU
#undef P2_WRITE
    }
    __syncthreads();
}
constexpr int A_SLOT = 32768, A_VOFF = 16384, A_QOFF = 4 * A_SLOT, A_LUT = A_QOFF + 16384;
static_assert(A_LUT + 1024 <= LDSCTL_OFF, "attention LDS map");
constexpr int ATT_UNITS = 3 * BATCH * NH * 64;
typedef short v4i16_t __attribute__((ext_vector_type(4)));
__device__ __forceinline__ u32x2v tr16(const LAS bf16* p) { return __builtin_bit_cast(u32x2v, __builtin_amdgcn_ds_read_tr16_b64_v4i16((LAS v4i16_t*)p)); }
__device__ __forceinline__ float max3f(float a, float b, float c) { float r; asm("v_max3_f32 %0, %1, %2, %3" : "=v"(r) : "v"(a), "v"(b), "v"(c)); return r; }
struct AU { int g, b, h, r, n, dil; };
__device__ __forceinline__ AU att_decode(int U) { AU a; a.g = U >> 11; const int rem = U & 2047; a.b = rem >> 9; a.h = (rem >> 6) & 7; const int rn = rem & 63;
    a.dil = (a.g == 0) ? 1 : (a.g == 1) ? 4 : 16; const int nb = 64 / a.dil; a.r = rn / nb; a.n = rn % nb; return a; }
template <int VAR> __device__ __forceinline__ void p7_attention(const Ctx& C, bf16* QKV, float* lse, const float* lutg) {
    LAS unsigned char* L = C.lds; LAS float* LUT = (LAS float*)(L + A_LUT);
    const int tid = C.tid, lane = C.lane, w = C.wave, r16 = lane & 15, qq = lane >> 4;
    const int per = (ATT_UNITS + C.G - 1) / C.G;
    const int u_lo = C.vcu * per, u_hi = (u_lo + per < ATT_UNITS) ? u_lo + per : ATT_UNITS;
    if (u_lo >= u_hi) return;
#define ATT_SLICE(a, t) (QKV + ((size_t)((((t) * 3 + (a).g) * 8 + (a).h) * BATCH + (a).b) * SEQ + (size_t)(a).r * (SEQ / (a).dil)) * 64)
    const int drow = lane >> 3, dch = lane & 7;
#define ATT_GLDS(gsrc, ldsoff) do { unsigned keep_; const unsigned ldst_ = (unsigned)__builtin_amdgcn_readfirstlane((int)((unsigned)(uintptr_t)L + (unsigned)(ldsoff))); const bf16* gs_ = (gsrc); \
        asm volatile("s_mov_b32 %0, m0\n\ts_mov_b32 m0, %2\n\ts_nop 0\n\tglobal_load_lds_dwordx4 %1, off\n\ts_mov_b32 m0, %0" : "=&s"(keep_) : "v"(gs_), "s"(ldst_) : "memory"); } while (0)
#define ATT_DMA_BLOCK(a, nblk, slot) do { _Pragma("unroll") for (int j_ = 0; j_ < 2; ++j_) { const int row_ = 16 * w + 8 * j_ + drow; \
        const size_t go_ = (size_t)((nblk) * 128 + row_) * 64 + ((dch ^ ((row_ >> 1) & 7)) << 3); const int lo_ = (slot) * A_SLOT + (16 * w + 8 * j_) * 128; \
        ATT_GLDS(ATT_SLICE(a, 1) + go_, lo_); ATT_GLDS(ATT_SLICE(a, 2) + go_, lo_ + A_VOFF); } } while (0)
#define ATT_LDQ(a, q0, q1) do { const bf16* qp_ = ATT_SLICE(a, 0) + (size_t)((a).n * 128 + 16 * w + r16) * 64 + 8 * qq; \
        asm volatile("global_load_dwordx4 %0, %2, off\n\tglobal_load_dwordx4 %1, %2, off offset:64" : "=&v"(q0), "=&v"(q1) : "v"(qp_) : "memory"); } while (0)
#define ATT_WAITBAR_Q(N, q0, q1) do { asm volatile("s_waitcnt vmcnt(" #N ") lgkmcnt(0)" : "+v"(q0), "+v"(q1) :: "memory"); __builtin_amdgcn_s_barrier(); asm volatile("" ::: "memory"); } while (0)
#define ATT_WAITBAR(N) do { asm volatile("s_waitcnt vmcnt(" #N ") lgkmcnt(0)" ::: "memory"); __builtin_amdgcn_s_barrier(); asm volatile("" ::: "memory"); } while (0)
    AU cu = att_decode(u_lo);
    u32x4 qreg[2][2];
    {
      __builtin_amdgcn_s_waitcnt(0x0F70);
      __builtin_amdgcn_s_barrier();
      if (cu.n > 0) { ATT_DMA_BLOCK(cu, cu.n - 1, 3); }
      else { _Pragma("unroll") for (int i = 0; i < 4; ++i) *(LAS v4u*)(L + 3 * A_SLOT + (tid + 512 * i) * 16) = (v4u){0u, 0u, 0u, 0u};
             _Pragma("unroll") for (int j_ = 0; j_ < 4; ++j_) ATT_GLDS(ATT_SLICE(cu, 1) + (size_t)lane * 8, 2 * A_SLOT + (16 * w + 8 * (j_ & 1)) * 128 + (j_ >> 1) * A_VOFF); }
      ATT_DMA_BLOCK(cu, cu.n, 0);
      const AU n1 = att_decode(u_lo + 1 < u_hi ? u_lo + 1 : u_lo);
      ATT_LDQ(cu, qreg[0][0], qreg[0][1]); ATT_LDQ(n1, qreg[1][0], qreg[1][1]);
      ATT_DMA_BLOCK(n1, n1.n, 1);
      if (tid < LUT_N) LUT[tid] = lutg[(cu.g * 8 + cu.h) * LUT_N + tid];
      asm volatile("s_waitcnt vmcnt(4)" : "+v"(qreg[0][0]), "+v"(qreg[0][1]) :: "memory");
      ATT_WAITBAR_Q(4, qreg[1][0], qreg[1][1]); }
    for (int U0 = u_lo; U0 < u_hi; U0 += 2) {
#pragma unroll
      for (int par = 0; par < 2; ++par) {
        const int U = U0 + par; if (U >= u_hi) break;
        const int ui = U - u_lo;
        const AU nx = att_decode(U + 1 < u_hi ? U + 1 : U), nx2 = att_decode(U + 2 < u_hi ? U + 2 : U);
        const int pbase = ((ui + 3) & 3) * A_SLOT, cbase = (ui & 3) * A_SLOT;
        const bf16x8 qf[2] = {__builtin_bit_cast(bf16x8, qreg[par][0]), __builtin_bit_cast(bf16x8, qreg[par][1])};
        if constexpr (VAR < 3) {
        ATT_DMA_BLOCK(nx2, nx2.n, (ui + 2) & 3);
        }
        f32x4 o[4]; float mx = 0.f, lsum = 1.f;
        if constexpr (VAR == 2) { _Pragma("unroll") for (int dt = 0; dt < 4; ++dt) { o[dt] = (f32x4){qf[0][0] * 1.0f, 0.f, 0.f, 0.f}; } } else {
        f32x4 s[9];
#pragma unroll
        for (int kt = 0; kt < 9; ++kt) { const int kk0 = 16 * w + 16 * kt, row = (kk0 & 127) + r16, sw = (row >> 1) & 7;
            const LAS unsigned char* kp = L + (kk0 < 128 ? pbase : cbase) + row * 128;
            const bf16x8 k0 = *(const LAS bf16x8*)(kp + ((qq ^ sw) << 4)), k1 = *(const LAS bf16x8*)(kp + (((qq + 4) ^ sw) << 4));
            f32x4 a = (f32x4){0.f, 0.f, 0.f, 0.f};
            a = __builtin_amdgcn_mfma_f32_16x16x32_bf16(k0, qf[0], a, 0, 0, 0);
            a = __builtin_amdgcn_mfma_f32_16x16x32_bf16(k1, qf[1], a, 0, 0, 0); s[kt] = a; }
        if constexpr (VAR < 3) { ATT_LDQ(nx2, qreg[par][0], qreg[par][1]); }
        const float SC = 0.125f * LOG2E, NEG = -1e30f;
        const LAS float* lp = LUT + (144 + r16 - 4 * qq);
#pragma unroll
        for (int kt = 0; kt < 9; ++kt)
#pragma unroll
            for (int j = 0; j < 4; ++j) { float t = s[kt][j] * SC + lp[-(16 * kt + j)];
                if (kt == 0) t = (4 * qq + j >= r16) ? t : NEG;
                if (kt == 8) t = (4 * qq + j <= r16) ? t : NEG;
                s[kt][j] = t; }
        if (cu.n == 0) {
#pragma unroll
            for (int kt = 0; kt < 8; ++kt) if (kt < 8 - w) { s[kt] = (f32x4){NEG, NEG, NEG, NEG}; asm volatile("" : "+v"(s[kt])); } }
        { float a_ = max3f(s[0][0], s[0][1], s[0][2]), b_ = max3f(s[0][3], s[1][0], s[1][1]);
#pragma unroll
          for (int kt = 1; kt < 9; ++kt) { if (kt & 1) { a_ = max3f(a_, s[kt][2], s[kt][3]); if (kt + 1 < 9) b_ = max3f(b_, s[kt + 1][0], s[kt + 1][1]); }
                                           else { a_ = max3f(a_, s[kt][2], s[kt][3]); if (kt + 1 < 9) b_ = max3f(b_, s[kt + 1][0], s[kt + 1][1]); } }
          mx = fmaxf(a_, b_); }
        mx = fmaxf(mx, __shfl_xor(mx, 16)); mx = fmaxf(mx, __shfl_xor(mx, 32));
#pragma unroll
        for (int kt = 0; kt < 9; ++kt)
#pragma unroll
            for (int j = 0; j < 4; ++j) s[kt][j] = __builtin_amdgcn_exp2f(s[kt][j] - mx);
        f32x4 osum = (f32x4){0.f, 0.f, 0.f, 0.f};
        const bf16x8 ones = (bf16x8){0x3F80, 0x3F80, 0x3F80, 0x3F80, 0x3F80, 0x3F80, 0x3F80, 0x3F80};
        const int vrow = 4 * qq + (r16 >> 2), vc = (r16 & 3) >> 1, vh = (r16 & 1) * 8;
#pragma unroll
        for (int dt = 0; dt < 4; ++dt) o[dt] = (f32x4){0.f, 0.f, 0.f, 0.f};
#pragma unroll
        for (int ks = 0; ks < 5; ++ks) {
            u32x4 pw; pw.x = cvtpk(s[2 * ks][0], s[2 * ks][1]); pw.y = cvtpk(s[2 * ks][2], s[2 * ks][3]);
            if (ks < 4) { pw.z = cvtpk(s[2 * ks + 1][0], s[2 * ks + 1][1]); pw.w = cvtpk(s[2 * ks + 1][2], s[2 * ks + 1][3]); } else { pw.z = 0u; pw.w = 0u; }
            const bf16x8 pf = __builtin_bit_cast(bf16x8, pw);
            osum = __builtin_amdgcn_mfma_f32_16x16x32_bf16(ones, pf, osum, 0, 0, 0);
            const int ka = 16 * w + 32 * ks, kb = ka + 16;
            const int rowa = (ka & 127) + vrow, rowb = (kb & 127) + vrow, swa = (rowa >> 1) & 7, swb = (rowb >> 1) & 7;
            const LAS unsigned char* pa = L + (ka < 128 ? pbase : cbase) + A_VOFF + rowa * 128 + vh; const LAS unsigned char* pb = L + (kb < 128 ? pbase : cbase) + A_VOFF + rowb * 128 + vh;
#pragma unroll
            for (int dt = 0; dt < 4; ++dt) {
                const u32x2v lo = tr16((const LAS bf16*)(pa + (((2 * dt + vc) ^ swa) << 4)));
                u32x2v hi = (u32x2v){0u, 0u}; if (ks < 4) hi = tr16((const LAS bf16*)(pb + (((2 * dt + vc) ^ swb) << 4)));
                const u32x4 vw = (u32x4){lo.x, lo.y, hi.x, hi.y};
                o[dt] = __builtin_amdgcn_mfma_f32_16x16x32_bf16(__builtin_bit_cast(bf16x8, vw), pf, o[dt], 0, 0, 0); } }
        lsum = osum[0]; }
        const float inv = 1.0f / lsum;
        bf16* op = ATT_SLICE(cu, 0) + (size_t)(cu.n * 128 + 16 * w + r16) * 64 + 4 * qq;
        if constexpr (VAR == 4) { asm volatile("" :: "v"(o[0]), "v"(o[1]), "v"(o[2]), "v"(o[3]), "v"(inv), "v"(mx)); } else {
#pragma unroll
        for (int dt = 0; dt < 4; ++dt)
            *(u32x2v*)(op + 16 * dt) = (u32x2v){cvtpk(o[dt][0] * inv, o[dt][1] * inv), cvtpk(o[dt][2] * inv, o[dt][3] * inv)};
        }
        if (VAR != 4 && qq == 0) lse[((size_t)cu.g * M + (size_t)cu.b * SEQ + (size_t)((cu.n * 128 + 16 * w + r16) * cu.dil + cu.r)) * NH + cu.h] = mx + log2f(lsum);
        if ((nx.g * 8 + nx.h) != (cu.g * 8 + cu.h)) {
            ATT_WAITBAR_Q(11, qreg[par ^ 1][0], qreg[par ^ 1][1]); if (tid < LUT_N) LUT[tid] = lutg[(nx.g * 8 + nx.h) * LUT_N + tid]; ATT_WAITBAR(0); }
        else ATT_WAITBAR_Q(11, qreg[par ^ 1][0], qreg[par ^ 1][1]);
        cu = nx;
      }
    }
    ATT_WAITBAR(0);
#undef ATT_SLICE
#undef ATT_GLDS
#undef ATT_DMA_BLOCK
#undef ATT_LDQ
#undef ATT_WAITBAR_Q
#undef ATT_WAITBAR
}
__device__ __forceinline__ void p8_merge(const Ctx& C, int row_lo, const bf16* QKV, const float* lse, bf16* OM) {
    for (int idx = row_lo * 64 + C.tid; idx < (row_lo + 128) * 64; idx += NWAVES * 64) { const int tok = idx >> 6, cch = idx & 63, h = cch >> 3;
        const float l0 = lse[((size_t)0 * M + tok) * NH + h], l1 = lse[((size_t)1 * M + tok) * NH + h], l2 = lse[((size_t)2 * M + tok) * NH + h];
        const float mx = fmaxf(l0, fmaxf(l1, l2)); float w0 = __builtin_amdgcn_exp2f(l0 - mx), w1 = __builtin_amdgcn_exp2f(l1 - mx), w2 = __builtin_amdgcn_exp2f(l2 - mx);
        const float inv = 1.0f / (w0 + w1 + w2); w0 *= inv; w1 *= inv; w2 *= inv;
        const int b = tok >> 13, pos = tok & (SEQ - 1);
        const size_t hs = (size_t)BATCH * SEQ * 64;
        const bf16* base = QKV + ((size_t)b * SEQ) * 64 + (cch & 7) * 8;
        const v4u a = __builtin_nontemporal_load((const v4u*)(base + (size_t)(0 * 8 + h) * hs + (size_t)pos * 64));
        const v4u bb = __builtin_nontemporal_load((const v4u*)(base + (size_t)(1 * 8 + h) * hs + ((size_t)(pos & 3) * (SEQ / 4) + (pos >> 2)) * 64));
        const v4u c = __builtin_nontemporal_load((const v4u*)(base + (size_t)(2 * 8 + h) * hs + ((size_t)(pos & 15) * (SEQ / 16) + (pos >> 4)) * 64));
        v4u o;
        o.x = cvtpk(w0 * bflo(a.x) + w1 * bflo(bb.x) + w2 * bflo(c.x), w0 * bfhi(a.x) + w1 * bfhi(bb.x) + w2 * bfhi(c.x));
        o.y = cvtpk(w0 * bflo(a.y) + w1 * bflo(bb.y) + w2 * bflo(c.y), w0 * bfhi(a.y) + w1 * bfhi(bb.y) + w2 * bfhi(c.y));
        o.z = cvtpk(w0 * bflo(a.z) + w1 * bflo(bb.z) + w2 * bflo(c.z), w0 * bfhi(a.z) + w1 * bfhi(bb.z) + w2 * bfhi(c.z));
        o.w = cvtpk(w0 * bflo(a.w) + w1 * bflo(bb.w) + w2 * bflo(c.w), w0 * bfhi(a.w) + w1 * bfhi(bb.w) + w2 * bfhi(c.w));
        *(v4u*)(OM + (size_t)tok * AW + cch * 8) = o; }
}
__device__ __forceinline__ void p12_final(const Ctx& C, int row_lo, const bf16* hb, float* out, const float* ssq, const float* gfin) {
    f32x4 gv[4];
#pragma unroll
    for (int j = 0; j < 4; ++j) gv[j] = ((const f32x4*)gfin)[C.lane + 64 * j];
    for (int m = row_lo + C.wave; m < row_lo + 128; m += NWAVES) {
        float s = ssq[(size_t)m * 16 + (C.lane & 15)];
        const u32x2v* hr = (const u32x2v*)(hb + (size_t)m * D) + C.lane; u32x2v v[4];
#pragma unroll
        for (int j = 0; j < 4; ++j) v[j] = hr[64 * j];
        s += __shfl_xor(s, 1); s += __shfl_xor(s, 2); s += __shfl_xor(s, 4); s += __shfl_xor(s, 8);
        const float rs = __builtin_amdgcn_rsqf(s * (1.0f / 1024.0f) + EPS);
        f32x4* xr = (f32x4*)(out + (size_t)m * D) + C.lane;
#pragma unroll
        for (int j = 0; j < 4; ++j) xr[64 * j] = (f32x4){bflo(v[j].x), bfhi(v[j].x), bflo(v[j].y), bfhi(v[j].y)} * rs * gv[j]; }
}
__device__ __forceinline__ void gate_arrive(unsigned* cnt) { if (threadIdx.x == 0) (void)__hip_atomic_fetch_add(cnt, 1u, __ATOMIC_RELAXED, __HIP_MEMORY_SCOPE_AGENT); }
struct GrpBar { unsigned* cnt; unsigned phase; unsigned same; };
__device__ __forceinline__ void grp_barrier(GrpBar& b) {
    asm volatile("s_waitcnt vmcnt(0)" ::: "memory");
    __syncthreads();
    if (threadIdx.x == 0) {
        if (!b.same) { __builtin_amdgcn_fence(__ATOMIC_RELEASE, "agent"); asm volatile("s_waitcnt vmcnt(0)" ::: "memory"); }
        const unsigned target = (b.phase + 1u) * 4u;
        (void)__hip_atomic_fetch_add(b.cnt, 1u, __ATOMIC_RELAXED, __HIP_MEMORY_SCOPE_AGENT);
        unsigned sp = 0u;
        while (__hip_atomic_load(b.cnt, __ATOMIC_RELAXED, __HIP_MEMORY_SCOPE_AGENT) < target) { __builtin_amdgcn_s_sleep(1); if (++sp > (1u << 22)) break; }
        __builtin_amdgcn_fence(__ATOMIC_ACQUIRE, "agent"); asm volatile("s_waitcnt vmcnt(0)" ::: "memory");
    }
    __syncthreads();
    ++b.phase;
}
namespace pg8 {
struct EpiFinal {
    static constexpr bool PERM = true, AFTER_DRAIN = false;
    const bf16_t* hb; float* out; float* ssq; const float* gfin; int ldc; GrpBar* gb;
    __device__ __forceinline__ void operator()(f32x4 (&acc)[2][2][4][2], const Unit& u, int wr, int wc, int fr, int fq) const {
        const int row0 = u.pm * BM + wr * 64 + fr, col0 = u.pn * BM + wc * 32 + 8 * fq;
        { u32x4 r[2][4][2];
#pragma unroll
          for (int ai = 0; ai < 2; ++ai)
#pragma unroll
              for (int m = 0; m < 4; ++m)
#pragma unroll
                  for (int bj = 0; bj < 2; ++bj) r[ai][m][bj] = *(const u32x4*)(hb + (size_t)(row0 + ai * HALF + m * 16) * ldc + col0 + bj * HALF);
          asm volatile("s_waitcnt vmcnt(0)" ::: "memory");
#pragma unroll
          for (int ai = 0; ai < 2; ++ai)
#pragma unroll
              for (int m = 0; m < 4; ++m) { float q = 0.f;
#pragma unroll
                  for (int bj = 0; bj < 2; ++bj) { const u32x4 rr = r[ai][m][bj];
                      acc[ai][bj][m][0] += (f32x4){bf_lo(rr.x), bf_hi(rr.x), bf_lo(rr.y), bf_hi(rr.y)}; acc[ai][bj][m][1] += (f32x4){bf_lo(rr.z), bf_hi(rr.z), bf_lo(rr.w), bf_hi(rr.w)};
                      const f32x4 h0 = acc[ai][bj][m][0], h1 = acc[ai][bj][m][1];
                      q += ((h0[0] * h0[0] + h0[1] * h0[1]) + (h0[2] * h0[2] + h0[3] * h0[3])) + ((h1[0] * h1[0] + h1[1] * h1[1]) + (h1[2] * h1[2] + h1[3] * h1[3])); }
                  q += __shfl_xor(q, 16); q += __shfl_xor(q, 32);
                  if (fq == 0) ssq[(size_t)(row0 + ai * HALF + m * 16) * 16 + u.pn * 4 + wc] = q; } }
        f32x4 gv[2][2];
#pragma unroll
        for (int bj = 0; bj < 2; ++bj)
#pragma unroll
            for (int n = 0; n < 2; ++n) gv[bj][n] = *(const f32x4*)(gfin + col0 + bj * HALF + 4 * n);
        grp_barrier(*gb);
        f32x4 p[2][4];
#pragma unroll
        for (int ai = 0; ai < 2; ++ai)
#pragma unroll
            for (int m = 0; m < 4; ++m) p[ai][m] = *(const f32x4*)(ssq + (size_t)(row0 + ai * HALF + m * 16) * 16 + fq * 4);
#pragma unroll
        for (int ai = 0; ai < 2; ++ai)
#pragma unroll
            for (int m = 0; m < 4; ++m) { float s = (p[ai][m][0] + p[ai][m][1]) + (p[ai][m][2] + p[ai][m][3]);
                s += __shfl_xor(s, 16); s += __shfl_xor(s, 32);
                const float rs = __builtin_amdgcn_rsqf(s * (1.0f / 1024.0f) + 1e-6f);
                float* orow = out + (size_t)(row0 + ai * HALF + m * 16) * ldc + col0;
#pragma unroll
                for (int bj = 0; bj < 2; ++bj) { *(f32x4*)(orow + bj * HALF) = acc[ai][bj][m][0] * rs * gv[bj][0]; *(f32x4*)(orow + bj * HALF + 4) = acc[ai][bj][m][1] * rs * gv[bj][1]; } }
    }
};
}
struct Args { const float* in[15]; float* out; unsigned char* ws; int ph_lo, ph_hi; };
__global__ void __launch_bounds__(NWAVES * 64, 2) trunk_fwd(Args args) {
    extern __shared__ __attribute__((aligned(16))) unsigned char lds[];
    Ctx C;
    C.lds = (LAS unsigned char*)lds;
    volatile LAS unsigned* MISC = (volatile LAS unsigned*)(C.lds + MISC_OFF);
    C.tid = threadIdx.x; C.lane = C.tid & 63; C.wave = __builtin_amdgcn_readfirstlane(C.tid >> 6);
    C.G = gridDim.x; { const int bx = blockIdx.x; C.vcu = (C.G % 8 == 0) ? (bx % 8) * (C.G / 8) + bx / 8 : bx; }
    const int gx = (int)blockIdx.x % 8, k8 = ((int)blockIdx.x / 8) % 8, gz = (int)blockIdx.x / 64;
    const int item_row = (16 * gx + 8 * (gz >> 1) + k8) * 256 + (gz & 1) * 128;
    unsigned char* ws = args.ws;
    gu32* ctl = (gu32*)(ws + WS_CTL);
    if (C.tid == 0 && !MK_SPLIT) __hip_atomic_store((unsigned*)(ctl + CW_XCC) + blockIdx.x, xb_xcc_id() + 1u, __ATOMIC_RELAXED, __HIP_MEMORY_SCOPE_AGENT);
    unsigned* gate5 = (unsigned*)(ctl + CW_GATE); unsigned* gate8 = (unsigned*)(ctl + CW_GATE + 64);
    GrpBar gbr; gbr.cnt = (unsigned*)(ctl + CW_GRP) + (gx * 8 + k8) * 64; gbr.phase = 0u; gbr.same = 0u;
    const int cls = (gx >> 1) & 1, cwave = ((gz * 8 + k8) * 4 + ((gx & 1) | ((gx >> 2) << 1))) * NWAVES + C.wave;
    unsigned* s1cnt = (unsigned*)(ctl + CW_GATE + 128);
    for (int u = C.tid; u < (LDS_BYTES - LDSCTL_OFF) / 4; u += NWAVES * 64) ((LAS unsigned*)(C.lds + LDSCTL_OFF))[u] = 0u;
    __syncthreads();
    XcdBarrier bar; bar.bar = (unsigned*)(ctl + CW_BAR); bar.x = 0; bar.st = nullptr;
    if (!MK_SPLIT) bar = xcd_barrier_post((unsigned*)(ctl + CW_BAR), MISC + 8);
    const float* x = args.in[0]; const float* mixg = args.in[1]; const float* mlpg = args.in[2]; const float* fing = args.in[3];
    bf16* XN = (bf16*)(ws + WS_XN); unsigned char* big = ws + WS_BIG; bf16* OM = (bf16*)(ws + WS_OM);
    float* SSQ = (float*)(ws + WS_SSQ); float* VST = (float*)(ws + WS_VST); float* LSE = (float*)(ws + WS_LSE);
    float* out = args.out;
    const int lo = args.ph_lo, hi = args.ph_hi; int pos = 0;
#define GSTEP(BODY) do { if (lo <= pos && pos < hi) { BODY } if (lo <= pos && pos + 1 < hi) { for (int rb_ = 0; rb_ < BAR_REPS; ++rb_) xcd_barrier(bar); } ++pos; } while (0)
#define CSTEP(BODY) do { if (lo <= pos && pos < hi) { BODY } if (lo <= pos && pos + 1 < hi) { for (int rb_ = 0; rb_ < BAR_REPS; ++rb_) grp_barrier(gbr); } ++pos; } while (0)
#define STEP(BODY) do { if (lo <= pos && pos < hi) { BODY } if (lo <= pos && pos + 1 < hi) { for (int rb_ = 0; rb_ < BAR_REPS; ++rb_) xcd_barrier(bar); } ++pos; } while (0)
#define P0ARGS P0Args{x, mixg, mlpg, args.in[4], args.in[7], args.in[9], args.in[10], args.in[11], args.in[12], args.in[13], args.in[14], ws}
#define PH0 { const P0Args A = P0ARGS; p0_prologue(C, A); }
#define PH1 { pg8::Gemm g{XN, (const bf16*)(ws + WS_WIN), M, 2 * D, D, (size_t)256 * D * 2}; pg8::StaticOrder S; S.init(M, 2 * D, C.G, (int)blockIdx.x); pg8::EpiAct<1> E{(bf16*)big, 2 * D, BLK / 2, pg8::RsTable{SSQ, (LAS float*)(C.lds + RSTAB_OFF), -1}, VST, pg8::GateW{nullptr, 0u, 0}}; \
        pg8::gemm_phase<pg8::EpiAct<1>, pg8::StaticOrder, true, true>(C.lds + RING_OFF, g, S, E); }
#define PH2 { p2_gating(C, item_row / CHUNK, big, VST, (const bf16*)(ws + WS_WST), args.in[5], args.in[6], args.in[8]); }
#define S1WAIT { if (C.tid == 0) { unsigned sp = 0u; while (__hip_atomic_load(s1cnt, __ATOMIC_RELAXED, __HIP_MEMORY_SCOPE_AGENT) < 128u) { __builtin_amdgcn_s_sleep(2); if (++sp > (1u << 22)) break; } \
        __builtin_amdgcn_fence(__ATOMIC_ACQUIRE, "agent"); asm volatile("s_waitcnt vmcnt(0)" ::: "memory"); } __syncthreads(); }
#define PH3 { S1WAIT pg8::Gemm g{(const bf16*)(big + BLK_UG), (const bf16*)(ws + WS_WOA), M, D, D, BLK}; pg8::StaticOrder S; S.init(M, D, C.G, (int)blockIdx.x); pg8::EpiRes E{XN, SSQ, D}; \
        pg8::gemm_phase<pg8::EpiRes, pg8::StaticOrder, true, true>(C.lds + RING_OFF, g, S, E); }
#define PHUP(L) { pg8::Gemm g{XN, (const bf16*)(ws + WS_WUP + (L) * 8 * MiB), M, FF, D, (size_t)256 * D * 2}; pg8::StaticOrder S; S.init(M, FF, C.G, (int)blockIdx.x); pg8::EpiAct<2> E{(bf16*)big, FF, BLK / 2, pg8::RsTable{SSQ, (LAS float*)(C.lds + RSTAB_OFF), -1}, nullptr, pg8::GateW{(L) ? gate8 : nullptr, (unsigned)C.G, 0}}; \
        pg8::gemm_phase<pg8::EpiAct<2>, pg8::StaticOrder, true, true>(C.lds + RING_OFF, g, S, E); }
#define PHDN(L) { pg8::Gemm g{(const bf16*)big, (const bf16*)(ws + WS_WDN + (L) * 8 * MiB), M, D, FF, BLK}; pg8::StaticOrder S; S.init(M, D, C.G, (int)blockIdx.x); S.reversed(); pg8::EpiRes E{XN, SSQ, D}; \
        pg8::gemm_phase<pg8::EpiRes, pg8::StaticOrder, true, true>(C.lds + RING_OFF, g, S, E); if ((L) == 0) gate_arrive(gate5); }
#define PHFIN { pg8::Gemm g{(const bf16*)big, (const bf16*)(ws + WS_WDN + 8 * MiB), M, D, FF, BLK}; pg8::StaticOrder S; S.init(M, D, C.G, (int)blockIdx.x); S.reversed(); pg8::EpiFinal E{XN, out, SSQ, fing, D, &gbr}; \
        pg8::gemm_phase<pg8::EpiFinal, pg8::StaticOrder, true, true>(C.lds + RING_OFF, g, S, E); }
#define PH6 { pg8::Gemm g{XN, (const bf16*)(ws + WS_WQKV), M, NQKV, D, (size_t)256 * D * 2}; pg8::StaticOrder S; S.init(M, NQKV, C.G, (int)blockIdx.x); pg8::EpiQKV E{(bf16*)big, pg8::RsTable{SSQ, (LAS float*)(C.lds + RSTAB_OFF), -1}, SEQ, BATCH, pg8::GateW{gate5, (unsigned)C.G, 0}}; \
        pg8::gemm_phase<pg8::EpiQKV, pg8::StaticOrder, true, true>(C.lds + RING_OFF, g, S, E); \
        if (cls == 0) { const P0Args A = P0ARGS; p0_items(C, A, cwave, 128 * NWAVES, P0_AT_UP1, P0_I_UP, P0_AT_DN1, P0_I_DN); } }
#define PH6N { pg8::Gemm g{XN, (const bf16*)(ws + WS_WQKV), M, NQKV, D, (size_t)256 * D * 2}; pg8::StaticOrder S; S.init(M, NQKV, C.G, (int)blockIdx.x); pg8::EpiNull E{}; \
        pg8::gemm_phase<pg8::EpiNull, pg8::StaticOrder, true, true>(C.lds + RING_OFF, g, S, E); }
#define PH6S { pg8::Gemm g{XN, (const bf16*)(ws + WS_WQKV), M, NQKV, D, (size_t)256 * D * 2}; pg8::StaticOrder S; S.init(M, NQKV, C.G, (int)blockIdx.x); pg8::EpiStoreOnly E{(bf16*)big, NQKV}; \
        pg8::gemm_phase<pg8::EpiStoreOnly, pg8::StaticOrder, true, true>(C.lds + RING_OFF, g, S, E); }
#define PH7V(v) { p7_attention<v>(C, (bf16*)big, LSE, (const float*)(ws + WS_LUT)); }
#define PH7 { p7_attention<0>(C, (bf16*)big, LSE, (const float*)(ws + WS_LUT)); }
#define PH8 { p8_merge(C, item_row, (const bf16*)big, LSE, OM); __syncthreads(); gate_arrive(gate8); }
#define PH9 { pg8::Gemm g{OM, (const bf16*)(ws + WS_WOB), M, D, AW, (size_t)256 * AW * 2}; pg8::StaticOrder S; S.init(M, D, C.G, (int)blockIdx.x); pg8::EpiRes E{XN, SSQ, D}; \
        pg8::gemm_phase<pg8::EpiRes, pg8::StaticOrder, true, true>(C.lds + RING_OFF, g, S, E); }
#define PH12 { p12_final(C, item_row, XN, out, SSQ, fing); }
#define DUPAT(k) do { if (DUP_AFTER == (k)) { DUP_BODY } } while (0)
    GSTEP(PH0); DUPAT(0);
    if (lo <= 0 && 1 < hi) {
        const unsigned* xw = (const unsigned*)(ctl + CW_XCC) + k8 * 8 + gx;
        const unsigned a0 = __hip_atomic_load(xw, __ATOMIC_RELAXED, __HIP_MEMORY_SCOPE_AGENT), a1 = __hip_atomic_load(xw + 64, __ATOMIC_RELAXED, __HIP_MEMORY_SCOPE_AGENT),
                       a2 = __hip_atomic_load(xw + 128, __ATOMIC_RELAXED, __HIP_MEMORY_SCOPE_AGENT), a3 = __hip_atomic_load(xw + 192, __ATOMIC_RELAXED, __HIP_MEMORY_SCOPE_AGENT);
        gbr.same = (a0 != 0u && a0 == a1 && a0 == a2 && a0 == a3) ? 1u : 0u; }
    if (lo <= 0 && 1 < hi && cls == 1) { const P0Args A = P0ARGS;
        p0_items(C, A, cwave, 128 * NWAVES, P0_AT_OA, P0_AT_UP1 - P0_AT_OA, P0_AT_DN0, P0_I_DN);
        asm volatile("s_waitcnt vmcnt(0)" ::: "memory"); __syncthreads();
        if (C.tid == 0) { __builtin_amdgcn_fence(__ATOMIC_RELEASE, "agent"); asm volatile("s_waitcnt vmcnt(0)" ::: "memory"); (void)__hip_atomic_fetch_add(s1cnt, 1u, __ATOMIC_RELAXED, __HIP_MEMORY_SCOPE_AGENT); } }
    CSTEP(PH1); DUPAT(1);
    CSTEP(PH2); DUPAT(2);
    CSTEP(PH3); DUPAT(3);
    CSTEP(PHUP(0)); DUPAT(4);
    CSTEP(PHDN(0)); DUPAT(5);
    GSTEP(PH6); DUPAT(6);
    GSTEP(PH7); DUPAT(7);
    CSTEP(PH8); DUPAT(8);
    CSTEP(PH9); DUPAT(9);
    CSTEP(PHUP(1)); DUPAT(10);
    CSTEP(PHFIN);
}

extern "C" void kernel_launch(void* const* d_in, const int* in_sizes, int n_in, void* d_out, int out_size, void* d_ws, size_t ws_size, hipStream_t stream) {
    static int grid = 0;
    if (grid == 0) {
        if (n_in != 15 || in_sizes[0] != M * D || out_size != M * D || ws_size < WS_END) { fprintf(stderr, "kernel_launch: shape/workspace mismatch (n_in %d, in0 %d, out %d, ws %zu); nothing launched\n", n_in, n_in > 0 ? in_sizes[0] : -1, out_size, ws_size); grid = -1; return; }
        int dev = 0, cus = 0, per_cu = 0;
        if (hipGetDevice(&dev) != hipSuccess || hipDeviceGetAttribute(&cus, hipDeviceAttributeMultiprocessorCount, dev) != hipSuccess) { grid = -1; return; }
        if (hipFuncSetAttribute((const void*)trunk_fwd, hipFuncAttributeMaxDynamicSharedMemorySize, LDS_BYTES) != hipSuccess) { fprintf(stderr, "kernel_launch: hipFuncSetAttribute failed\n"); grid = -1; return; }
        if (hipOccupancyMaxActiveBlocksPerMultiprocessor(&per_cu, (const void*)trunk_fwd, NWAVES * 64, LDS_BYTES) != hipSuccess || per_cu < 1)
            fprintf(stderr, "kernel_launch: note: occupancy query reports %d workgroups per CU\n", per_cu);
        (void)hipGetLastError();
        grid = cus;
        if (grid != 256) { fprintf(stderr, "kernel_launch: %d CUs: this kernel's group seams are derived for a 256-workgroup grid; nothing launched\n", grid); grid = -1; return; }
    }
    if (grid < 0) return;
    if (hipMemsetAsync((char*)d_ws + WS_CTL, 0, CTL_ZERO_BYTES, stream) != hipSuccess) return;
    Args a{};
    for (int i = 0; i < 15; ++i) a.in[i] = (const float*)d_in[i];
    a.out = (float*)d_out; a.ws = (unsigned char*)d_ws;
#if MK_SPLIT
    for (int p = 0; p < N_SEQ; ++p) { a.ph_lo = p; a.ph_hi = p + 1; hipLaunchKernelGGL(trunk_fwd, dim3(grid), dim3(NWAVES * 64), LDS_BYTES, stream, a); }
#else
    a.ph_lo = 0; a.ph_hi = N_SEQ;
    hipLaunchKernelGGL(trunk_fwd, dim3(grid), dim3(NWAVES * 64), LDS_BYTES, stream, a);
#endif
    const hipError_t le = hipPeekAtLastError();
    if (le != hipSuccess) fprintf(stderr, "kernel_launch: launch failed: %s\n", hipGetErrorName(le));
}
```

```cpp
#include <hip/hip_runtime.h>
#include <cstdio>
#include <cstdint>
namespace pg8 {
#define PG8_LAS __attribute__((address_space(3)))
typedef unsigned short bf16_t;
typedef short bf16x8 __attribute__((ext_vector_type(8)));
typedef float f32x4 __attribute__((ext_vector_type(4)));
typedef unsigned u32x4 __attribute__((ext_vector_type(4)));
constexpr int BM = 256, BK = 64, HALF = 128, HTB = HALF * BK * 2  , STAGE_BYTES = 8 * HTB, NXCD = 8, WGM = 8;

__host__ __device__ __forceinline__ int lds_byte(int r, int c) { const int st = (r >> 4) * 2 + (c >> 5), rr = r & 15, cc = c & 31, ob = rr * 64 + cc * 2; return st * 1024 + (ob ^ (((ob >> 9) & 1) << 5)); }
__host__ __device__ __forceinline__ void stage_rc(int b, int& R, int& C) { const int st = b / 1024, sb = b % 1024, swz = sb ^ (((sb >> 9) & 1) << 5); R = (st >> 1) * 16 + swz / 64; C = (st & 1) * 32 + (swz % 64) / 2; }
__host__ __device__ __forceinline__ int perm32(int rho) { const int n = rho >> 4, i = rho & 15; return 8 * (i >> 2) + 4 * n + (i & 3); }

struct Unit { int pm, pn; };
struct Gemm { const bf16_t* A; const bf16_t* Bt; int M, N, K; size_t tstepA; };

struct StaticOrder {
    int nM, nN, nwg, G, c, rev, pnrev;
    __host__ __device__ void init(int M, int N, int G_, int c_) { nM = M / BM; nN = N / BM; nwg = nM * nN; G = G_; c = c_; rev = 0; pnrev = 0; }
    __host__ __device__ void columns_descending() { pnrev = 1; }
    __host__ __device__ void reversed() { rev = (nwg + G - 1) / G; }
    __host__ __device__ bool next(int i, Unit& u) const {
        if (rev) { if (i >= rev) return false; i = rev - 1 - i; }
        const long L = (long)i * G + c; if (L >= nwg) return false;
        int wgid = (int)L; { const int q = nwg / NXCD, r = nwg % NXCD, xcd = wgid % NXCD, off = wgid / NXCD; wgid = (xcd < r ? xcd * (q + 1) : r * (q + 1) + (xcd - r) * q) + off; }
        const int nig = WGM * nN, gid = wgid / nig, fm = gid * WGM, gsz = (nM - fm) < WGM ? (nM - fm) : WGM;
        u.pm = fm + ((wgid % nig) % gsz); u.pn = (wgid % nig) / gsz; if (pnrev) u.pn = nN - 1 - u.pn; return true;
    }
    __device__ __forceinline__ void a_ready(const Unit&) const {}
    __device__ __forceinline__ void done(const Unit&) const {}
};

__device__ __forceinline__ unsigned cvt_pk_bf16(float lo, float hi) { unsigned r; asm volatile("v_cvt_pk_bf16_f32 %0, %1, %2" : "=v"(r) : "v"(lo), "v"(hi)); return r; }
typedef float f32x2 __attribute__((ext_vector_type(2)));
__device__ __forceinline__ f32x2 gelu_pk(f32x2 v) {
    f32x2 a; a.x = fminf(__builtin_fabsf(v.x), 5.3f); a.y = fminf(__builtin_fabsf(v.y), 5.3f);
    const f32x2 x = a * 0.377358496f + (-1.0f);
    f32x2 q = x * (-2.680665057e-04f) + (-4.321495537e-03f);
    q = q * x + 7.164665032e-03f; q = q * x + 1.980672404e-02f; q = q * x + (-4.157880694e-02f); q = q * x + (-2.189491689e-02f); q = q * x + 1.078988388e-01f;
    q = q * x + (-5.974620953e-02f); q = q * x + (-1.094131693e-01f); q = q * x + 2.026295662e-01f; q = q * x + (-8.957923949e-02f); q = q * x + (-1.324163824e-01f);
    q = q * x + 2.609098256e-01f; q = q * x + (-2.224893272e-01f); q = q * x + 1.108414084e-01f; q = q * x + (-3.156794980e-02f); q = q * x + 4.024588503e-03f;
    const f32x2 m = v * q, r = v - m;
    f32x2 o; o.x = v.x < 0.f ? m.x : r.x; o.y = v.y < 0.f ? m.y : r.y; return o;
}

struct RsTable {
    const float* ssq; PG8_LAS float* tab; mutable int pm_cached;
    __device__ __forceinline__ void get(const Unit& u, int wr, int fr, float (&rs)[2][4]) const {
        if (u.pm != pm_cached) {
            const int t = threadIdx.x, row = t >> 1, half = t & 1;
            const f32x4 a = *(const f32x4*)(ssq + (size_t)(u.pm * BM + row) * 16 + half * 8), b = *(const f32x4*)(ssq + (size_t)(u.pm * BM + row) * 16 + half * 8 + 4);
            float s = ((a[0] + a[1]) + (a[2] + a[3])) + ((b[0] + b[1]) + (b[2] + b[3]));
            s += __shfl_xor(s, 1);
            if (half == 0) tab[row] = __builtin_amdgcn_rsqf(s * (1.0f / 1024.0f) + 1e-6f);
            asm volatile("s_waitcnt lgkmcnt(0)" ::: "memory"); __builtin_amdgcn_s_barrier(); asm volatile("" ::: "memory");
            pm_cached = u.pm;
        }
#pragma unroll
        for (int ai = 0; ai < 2; ++ai)
#pragma unroll
            for (int m = 0; m < 4; ++m) rs[ai][m] = tab[ai * HALF + wr * 64 + m * 16 + fr];
    }
};
struct GateW { const unsigned* cnt; unsigned target; mutable int passed;
    __device__ __forceinline__ void wait() const { if (cnt && !passed) { unsigned sp = 0u; while (__hip_atomic_load(cnt, __ATOMIC_RELAXED, __HIP_MEMORY_SCOPE_AGENT) < target) { __builtin_amdgcn_s_sleep(2); if (++sp > (1u << 22)) break; } passed = 1; } } };
template <int ACT> struct EpiAct {
    static constexpr bool PERM = true, AFTER_DRAIN = false;
    bf16_t* O; int ldc; size_t pstride; RsTable rt; float* vst; GateW gate;
    __device__ __forceinline__ void operator()(const f32x4 (&acc)[2][2][4][2], const Unit& u, int wr, int wc, int fr, int fq) const {
        const int row0 = u.pm * BM + wr * 64 + fr, col0 = u.pn * BM + wc * 32 + 8 * fq;
        const bool vhalf = (ACT == 1) && (u.pn >= 4);
        float rsv[2][4]; rt.get(u, wr, fr, rsv); gate.wait();
#pragma unroll
        for (int ai = 0; ai < 2; ++ai)
#pragma unroll
            for (int m = 0; m < 4; ++m) {
                const int row = row0 + ai * HALF + m * 16;
                const float rs = rsv[ai][m];
                bf16_t* rowp = O + (size_t)u.pm * pstride + (size_t)(row - u.pm * BM) * ldc + col0;
                float s1 = 0.f, s2 = 0.f;
#pragma unroll
                for (int bj = 0; bj < 2; ++bj) {
                    f32x4 v0 = acc[ai][bj][m][0] * rs, v1 = acc[ai][bj][m][1] * rs;
                    if (ACT == 1) { f32x2 a = gelu_pk((f32x2){v0[0], v0[1]}), b = gelu_pk((f32x2){v0[2], v0[3]}), c = gelu_pk((f32x2){v1[0], v1[1]}), d = gelu_pk((f32x2){v1[2], v1[3]});
                        v0 = (f32x4){a.x, a.y, b.x, b.y}; v1 = (f32x4){c.x, c.y, d.x, d.y};
                        s1 += ((v0[0] + v0[1]) + (v0[2] + v0[3])) + ((v1[0] + v1[1]) + (v1[2] + v1[3]));
                        s2 += ((v0[0] * v0[0] + v0[1] * v0[1]) + (v0[2] * v0[2] + v0[3] * v0[3])) + ((v1[0] * v1[0] + v1[1] * v1[1]) + (v1[2] * v1[2] + v1[3] * v1[3])); }
                    if (ACT == 2) {
#pragma unroll
                        for (int e = 0; e < 4; ++e) { const float a = fmaxf(v0[e], 0.f), b = fmaxf(v1[e], 0.f); v0[e] = a * a; v1[e] = b * b; } }
                    u32x4 w; w.x = cvt_pk_bf16(v0[0], v0[1]); w.y = cvt_pk_bf16(v0[2], v0[3]); w.z = cvt_pk_bf16(v1[0], v1[1]); w.w = cvt_pk_bf16(v1[2], v1[3]);
                    *(u32x4*)(rowp + bj * HALF) = w; }
                if (ACT == 1) { if (vhalf) { s1 += __shfl_xor(s1, 16); s1 += __shfl_xor(s1, 32); s2 += __shfl_xor(s2, 16); s2 += __shfl_xor(s2, 32);
                        if (fq == 0) *(f32x2*)(vst + ((size_t)row * 16 + (u.pn - 4) * 4 + wc) * 2) = (f32x2){s1, s2}; } }
            }
    }
};
struct EpiQKV {
    static constexpr bool PERM = true, AFTER_DRAIN = false;
    bf16_t* O; RsTable rt; int seq, nb; GateW gate;
    __device__ __forceinline__ void operator()(const f32x4 (&acc)[2][2][4][2], const Unit& u, int wr, int wc, int fr, int fq) const {
        const int row0 = u.pm * BM + wr * 64 + fr, col0 = u.pn * BM + wc * 32 + 8 * fq;
        const int g = ((u.pn * BM) / 512) % 3, lg = 2 * g, dm = (1 << lg) - 1;
        float rsv[2][4]; rt.get(u, wr, fr, rsv); gate.wait();
#pragma unroll
        for (int ai = 0; ai < 2; ++ai)
#pragma unroll
            for (int m = 0; m < 4; ++m) {
                const int row = row0 + ai * HALF + m * 16, b = row / seq, pos = row - b * seq;
                const size_t prow = (size_t)b * seq + (size_t)(pos & dm) * (seq >> lg) + (pos >> lg);
                const float rs = rsv[ai][m];
#pragma unroll
                for (int bj = 0; bj < 2; ++bj) { const int col = col0 + bj * HALF, hd = col >> 6;
                    const f32x4 v0 = acc[ai][bj][m][0] * rs, v1 = acc[ai][bj][m][1] * rs;
                    u32x4 w; w.x = cvt_pk_bf16(v0[0], v0[1]); w.y = cvt_pk_bf16(v0[2], v0[3]); w.z = cvt_pk_bf16(v1[0], v1[1]); w.w = cvt_pk_bf16(v1[2], v1[3]);
                    *(u32x4*)(O + ((size_t)hd * nb * seq + prow) * 64 + (col & 63)) = w; } }
    }
};
__device__ __forceinline__ float bf_lo(unsigned w) { return __builtin_bit_cast(float, w << 16); }
__device__ __forceinline__ float bf_hi(unsigned w) { return __builtin_bit_cast(float, w & 0xffff0000u); }
struct EpiRes {
    static constexpr bool PERM = true, AFTER_DRAIN = false;
    bf16_t* hb; float* ssq; int ldc;
    __device__ __forceinline__ void operator()(const f32x4 (&acc)[2][2][4][2], const Unit& u, int wr, int wc, int fr, int fq) const {
        const int row0 = u.pm * BM + wr * 64 + fr, col0 = u.pn * BM + wc * 32 + 8 * fq;
        u32x4 r[2][4][2];
#pragma unroll
        for (int ai = 0; ai < 2; ++ai)
#pragma unroll
            for (int m = 0; m < 4; ++m)
#pragma unroll
                for (int bj = 0; bj < 2; ++bj) r[ai][m][bj] = *(const u32x4*)(hb + (size_t)(row0 + ai * HALF + m * 16) * ldc + col0 + bj * HALF);
        asm volatile("" ::: "memory");
#pragma unroll
        for (int ai = 0; ai < 2; ++ai)
#pragma unroll
            for (int m = 0; m < 4; ++m) {
                const int row = row0 + ai * HALF + m * 16;
                float q = 0.f;
#pragma unroll
                for (int bj = 0; bj < 2; ++bj) { const u32x4 rr = r[ai][m][bj];
                    const f32x4 h0 = (f32x4){bf_lo(rr.x), bf_hi(rr.x), bf_lo(rr.y), bf_hi(rr.y)} + acc[ai][bj][m][0], h1 = (f32x4){bf_lo(rr.z), bf_hi(rr.z), bf_lo(rr.w), bf_hi(rr.w)} + acc[ai][bj][m][1];
                    u32x4 w; w.x = cvt_pk_bf16(h0[0], h0[1]); w.y = cvt_pk_bf16(h0[2], h0[3]); w.z = cvt_pk_bf16(h1[0], h1[1]); w.w = cvt_pk_bf16(h1[2], h1[3]);
                    *(u32x4*)(hb + (size_t)row * ldc + col0 + bj * HALF) = w;
                    q += ((h0[0] * h0[0] + h0[1] * h0[1]) + (h0[2] * h0[2] + h0[3] * h0[3])) + ((h1[0] * h1[0] + h1[1] * h1[1]) + (h1[2] * h1[2] + h1[3] * h1[3])); }
                q += __shfl_xor(q, 16); q += __shfl_xor(q, 32);
                if (fq == 0) ssq[(size_t)row * 16 + u.pn * 4 + wc] = q;
            }
    }
};
struct EpiNull {
    static constexpr bool PERM = true, AFTER_DRAIN = false;
    __device__ __forceinline__ void operator()(const f32x4 (&acc)[2][2][4][2], const Unit& u, int wr, int wc, int fr, int fq) const {
#pragma unroll
        for (int ai = 0; ai < 2; ++ai)
#pragma unroll
            for (int bj = 0; bj < 2; ++bj)
#pragma unroll
                for (int m = 0; m < 4; ++m)
#pragma unroll
                    for (int n = 0; n < 2; ++n) asm volatile("" :: "v"(acc[ai][bj][m][n]));
    }
};
struct EpiStoreOnly {
    static constexpr bool PERM = true, AFTER_DRAIN = false;
    bf16_t* O; int ldc;
    __device__ __forceinline__ void operator()(const f32x4 (&acc)[2][2][4][2], const Unit& u, int wr, int wc, int fr, int fq) const {
        const int row0 = u.pm * BM + wr * 64 + fr, col0 = u.pn * BM + wc * 32 + 8 * fq;
#pragma unroll
        for (int ai = 0; ai < 2; ++ai)
#pragma unroll
            for (int m = 0; m < 4; ++m) {
                bf16_t* rowp = O + (size_t)(row0 + ai * HALF + m * 16) * ldc + col0;
#pragma unroll
                for (int bj = 0; bj < 2; ++bj) { const f32x4 v0 = acc[ai][bj][m][0], v1 = acc[ai][bj][m][1];
                    u32x4 w; w.x = cvt_pk_bf16(v0[0], v0[1]); w.y = cvt_pk_bf16(v0[2], v0[3]); w.z = cvt_pk_bf16(v1[0], v1[1]); w.w = cvt_pk_bf16(v1[2], v1[3]);
                    *(u32x4*)(rowp + bj * HALF) = w; } }
    }
};
template <class Epi, class Sched, bool ALIGN_EPI = false, bool SP2 = false, bool KDESC = false>
__device__ __forceinline__ void gemm_phase(PG8_LAS unsigned char* lds, const Gemm g, const Sched& S, const Epi& E) {
    const int tid = threadIdx.x, wid = __builtin_amdgcn_readfirstlane(tid >> 6), lane = tid & 63, wr = wid >> 2, wc = wid & 3, fr = lane & 15, fq = lane >> 4;
    const int K = g.K, nt = K / BK;
    unsigned voffA[2], voffB[2];
#pragma unroll
    for (int i = 0; i < 2; ++i) { int R, C; stage_rc(tid * 16 + i * 8192, R, C); const int Rb = Epi::PERM ? ((R & ~31) + perm32(R & 31)) : R;
        voffA[i] = (unsigned)(R * K + C) * 2u; voffB[i] = (unsigned)(Rb * K + C) * 2u; }
    const size_t kstep = KDESC ? (size_t)0 - (size_t)(BK * 2) : (size_t)(BK * 2);
    const size_t kfirst = KDESC ? (size_t)(nt - 1) * (size_t)(BK * 2) : (size_t)0;
    const size_t hstep = (size_t)HALF * K * 2;
    const size_t tstep = 2 * hstep;
    const unsigned ldsw = (unsigned)wid * 1024u;
    const int aoff = lds_byte(wr * 64 + fr, fq * 8), boff = lds_byte(wc * 32 + fr, fq * 8);
#define PG8_SA(b, h) (((b) * 2 + (h)) * HTB)
#define PG8_SB(b, h) ((4 + (b) * 2 + (h)) * HTB)
#define PG8_STAGE(bufoff, gbase, voff) do { _Pragma("unroll") for (int _i = 0; _i < 2; ++_i) \
        __builtin_amdgcn_global_load_lds((const unsigned*)((const char*)(gbase) + (voff)[_i]), (PG8_LAS unsigned*)(lds + (bufoff) + ldsw + _i * 8192), 16, 0, 0); } while (0)
#define PG8_LDA(dst, b, h) do { _Pragma("unroll") for (int m = 0; m < 4; ++m) _Pragma("unroll") for (int k = 0; k < 2; ++k) dst[m][k] = *(const PG8_LAS bf16x8*)(lds + PG8_SA(b, h) + aoff + m * 2048 + k * 1024); } while (0)
#define PG8_LDB(dst, b, h) do { _Pragma("unroll") for (int n = 0; n < 2; ++n) _Pragma("unroll") for (int k = 0; k < 2; ++k) dst[n][k] = *(const PG8_LAS bf16x8*)(lds + PG8_SB(b, h) + boff + n * 2048 + k * 1024); } while (0)
#define PG8_MMA(ai, bj, At, Bt) do { __builtin_amdgcn_s_setprio(1); _Pragma("unroll") for (int m = 0; m < 4; ++m) _Pragma("unroll") for (int n = 0; n < 2; ++n) _Pragma("unroll") for (int k = 0; k < 2; ++k) \
        acc[ai][bj][m][n] = __builtin_amdgcn_mfma_f32_16x16x32_bf16(Bt[n][k], At[m][k], acc[ai][bj][m][n], 0, 0, 0); __builtin_amdgcn_s_setprio(0); } while (0)
#define PG8_WAIT_V(n) asm volatile("s_waitcnt vmcnt(" #n ")" ::: "memory")
#define PG8_WAIT_L(n) asm volatile("s_waitcnt lgkmcnt(" #n ")" ::: "memory")
#define PG8_BAR __builtin_amdgcn_s_barrier()
#define PG8_SCHED __builtin_amdgcn_sched_barrier(0)
    Unit cur, nxt; int ui = 0;
    if (!S.next(0, cur)) return;
    f32x4 acc[2][2][4][2];
#pragma unroll
    for (int a = 0; a < 2; ++a)
#pragma unroll
        for (int b = 0; b < 2; ++b)
#pragma unroll
            for (int m = 0; m < 4; ++m)
#pragma unroll
                for (int n = 0; n < 2; ++n) acc[a][b][m][n] = (f32x4){0.f, 0.f, 0.f, 0.f};
    bf16x8 At[4][2], B0[2][2], B1[2][2];
    const char* cA = (const char*)g.A + (size_t)cur.pm * g.tstepA + kfirst; const char* cB = (const char*)g.Bt + (size_t)cur.pn * tstep + kfirst;
    S.a_ready(cur);
    if constexpr (SP2) {
        PG8_STAGE(PG8_SB(0, 0), cB, voffB); PG8_STAGE(PG8_SB(0, 1), cB + hstep, voffB); PG8_STAGE(PG8_SA(0, 0), cA, voffA); PG8_STAGE(PG8_SA(0, 1), cA + hstep, voffA);
        if (wr == 1) PG8_BAR;
        PG8_WAIT_V(2); PG8_BAR;
        PG8_STAGE(PG8_SB(1, 0), cB + kstep, voffB); PG8_STAGE(PG8_SB(1, 1), cB + hstep + kstep, voffB);
        PG8_WAIT_V(4); PG8_BAR;
    } else {
        PG8_STAGE(PG8_SB(0, 0), cB, voffB); PG8_STAGE(PG8_SA(0, 0), cA, voffA); PG8_STAGE(PG8_SB(0, 1), cB + hstep, voffB); PG8_STAGE(PG8_SA(0, 1), cA + hstep, voffA);
        if (wr == 1) PG8_BAR;
        PG8_WAIT_V(4); PG8_BAR;
        PG8_STAGE(PG8_SB(1, 0), cB + kstep, voffB); PG8_STAGE(PG8_SA(1, 0), cA + kstep, voffA); PG8_STAGE(PG8_SB(1, 1), cB + hstep + kstep, voffB);
        PG8_WAIT_V(6); PG8_BAR;
    }
    for (;;) {
        const bool has_next = S.next(ui + 1, nxt);
        const char* nA = has_next ? (const char*)g.A + (size_t)nxt.pm * g.tstepA + kfirst : cA; const char* nB = has_next ? (const char*)g.Bt + (size_t)nxt.pn * tstep + kfirst : cB;
        for (int t = 0; t < nt; t += 2) {
            const bool last = (t == nt - 2);
            const char* a1 = cA + (size_t)(t + 1) * kstep;
            const char* a2 = last ? nA : cA + (size_t)(t + 2) * kstep; const char* b2 = last ? nB : cB + (size_t)(t + 2) * kstep;
            const char* a3 = a2 + kstep; const char* b3 = b2 + kstep;
            if (last && has_next) S.a_ready(nxt);
            if constexpr (SP2) {
            PG8_STAGE(PG8_SA(1, 0), a1, voffA); PG8_SCHED; PG8_LDB(B0, 0, 0); PG8_LDB(B1, 0, 1); PG8_SCHED; PG8_LDA(At, 0, 0); PG8_STAGE(PG8_SA(1, 1), a1 + hstep, voffA);
            PG8_WAIT_V(8); PG8_WAIT_L(0); PG8_BAR; PG8_MMA(0, 0, At, B0); PG8_MMA(0, 1, At, B1); PG8_BAR; PG8_SCHED;
            PG8_LDA(At, 0, 1); PG8_STAGE(PG8_SB(0, 0), b2, voffB); PG8_STAGE(PG8_SB(0, 1), b2 + hstep, voffB);
            PG8_WAIT_V(6); PG8_WAIT_L(0); PG8_BAR; PG8_MMA(1, 0, At, B0); PG8_MMA(1, 1, At, B1); PG8_BAR; PG8_SCHED;
            PG8_STAGE(PG8_SA(0, 0), a2, voffA); PG8_SCHED; PG8_LDB(B0, 1, 0); PG8_LDB(B1, 1, 1); PG8_SCHED; PG8_LDA(At, 1, 0); PG8_STAGE(PG8_SA(0, 1), a2 + hstep, voffA);
            PG8_WAIT_V(8); PG8_WAIT_L(0); PG8_BAR; PG8_MMA(0, 0, At, B0); PG8_MMA(0, 1, At, B1); PG8_BAR; PG8_SCHED;
            PG8_LDA(At, 1, 1); PG8_STAGE(PG8_SB(1, 0), b3, voffB); PG8_STAGE(PG8_SB(1, 1), b3 + hstep, voffB);
            PG8_WAIT_V(6); PG8_WAIT_L(0); PG8_BAR; PG8_MMA(1, 0, At, B0); PG8_MMA(1, 1, At, B1); PG8_BAR; PG8_SCHED;
            } else {
            PG8_LDB(B0, 0, 0); PG8_SCHED; PG8_LDA(At, 0, 0); PG8_STAGE(PG8_SA(1, 1), a1 + hstep, voffA);
            PG8_WAIT_L(8); PG8_BAR; PG8_WAIT_L(0); PG8_MMA(0, 0, At, B0); PG8_BAR; PG8_SCHED;
            PG8_LDB(B1, 0, 1); PG8_STAGE(PG8_SB(0, 0), b2, voffB);
            PG8_BAR; PG8_WAIT_L(0); PG8_MMA(0, 1, At, B1); PG8_BAR;
            PG8_LDA(At, 0, 1); PG8_STAGE(PG8_SA(0, 0), a2, voffA);
            PG8_BAR; PG8_WAIT_L(0); PG8_MMA(1, 0, At, B0); PG8_BAR; PG8_SCHED;
            PG8_STAGE(PG8_SB(0, 1), b2 + hstep, voffB);
            PG8_WAIT_V(6); PG8_BAR; PG8_MMA(1, 1, At, B1); PG8_BAR;
            PG8_LDB(B0, 1, 0); PG8_SCHED; PG8_LDA(At, 1, 0); PG8_STAGE(PG8_SA(0, 1), a2 + hstep, voffA);
            PG8_WAIT_L(8); PG8_BAR; PG8_WAIT_L(0); PG8_MMA(0, 0, At, B0); PG8_BAR; PG8_SCHED;
            PG8_LDB(B1, 1, 1); PG8_STAGE(PG8_SB(1, 0), b3, voffB);
            PG8_BAR; PG8_WAIT_L(0); PG8_MMA(0, 1, At, B1); PG8_BAR;
            PG8_LDA(At, 1, 1); PG8_STAGE(PG8_SA(1, 0), a3, voffA);
            PG8_BAR; PG8_WAIT_L(0); PG8_MMA(1, 0, At, B0); PG8_BAR; PG8_SCHED;
            PG8_STAGE(PG8_SB(1, 1), b3 + hstep, voffB);
            PG8_WAIT_V(6); PG8_BAR; PG8_MMA(1, 1, At, B1); PG8_BAR;
            }
        }
        if constexpr (ALIGN_EPI) { if (wr == 0) PG8_BAR; }
        if constexpr (!Epi::AFTER_DRAIN) { E(acc, cur, wr, wc, fr, fq); S.done(cur); }
        if (!has_next) break;
#pragma unroll
        for (int a = 0; a < 2; ++a)
#pragma unroll
            for (int b = 0; b < 2; ++b)
#pragma unroll
                for (int m = 0; m < 4; ++m)
#pragma unroll
                    for (int n = 0; n < 2; ++n) acc[a][b][m][n] = (f32x4){0.f, 0.f, 0.f, 0.f};
        cur = nxt; cA = nA; cB = nB; ++ui;
        if constexpr (ALIGN_EPI) { if (wr == 1) PG8_BAR; }
    }
    PG8_WAIT_V(0);
    if constexpr (!ALIGN_EPI) { if (wr == 0) PG8_BAR; }
    PG8_BAR;
    if constexpr (Epi::AFTER_DRAIN) { E.fused(acc, cur, wr, wc, fr, fq, lds, wid, lane); S.done(cur); }
#undef PG8_SA
#undef PG8_SB
#undef PG8_STAGE
#undef PG8_LDA
#undef PG8_LDB
#undef PG8_MMA
#undef PG8_WAIT_V
#undef PG8_WAIT_L
#undef PG8_BAR
#undef PG8_SCHED
}
}
constexpr int NWAVES = 8;
constexpr int BATCH = 4, SEQ = 8192, D = 1024, FF = 4096, NQKV = 4608, AW = 512, NH = 8, HD = 64;
constexpr int M = BATCH * SEQ;
constexpr int CHUNK = 128, NCHUNK = M / CHUNK, NGRP = 8;
constexpr float EPS = 1e-6f;
constexpr float LOG2E = 1.4426950408889634f;
constexpr int LUT_N = 176;
#ifndef MK_SPLIT
#define MK_SPLIT 0
#endif
constexpr int N_PHASES = 12;
#define DUP_AFTER (-1)
#define DUP_N 0
#define DUP_BODY
#define BAR_REPS 1
constexpr int N_SEQ = N_PHASES + DUP_N;

constexpr size_t MiB = 1u << 20;
constexpr size_t WS_CTL = 0, CTL_ZERO_BYTES = 128 * 1024;
constexpr size_t WS_WIN = 2 * MiB, WS_WOA = 6 * MiB, WS_WQKV = 8 * MiB, WS_WOB = 17 * MiB, WS_WUP = 18 * MiB, WS_WDN = 34 * MiB;
constexpr size_t WS_WST = 50 * MiB;
constexpr size_t WS_LUT = 50 * MiB + 512 * 1024;
constexpr size_t WS_SSQ = 51 * MiB;
constexpr size_t WS_VST = 53 * MiB;
constexpr size_t WS_LSE = 57 * MiB;
constexpr size_t WS_XN = 64 * MiB;
constexpr size_t WS_BIG = 128 * MiB;
constexpr size_t BLK = 2304 * 1024;
constexpr size_t BLK_UG = 1 * MiB, QSLICE = 256 * 64;
constexpr size_t WS_OM = 416 * MiB;
constexpr size_t WS_END = 448 * MiB;
constexpr int CW_TMO = 0, CW_CODE = 1, CW_BAR = 4096, CW_GRP = 8192, CW_XCC = 16384, CW_GATE = 20480;
static_assert((size_t)(CW_GATE + 256) * 4 <= CTL_ZERO_BYTES, "control words inside the per-call memset");

constexpr int RING_OFF = 0, RING_BYTES = 131072;
constexpr int LDSCTL_OFF = 159744  , MISC_OFF = LDSCTL_OFF + 320, RSTAB_OFF = LDSCTL_OFF + 1024;
constexpr int LDS_BYTES = 163840;

#define GAS __attribute__((address_space(1)))
#define LAS __attribute__((address_space(3)))
typedef unsigned short bf16;
typedef unsigned v4u __attribute__((ext_vector_type(4)));
typedef float f32x4 __attribute__((ext_vector_type(4)));
typedef short bf16x8 __attribute__((ext_vector_type(8)));
typedef GAS unsigned gu32;
typedef GAS unsigned long long gu64;
#define RLX_AGENT __ATOMIC_RELAXED, __HIP_MEMORY_SCOPE_AGENT
#define LDS_WAIT() asm volatile("s_waitcnt lgkmcnt(0)" ::: "memory")
#define VM_WAIT() asm volatile("s_waitcnt vmcnt(0)" ::: "memory")
__device__ __forceinline__ unsigned long long rt() { return __builtin_amdgcn_s_memrealtime(); }
__device__ __forceinline__ unsigned f2bf(float f) { unsigned u = __builtin_bit_cast(unsigned, f); return (u + 0x7fffu + ((u >> 16) & 1u)) >> 16; }
__device__ __forceinline__ unsigned pk2(float lo, float hi) { return f2bf(lo) | (f2bf(hi) << 16); }

#define XB_TMO      128
#define XB_XCNT(j)  (256  + 64 * (j))
#define XB_XSUB(j)  (1280 + 64 * (j))
#define XB_XGEN(j)  (2304 + 64 * (j))
#define XB_TOP      3328
#define XB_TOPGEN   3392
#define XCD_BAR_WORDS 3456
#define XB_SPIN_CAP (1u << 18)

__device__ __forceinline__ unsigned xb_ld(unsigned* p)              { return __hip_atomic_load(p, __ATOMIC_RELAXED, __HIP_MEMORY_SCOPE_AGENT); }
__device__ __forceinline__ unsigned xb_add(unsigned* p, unsigned v) { return __hip_atomic_fetch_add(p, v, __ATOMIC_RELAXED, __HIP_MEMORY_SCOPE_AGENT); }
__device__ __forceinline__ unsigned xb_xcc_id() { return (unsigned)__builtin_amdgcn_s_getreg((3 << 11) | 20) & 0xFu; }
#define XB_SPIN(cond, bar) do { unsigned _sp = 0; while (cond) { __builtin_amdgcn_s_sleep(1); \
    if ((++_sp & 255u) == 0u) { if (xb_ld(&(bar)[XB_TMO])) break; if (_sp > XB_SPIN_CAP) { atomicAdd(&(bar)[XB_TMO], 1u); break; } } } } while (0)

struct XcdBarrier {
    unsigned* bar; unsigned x;
    volatile LAS unsigned* st;
};

__device__ __forceinline__ XcdBarrier xcd_barrier_post(unsigned* bar, volatile LAS unsigned* st) {
    XcdBarrier b; b.bar = bar; b.x = xb_xcc_id(); b.st = st;
    if (threadIdx.x == 0) (void)xb_add(&bar[XB_XCNT(b.x)], 1u);
    return b;
}
__device__ __forceinline__ void xcd_barrier_complete(unsigned* bar, unsigned x, unsigned& nloc, unsigned& nx) {
    const unsigned G = gridDim.x * gridDim.y * gridDim.z;
    unsigned sum, cnt, mine, sp = 0u;
    for (;;) {
        sum = 0u; cnt = 0u; mine = 0u;
#pragma unroll
        for (unsigned j = 0; j < 16; ++j) { const unsigned c = xb_ld(&bar[XB_XCNT(j)]); sum += c; cnt += (c > 0u) ? 1u : 0u; mine = (j == x) ? c : mine; }
        if (sum == G) break;
        __builtin_amdgcn_s_sleep(1);
        if ((++sp & 255u) == 0u) { if (xb_ld(&bar[XB_TMO])) break; if (sp > XB_SPIN_CAP) { atomicAdd(&bar[XB_TMO], 1u); break; } }
    }
    nloc = mine > 0u ? mine : 1u; nx = cnt > 0u ? cnt : 1u;
}

__device__ __forceinline__ void xcd_barrier(const XcdBarrier& b) {
    asm volatile("s_waitcnt vmcnt(0)" ::: "memory");
    __syncthreads();
    if (threadIdx.x == 0) {
        unsigned* bar = b.bar;
        __builtin_amdgcn_s_waitcnt(0);
        unsigned nloc = b.st[0], nx = b.st[1];
        if (nloc == 0u) { xcd_barrier_complete(bar, b.x, nloc, nx); b.st[0] = nloc; b.st[1] = nx; }
        const unsigned old = xb_add(&bar[XB_XSUB(b.x)], 1u);
        const unsigned gen = old / nloc;
        if (old + 1u == (gen + 1u) * nloc) {
            __builtin_amdgcn_fence(__ATOMIC_RELEASE, "agent");
            asm volatile("s_waitcnt vmcnt(0)" ::: "memory");
            const unsigned og = xb_add(&bar[XB_TOP], 1u);
            const unsigned tg = og / nx;
            if (og + 1u == (tg + 1u) * nx) xb_add(&bar[XB_TOPGEN], 1u);
            else XB_SPIN(xb_ld(&bar[XB_TOPGEN]) == tg, bar);
            __builtin_amdgcn_fence(__ATOMIC_ACQUIRE, "agent");
            xb_add(&bar[XB_XGEN(b.x)], 1u);
            asm volatile("s_waitcnt vmcnt(0)" ::: "memory");
        } else {
            XB_SPIN(xb_ld(&bar[XB_XGEN(b.x)]) == gen, bar);
            __builtin_amdgcn_fence(__ATOMIC_ACQUIRE, "agent");
            asm volatile("s_waitcnt vmcnt(0)" ::: "memory");
        }
    }
    __syncthreads();
}
typedef float f32x2v __attribute__((ext_vector_type(2)));
typedef pg8::u32x4 u32x4;
typedef unsigned u32x2v __attribute__((ext_vector_type(2)));
typedef unsigned short bf16x8us __attribute__((ext_vector_type(8)));
__device__ __forceinline__ unsigned cvtpk(float lo, float hi) { unsigned r; asm volatile("v_cvt_pk_bf16_f32 %0, %1, %2" : "=v"(r) : "v"(lo), "v"(hi)); return r; }
__device__ __forceinline__ float bf2f(unsigned short b) { return __builtin_bit_cast(float, (unsigned)b << 16); }
__device__ __forceinline__ float bflo(unsigned w) { return __builtin_bit_cast(float, w << 16); }
__device__ __forceinline__ float bfhi(unsigned w) { return __builtin_bit_cast(float, w & 0xffff0000u); }
__device__ __forceinline__ float wave_sum(float v) {
#pragma unroll
    for (int o = 1; o < 64; o <<= 1) v += __shfl_xor(v, o);
    return v;
}
struct Ctx { LAS unsigned char* lds; int tid, lane, wave, vcu, G; };

struct P0Item { const float* W; const float* gsc; bf16* WT; int K, N, item; };
__device__ __forceinline__ void p0_item_load(const P0Item& I, int lane, f32x4 (&v)[8]) {
    const int nblk = I.N / 32, kb = I.item / nblk, nb = I.item % nblk, k0 = 64 * kb, n0 = 32 * nb, kr = lane >> 3, c4 = (lane & 7) * 4;
#pragma unroll
    for (int i = 0; i < 8; ++i) v[i] = __builtin_nontemporal_load((const f32x4*)(I.W + (size_t)(k0 + 8 * i + kr) * I.N + n0 + c4));
}
__device__ __forceinline__ void p0_item_store(const P0Item& I, int lane, f32x4 (&v)[8], LAS float* scr) {
    const int nblk = I.N / 32, kb = I.item / nblk, nb = I.item % nblk, k0 = 64 * kb, n0 = 32 * nb, kr = lane >> 3, c4 = (lane & 7) * 4;
    if (I.gsc) {
#pragma unroll
        for (int i = 0; i < 8; ++i) v[i] = v[i] * I.gsc[k0 + 8 * i + kr]; }
#pragma unroll
    for (int i = 0; i < 8; ++i) { LAS float* d = scr + (8 * i + kr) * 33 + c4; d[0] = v[i][0]; d[1] = v[i][1]; d[2] = v[i][2]; d[3] = v[i][3]; }
    LDS_WAIT(); asm volatile("" ::: "memory");
    const int c = lane & 7;
#pragma unroll
    for (int j = 0; j < 4; ++j) { const int n = (lane >> 3) + 8 * j; const LAS float* s = scr + (8 * c) * 33 + n;
        v4u o; o.x = cvtpk(s[0 * 33], s[1 * 33]); o.y = cvtpk(s[2 * 33], s[3 * 33]); o.z = cvtpk(s[4 * 33], s[5 * 33]); o.w = cvtpk(s[6 * 33], s[7 * 33]);
        *(v4u*)(I.WT + (size_t)(n0 + n) * I.K + k0 + 8 * c) = o; }
    LDS_WAIT(); asm volatile("" ::: "memory");
}
struct P0Args { const float *x, *mixg, *mlpg, *w_in, *w_s, *w_outa, *w_qkv, *w_outb, *relb, *w_up, *w_dn; unsigned char* ws; };
__device__ __forceinline__ P0Item p0_item(const P0Args& A, int it) {
    constexpr int I0 = (D / 64) * (2 * D / 32), I1 = (D / 64) * (D / 32), I2 = (D / 64) * (NQKV / 32), I3 = (AW / 64) * (D / 32), I4 = (D / 64) * (FF / 32), I6 = (FF / 64) * (D / 32);
    unsigned char* ws = A.ws; int r = it;
    if (r < I0) return P0Item{A.w_in, A.mixg, (bf16*)(ws + WS_WIN), D, 2 * D, r}; r -= I0;
    if (r < I1) return P0Item{A.w_outa, nullptr, (bf16*)(ws + WS_WOA), D, D, r}; r -= I1;
    if (r < I2) return P0Item{A.w_qkv, A.mixg + D, (bf16*)(ws + WS_WQKV), D, NQKV, r}; r -= I2;
    if (r < I3) return P0Item{A.w_outb, nullptr, (bf16*)(ws + WS_WOB), AW, D, r}; r -= I3;
    if (r < I4) return P0Item{A.w_up, A.mlpg, (bf16*)(ws + WS_WUP), D, FF, r}; r -= I4;
    if (r < I4) return P0Item{A.w_up + (size_t)D * FF, A.mlpg + D, (bf16*)(ws + WS_WUP + 8 * MiB), D, FF, r}; r -= I4;
    if (r < I6) return P0Item{A.w_dn, nullptr, (bf16*)(ws + WS_WDN), FF, D, r}; r -= I6;
    return P0Item{A.w_dn + (size_t)FF * D, nullptr, (bf16*)(ws + WS_WDN + 8 * MiB), FF, D, r};
}
constexpr int P0_I_IN = (D / 64) * (2 * D / 32), P0_I_OA = (D / 64) * (D / 32), P0_I_QKV = (D / 64) * (NQKV / 32), P0_I_OB = (AW / 64) * (D / 32), P0_I_UP = (D / 64) * (FF / 32), P0_I_DN = (FF / 64) * (D / 32);
constexpr int P0_AT_OA = P0_I_IN, P0_AT_UP0 = P0_AT_OA + P0_I_OA + P0_I_QKV + P0_I_OB, P0_AT_UP1 = P0_AT_UP0 + P0_I_UP, P0_AT_DN0 = P0_AT_UP1 + P0_I_UP, P0_AT_DN1 = P0_AT_DN0 + P0_I_DN;
__device__ __forceinline__ void p0_items(const Ctx& C, const P0Args& A, int widx, int wcnt, int a0, int n0, int a1, int n1) {
    LAS float* scr = (LAS float*)(C.lds + RING_OFF + C.wave * 16384);
    const int n = n0 + n1;
#define P0_MAP(j_) ((j_) < n0 ? a0 + (j_) : a1 + ((j_) - n0))
    if (widx < n) {
        f32x4 va[8], vb[8]; P0Item ia = p0_item(A, P0_MAP(widx)); p0_item_load(ia, C.lane, va);
        for (int it = widx; it < n; it += 2 * wcnt) {
            const bool hb = it + wcnt < n; P0Item ib = ia; if (hb) { ib = p0_item(A, P0_MAP(it + wcnt)); p0_item_load(ib, C.lane, vb); }
            p0_item_store(ia, C.lane, va, scr);
            const bool ha = it + 2 * wcnt < n; if (ha) { ia = p0_item(A, P0_MAP(it + 2 * wcnt)); p0_item_load(ia, C.lane, va); }
            if (hb) p0_item_store(ib, C.lane, vb, scr);
        }
    }
#undef P0_MAP
}
__device__ __forceinline__ void p0_prologue(const Ctx& C, const P0Args& A) {
    const int gw = C.vcu * NWAVES + C.wave, NGW = C.G * NWAVES;
    unsigned char* ws = A.ws;
    p0_items(C, A, gw, NGW, 0, P0_I_IN, 0, 0);
    const int gt = (C.vcu * NWAVES + C.wave) * 64 + C.lane, NGT = NGW * 64;
    { bf16* wst = (bf16*)(ws + WS_WST);
      for (int i = gt; i < NGRP * CHUNK * CHUNK; i += NGT) { const int t = (i >> 7) & 127, s = i & 127; const float w = (s <= t) ? A.w_s[i] : 0.f; wst[i] = (bf16)(cvtpk(w, 0.f) & 0xffffu); } }
    { float* lut = (float*)(ws + WS_LUT);
      for (int i = gt; i < 24 * LUT_N; i += NGT) { const int gh = i / LUT_N, idx = i % LUT_N, g = gh >> 3, rel = idx - 16; float v = 0.f;
          if (rel >= 0 && rel <= 128) { const int dil = (g == 0) ? 1 : (g == 1) ? 4 : 16; const int dist = rel * dil; int bucket;
              if (dist < 16) bucket = dist; else { const float nf = (float)dist; int lg = 16 + (int)(logf(nf / 16.0f) / 4.852030263919617f * 16.0f); bucket = lg < 31 ? lg : 31; }
              v = A.relb[bucket * 24 + gh] * LOG2E; }
          lut[i] = v; } }
    { bf16* xn = (bf16*)(ws + WS_XN); float* ssq = (float*)(ws + WS_SSQ);
      f32x4 v0[4], v1[4];
      if (gw < M) {
#pragma unroll
          for (int j = 0; j < 4; ++j) v0[j] = __builtin_nontemporal_load(((const f32x4*)(A.x + (size_t)gw * D) + C.lane) + 64 * j); }
#define P0_ROW(m_, v_) do { float s_ = 0.f; _Pragma("unroll") for (int j = 0; j < 4; ++j) s_ += (v_[j][0] * v_[j][0] + v_[j][1] * v_[j][1]) + (v_[j][2] * v_[j][2] + v_[j][3] * v_[j][3]); \
            \
          unsigned px_[4], py_[4]; _Pragma("unroll") for (int j = 0; j < 4; ++j) { px_[j] = cvtpk(v_[j][0], v_[j][1]); py_[j] = cvtpk(v_[j][2], v_[j][3]); } \
          asm volatile("s_nop 1" : "+v"(px_[0]), "+v"(py_[0]), "+v"(px_[1]), "+v"(py_[1]), "+v"(px_[2]), "+v"(py_[2]), "+v"(px_[3]), "+v"(py_[3])); \
          _Pragma("unroll") for (int jp = 0; jp < 4; jp += 2) { const bool odd_ = C.lane & 1; \
              const unsigned ax_ = (unsigned)__builtin_amdgcn_mov_dpp((int)px_[jp], 0xB1, 0xF, 0xF, true), ay_ = (unsigned)__builtin_amdgcn_mov_dpp((int)py_[jp], 0xB1, 0xF, 0xF, true), \
                             bx_ = (unsigned)__builtin_amdgcn_mov_dpp((int)px_[jp + 1], 0xB1, 0xF, 0xF, true), by_ = (unsigned)__builtin_amdgcn_mov_dpp((int)py_[jp + 1], 0xB1, 0xF, 0xF, true); \
              const v4u val_ = odd_ ? (v4u){bx_, by_, px_[jp + 1], py_[jp + 1]} : (v4u){px_[jp], py_[jp], ax_, ay_}; \
              ((v4u*)(xn + (size_t)(m_) * D))[32 * (jp + (odd_ ? 1 : 0)) + (C.lane >> 1)] = val_; } \
          s_ = wave_sum(s_); if (C.lane < 16) ssq[(size_t)(m_) * 16 + C.lane] = (C.lane == 0) ? s_ : 0.f; } while (0)
      for (int m = gw; m < M; m += 2 * NGW) {
          const bool hb = m + NGW < M;
          if (hb) {
#pragma unroll
              for (int j = 0; j < 4; ++j) v1[j] = __builtin_nontemporal_load(((const f32x4*)(A.x + (size_t)(m + NGW) * D) + C.lane) + 64 * j); }
          P0_ROW(m, v0);
          if (m + 2 * NGW < M) {
#pragma unroll
              for (int j = 0; j < 4; ++j) v0[j] = __builtin_nontemporal_load(((const f32x4*)(A.x + (size_t)(m + 2 * NGW) * D) + C.lane) + 64 * j); }
          if (hb) P0_ROW(m + NGW, v1);
      }
#undef P0_ROW
    }
}

constexpr int G_VT = 0, G_WS = 32768, G_BS = G_WS + 128 * 136 * 2, G_BUF = G_BS + 512, G_STAT = 2 * G_BUF, G_LN = G_STAT + 1024;
static_assert(G_LN + 12288 <= LDSCTL_OFF, "gating LDS map");
__device__ __forceinline__ int vt_off(int c, int s) { return c * 128 + ((((s >> 3) ^ (c & 7) ^ ((c >> 3) & 15)) & 15) << 3) + (s & 7); }
__device__ __forceinline__ void p2_gating(const Ctx& C, int chunk0, unsigned char* big, const float* vst, const bf16* wst, const float* lng, const float* lnb, const float* bs) {
    LAS f32x2v* STAT = (LAS f32x2v*)(C.lds + G_STAT); LAS float* LNP = (LAS float*)(C.lds + G_LN);
    const int tid = C.tid, lane = C.lane, w = C.wave, r16 = lane & 15, qq = lane >> 4;
    const int cc = tid & 15;
    for (int chunk = chunk0; chunk < chunk0 + 1; ++chunk) {
        const size_t tok0 = (size_t)chunk * CHUNK;
        const bf16* UVc = (const bf16*)(big + (size_t)(chunk >> 1) * BLK) + (size_t)(chunk & 1) * CHUNK * (2 * D);
        bf16* UGc = (bf16*)(big + (size_t)(chunk >> 1) * BLK + BLK_UG) + (size_t)(chunk & 1) * CHUNK * D;
        __syncthreads();
        { const int row = tid >> 2, part = tid & 3; const f32x4* pp = (const f32x4*)(vst + ((tok0 + row) * 16 + part * 4) * 2);
          const f32x4 a = pp[0], b = pp[1]; float s1 = (a[0] + a[2]) + (b[0] + b[2]), s2 = (a[1] + a[3]) + (b[1] + b[3]);
          s1 += __shfl_xor(s1, 1); s1 += __shfl_xor(s1, 2); s2 += __shfl_xor(s2, 1); s2 += __shfl_xor(s2, 2);
          const float mean = s1 * (1.0f / 1024.0f), var = s2 * (1.0f / 1024.0f) - mean * mean;
          if (part == 0) STAT[row] = (f32x2v){mean, __builtin_amdgcn_rsqf(fmaxf(var, 0.f) + EPS)}; }
        { *(LAS f32x2v*)(LNP + tid * 2) = *(const f32x2v*)(lng + tid * 2); *(LAS f32x2v*)(LNP + 1024 + tid * 2) = *(const f32x2v*)(lnb + tid * 2); *(LAS f32x2v*)(LNP + 2048 + tid * 2) = *(const f32x2v*)(bs + tid * 2); }
        v4u vraw[2][4], wraw[4]; u32x4 uu[2][4];
#define P2_LOADW(g) do { _Pragma("unroll") for (int i = 0; i < 4; ++i) { const int id_ = tid + 512 * i; wraw[i] = *(const v4u*)(wst + (size_t)(g) * 16384 + (id_ >> 4) * 128 + (id_ & 15) * 8); } } while (0)
#define P2_LOADV(g, set) do { _Pragma("unroll") for (int i = 0; i < 4; ++i) vraw[set][i] = __builtin_nontemporal_load((const v4u*)(UVc + (size_t)((tid >> 4) + 32 * i) * (2 * D) + D + (g) * 128 + cc * 8)); } while (0)
#define P2_LOADU(g, set) do { _Pragma("unroll") for (int pp = 0; pp < 4; ++pp) uu[set][pp] = __builtin_nontemporal_load((const u32x4*)(UVc + (size_t)(32 * pp + 16 * (qq & 1) + r16) * (2 * D) + (g) * 128 + 16 * w + 8 * (qq >> 1))); } while (0)
#define P2_WRITE(g, buf, set) do { LAS bf16* VT_ = (LAS bf16*)(C.lds + (buf) * G_BUF + G_VT); LAS bf16* WS_ = (LAS bf16*)(C.lds + (buf) * G_BUF + G_WS); \
        const LAS f32x4* lp_ = (const LAS f32x4*)(LNP + (g) * 128 + cc * 8); const f32x4 g0 = lp_[0], g1 = lp_[1], b0 = lp_[256], b1 = lp_[257]; \
        _Pragma("unroll") for (int i = 0; i < 4; ++i) { const int s = (tid >> 4) + 32 * i; const f32x2v st = STAT[s]; const v4u raw = vraw[set][i]; \
            const float v[8] = {bflo(raw.x), bfhi(raw.x), bflo(raw.y), bfhi(raw.y), bflo(raw.z), bfhi(raw.z), bflo(raw.w), bfhi(raw.w)}; \
            _Pragma("unroll") for (int j = 0; j < 8; ++j) { const float gg = j < 4 ? g0[j & 3] : g1[j & 3], bb = j < 4 ? b0[j & 3] : b1[j & 3]; \
                const float y = (v[j] - st.x) * st.y * gg + bb; VT_[vt_off(cc * 8 + j, s)] = (bf16)(cvtpk(y, 0.f) & 0xffffu); } \
            const int id_ = tid + 512 * i; *(LAS v4u*)(WS_ + (id_ >> 4) * 136 + (id_ & 15) * 8) = wraw[i]; } } while (0)
        P2_LOADW(0); P2_LOADV(0, 0); P2_LOADV(1, 1); P2_LOADU(0, 0);
        __syncthreads();
        P2_WRITE(0, 0, 0);
        P2_LOADW(1); P2_LOADV(2, 0); P2_LOADU(1, 1);
        __syncthreads();
#define P2_BODY(g, PAR) do { \
            const LAS bf16* VT = (const LAS bf16*)(C.lds + (PAR) * G_BUF + G_VT); const LAS bf16* WS = (const LAS bf16*)(C.lds + (PAR) * G_BUF + G_WS); const LAS float* BS = LNP + 2048 + (g) * 128; \
              \
            bf16x8 xf[4]; \
            _Pragma("unroll") for (int ks = 0; ks < 4; ++ks) xf[ks] = *(const LAS bf16x8*)(VT + vt_off(16 * w + r16, 32 * ks + 8 * qq)); \
            _Pragma("unroll") for (int pp = 0; pp < 4; ++pp) { \
                const u32x4 L_ = uu[PAR][pp]; const auto r0_ = __builtin_amdgcn_permlane16_swap(L_.x, L_.z, false, false), r1_ = __builtin_amdgcn_permlane16_swap(L_.y, L_.w, false, false); \
                unsigned pk_[2][2]; \
                _Pragma("unroll") for (int hf = 0; hf < 2; ++hf) { const int tt = 2 * pp + hf; \
                    f32x4 acc = (f32x4){0.f, 0.f, 0.f, 0.f}; \
                    _Pragma("unroll") for (int ks = 0; ks <= tt / 2; ++ks) { const bf16x8 yf = *(const LAS bf16x8*)(WS + (16 * tt + r16) * 136 + 32 * ks + 8 * qq); \
                        acc = __builtin_amdgcn_mfma_f32_16x16x32_bf16(xf[ks], yf, acc, 0, 0, 0); } \
                    const float bsv = BS[16 * tt + r16]; const unsigned ux_ = r0_[hf], uy_ = r1_[hf]; \
                    const float o0 = bflo(ux_) * (acc[0] + bsv), o1 = bfhi(ux_) * (acc[1] + bsv), o2 = bflo(uy_) * (acc[2] + bsv), o3 = bfhi(uy_) * (acc[3] + bsv); \
                    pk_[hf][0] = cvtpk(o0, o1); pk_[hf][1] = cvtpk(o2, o3); } \
                asm volatile("s_nop 1" : "+v"(pk_[0][0]), "+v"(pk_[0][1]), "+v"(pk_[1][0]), "+v"(pk_[1][1]));     \
                const auto s0_ = __builtin_amdgcn_permlane16_swap(pk_[0][0], pk_[1][0], false, false), s1_ = __builtin_amdgcn_permlane16_swap(pk_[0][1], pk_[1][1], false, false); \
                *(u32x4*)(UGc + (size_t)(32 * pp + 16 * (qq & 1) + r16) * D + (g) * 128 + 16 * w + 8 * (qq >> 1)) = (u32x4){s0_[0], s1_[0], s0_[1], s1_[1]}; \
            } \
            if ((g) + 1 < NGRP) P2_WRITE((g) + 1, (PAR) ^ 1, (PAR) ^ 1);        \
            if ((g) + 2 < NGRP) P2_LOADW((g) + 2); \
            if ((g) + 3 < NGRP) P2_LOADV((g) + 3, (PAR) ^ 1); \
            if ((g) + 2 < NGRP) P2_LOADU((g) + 2, PAR); \
            __syncthreads(); } while (0)
        for (int g = 0; g < NGRP; g += 2) { P2_BODY(g, 0); P2_BODY(g + 1, 1); }
#undef P2_BODY
#undef P2_LOADW
#undef P2_LOADV
#undef P2_LOADU
#undef P2_WRITE
    }
    __syncthreads();
}
constexpr int A_SLOT = 32768, A_VOFF = 16384, A_QOFF = 4 * A_SLOT, A_LUT = A_QOFF + 16384;
static_assert(A_LUT + 1024 <= LDSCTL_OFF, "attention LDS map");
constexpr int ATT_UNITS = 3 * BATCH * NH * 64;
typedef short v4i16_t __attribute__((ext_vector_type(4)));
__device__ __forceinline__ u32x2v tr16(const LAS bf16* p) { return __builtin_bit_cast(u32x2v, __builtin_amdgcn_ds_read_tr16_b64_v4i16((LAS v4i16_t*)p)); }
__device__ __forceinline__ float max3f(float a, float b, float c) { float r; asm("v_max3_f32 %0, %1, %2, %3" : "=v"(r) : "v"(a), "v"(b), "v"(c)); return r; }
struct AU { int g, b, h, r, n, dil; };
__device__ __forceinline__ AU att_decode(int U) { AU a; a.g = U >> 11; const int rem = U & 2047; a.b = rem >> 9; a.h = (rem >> 6) & 7; const int rn = rem & 63;
    a.dil = (a.g == 0) ? 1 : (a.g == 1) ? 4 : 16; const int nb = 64 / a.dil; a.r = rn / nb; a.n = rn % nb; return a; }
template <int VAR> __device__ __forceinline__ void p7_attention(const Ctx& C, bf16* QKV, float* lse, const float* lutg) {
    LAS unsigned char* L = C.lds; LAS float* LUT = (LAS float*)(L + A_LUT);
    const int tid = C.tid, lane = C.lane, w = C.wave, r16 = lane & 15, qq = lane >> 4;
    const int per = (ATT_UNITS + C.G - 1) / C.G;
    const int u_lo = C.vcu * per, u_hi = (u_lo + per < ATT_UNITS) ? u_lo + per : ATT_UNITS;
    if (u_lo >= u_hi) return;
#define ATT_SLICE(a, t) (QKV + ((size_t)((((t) * 3 + (a).g) * 8 + (a).h) * BATCH + (a).b) * SEQ + (size_t)(a).r * (SEQ / (a).dil)) * 64)
    const int drow = lane >> 3, dch = lane & 7;
#define ATT_GLDS(gsrc, ldsoff) do { unsigned keep_; const unsigned ldst_ = (unsigned)__builtin_amdgcn_readfirstlane((int)((unsigned)(uintptr_t)L + (unsigned)(ldsoff))); const bf16* gs_ = (gsrc); \
        asm volatile("s_mov_b32 %0, m0\n\ts_mov_b32 m0, %2\n\ts_nop 0\n\tglobal_load_lds_dwordx4 %1, off nt\n\ts_mov_b32 m0, %0" : "=&s"(keep_) : "v"(gs_), "s"(ldst_) : "memory"); } while (0)
#define ATT_DMA_BLOCK(a, nblk, slot) do { _Pragma("unroll") for (int j_ = 0; j_ < 2; ++j_) { const int row_ = 16 * w + 8 * j_ + drow; \
        const size_t go_ = (size_t)((nblk) * 128 + row_) * 64 + ((dch ^ ((row_ >> 1) & 7)) << 3); const int lo_ = (slot) * A_SLOT + (16 * w + 8 * j_) * 128; \
        ATT_GLDS(ATT_SLICE(a, 1) + go_, lo_); ATT_GLDS(ATT_SLICE(a, 2) + go_, lo_ + A_VOFF); } } while (0)
#define ATT_LDQ(a, q0, q1) do { const bf16* qp_ = ATT_SLICE(a, 0) + (size_t)((a).n * 128 + 16 * w + r16) * 64 + 8 * qq; \
        asm volatile("global_load_dwordx4 %0, %2, off nt\n\tglobal_load_dwordx4 %1, %2, off offset:64 nt" : "=&v"(q0), "=&v"(q1) : "v"(qp_) : "memory"); } while (0)
#define ATT_WAITBAR_Q(N, q0, q1) do { asm volatile("s_waitcnt vmcnt(" #N ") lgkmcnt(0)" : "+v"(q0), "+v"(q1) :: "memory"); __builtin_amdgcn_s_barrier(); asm volatile("" ::: "memory"); } while (0)
#define ATT_WAITBAR(N) do { asm volatile("s_waitcnt vmcnt(" #N ") lgkmcnt(0)" ::: "memory"); __builtin_amdgcn_s_barrier(); asm volatile("" ::: "memory"); } while (0)
    AU cu = att_decode(u_lo);
    u32x4 qreg[2][2];
    {
      __builtin_amdgcn_s_waitcnt(0x0F70);
      __builtin_amdgcn_s_barrier();
      if (cu.n > 0) { ATT_DMA_BLOCK(cu, cu.n - 1, 3); }
      else { _Pragma("unroll") for (int i = 0; i < 4; ++i) *(LAS v4u*)(L + 3 * A_SLOT + (tid + 512 * i) * 16) = (v4u){0u, 0u, 0u, 0u};
             _Pragma("unroll") for (int j_ = 0; j_ < 4; ++j_) ATT_GLDS(ATT_SLICE(cu, 1) + (size_t)lane * 8, 2 * A_SLOT + (16 * w + 8 * (j_ & 1)) * 128 + (j_ >> 1) * A_VOFF); }
      ATT_DMA_BLOCK(cu, cu.n, 0);
      const AU n1 = att_decode(u_lo + 1 < u_hi ? u_lo + 1 : u_lo);
      ATT_LDQ(cu, qreg[0][0], qreg[0][1]); ATT_LDQ(n1, qreg[1][0], qreg[1][1]);
      ATT_DMA_BLOCK(n1, n1.n, 1);
      if (tid < LUT_N) LUT[tid] = lutg[(cu.g * 8 + cu.h) * LUT_N + tid];
      asm volatile("s_waitcnt vmcnt(4)" : "+v"(qreg[0][0]), "+v"(qreg[0][1]) :: "memory");
      ATT_WAITBAR_Q(4, qreg[1][0], qreg[1][1]); }
    for (int U0 = u_lo; U0 < u_hi; U0 += 2) {
#pragma unroll
      for (int par = 0; par < 2; ++par) {
        const int U = U0 + par; if (U >= u_hi) break;
        const int ui = U - u_lo;
        const AU nx = att_decode(U + 1 < u_hi ? U + 1 : U), nx2 = att_decode(U + 2 < u_hi ? U + 2 : U);
        const int pbase = ((ui + 3) & 3) * A_SLOT, cbase = (ui & 3) * A_SLOT;
        const bf16x8 qf[2] = {__builtin_bit_cast(bf16x8, qreg[par][0]), __builtin_bit_cast(bf16x8, qreg[par][1])};
        if constexpr (VAR < 3) {
        ATT_DMA_BLOCK(nx2, nx2.n, (ui + 2) & 3);
        }
        f32x4 o[4]; float mx = 0.f, lsum = 1.f;
        if constexpr (VAR == 2) { _Pragma("unroll") for (int dt = 0; dt < 4; ++dt) { o[dt] = (f32x4){qf[0][0] * 1.0f, 0.f, 0.f, 0.f}; } } else {
        f32x4 s[9];
#pragma unroll
        for (int kt = 0; kt < 9; ++kt) { const int kk0 = 16 * w + 16 * kt, row = (kk0 & 127) + r16, sw = (row >> 1) & 7;
            const LAS unsigned char* kp = L + (kk0 < 128 ? pbase : cbase) + row * 128;
            const bf16x8 k0 = *(const LAS bf16x8*)(kp + ((qq ^ sw) << 4)), k1 = *(const LAS bf16x8*)(kp + (((qq + 4) ^ sw) << 4));
            f32x4 a = (f32x4){0.f, 0.f, 0.f, 0.f};
            a = __builtin_amdgcn_mfma_f32_16x16x32_bf16(k0, qf[0], a, 0, 0, 0);
            a = __builtin_amdgcn_mfma_f32_16x16x32_bf16(k1, qf[1], a, 0, 0, 0); s[kt] = a; }
        if constexpr (VAR < 3) { ATT_LDQ(nx2, qreg[par][0], qreg[par][1]); }
        const float SC = 0.125f * LOG2E, NEG = -1e30f;
        const LAS float* lp = LUT + (144 + r16 - 4 * qq);
#pragma unroll
        for (int kt = 0; kt < 9; ++kt)
#pragma unroll
            for (int j = 0; j < 4; ++j) { float t = s[kt][j] * SC + lp[-(16 * kt + j)];
                if (kt == 0) t = (4 * qq + j >= r16) ? t : NEG;
                if (kt == 8) t = (4 * qq + j <= r16) ? t : NEG;
                s[kt][j] = t; }
        if (cu.n == 0) {
#pragma unroll
            for (int kt = 0; kt < 8; ++kt) if (kt < 8 - w) { s[kt] = (f32x4){NEG, NEG, NEG, NEG}; asm volatile("" : "+v"(s[kt])); } }
        { float a_ = max3f(s[0][0], s[0][1], s[0][2]), b_ = max3f(s[0][3], s[1][0], s[1][1]);
#pragma unroll
          for (int kt = 1; kt < 9; ++kt) { if (kt & 1) { a_ = max3f(a_, s[kt][2], s[kt][3]); if (kt + 1 < 9) b_ = max3f(b_, s[kt + 1][0], s[kt + 1][1]); }
                                           else { a_ = max3f(a_, s[kt][2], s[kt][3]); if (kt + 1 < 9) b_ = max3f(b_, s[kt + 1][0], s[kt + 1][1]); } }
          mx = fmaxf(a_, b_); }
        mx = fmaxf(mx, __shfl_xor(mx, 16)); mx = fmaxf(mx, __shfl_xor(mx, 32));
#pragma unroll
        for (int kt = 0; kt < 9; ++kt)
#pragma unroll
            for (int j = 0; j < 4; ++j) s[kt][j] = __builtin_amdgcn_exp2f(s[kt][j] - mx);
        f32x4 osum = (f32x4){0.f, 0.f, 0.f, 0.f};
        const bf16x8 ones = (bf16x8){0x3F80, 0x3F80, 0x3F80, 0x3F80, 0x3F80, 0x3F80, 0x3F80, 0x3F80};
        const int vrow = 4 * qq + (r16 >> 2), vc = (r16 & 3) >> 1, vh = (r16 & 1) * 8;
#pragma unroll
        for (int dt = 0; dt < 4; ++dt) o[dt] = (f32x4){0.f, 0.f, 0.f, 0.f};
#pragma unroll
        for (int ks = 0; ks < 5; ++ks) {
            u32x4 pw; pw.x = cvtpk(s[2 * ks][0], s[2 * ks][1]); pw.y = cvtpk(s[2 * ks][2], s[2 * ks][3]);
            if (ks < 4) { pw.z = cvtpk(s[2 * ks + 1][0], s[2 * ks + 1][1]); pw.w = cvtpk(s[2 * ks + 1][2], s[2 * ks + 1][3]); } else { pw.z = 0u; pw.w = 0u; }
            const bf16x8 pf = __builtin_bit_cast(bf16x8, pw);
            osum = __builtin_amdgcn_mfma_f32_16x16x32_bf16(ones, pf, osum, 0, 0, 0);
            const int ka = 16 * w + 32 * ks, kb = ka + 16;
            const int rowa = (ka & 127) + vrow, rowb = (kb & 127) + vrow, swa = (rowa >> 1) & 7, swb = (rowb >> 1) & 7;
            const LAS unsigned char* pa = L + (ka < 128 ? pbase : cbase) + A_VOFF + rowa * 128 + vh; const LAS unsigned char* pb = L + (kb < 128 ? pbase : cbase) + A_VOFF + rowb * 128 + vh;
#pragma unroll
            for (int dt = 0; dt < 4; ++dt) {
                const u32x2v lo = tr16((const LAS bf16*)(pa + (((2 * dt + vc) ^ swa) << 4)));
                u32x2v hi = (u32x2v){0u, 0u}; if (ks < 4) hi = tr16((const LAS bf16*)(pb + (((2 * dt + vc) ^ swb) << 4)));
                const u32x4 vw = (u32x4){lo.x, lo.y, hi.x, hi.y};
                o[dt] = __builtin_amdgcn_mfma_f32_16x16x32_bf16(__builtin_bit_cast(bf16x8, vw), pf, o[dt], 0, 0, 0); } }
        lsum = osum[0]; }
        const float inv = 1.0f / lsum;
        bf16* op = ATT_SLICE(cu, 0) + (size_t)(cu.n * 128 + 16 * w + r16) * 64 + 16 * (qq & 1) + 8 * (qq >> 1);
        if constexpr (VAR == 4) { asm volatile("" :: "v"(o[0]), "v"(o[1]), "v"(o[2]), "v"(o[3]), "v"(inv), "v"(mx)); } else {
#pragma unroll
        for (int k = 0; k < 4; k += 2) {
            unsigned ax = cvtpk(o[k][0] * inv, o[k][1] * inv), ay = cvtpk(o[k][2] * inv, o[k][3] * inv), bx = cvtpk(o[k + 1][0] * inv, o[k + 1][1] * inv), by = cvtpk(o[k + 1][2] * inv, o[k + 1][3] * inv);
            asm volatile("s_nop 1" : "+v"(ax), "+v"(ay), "+v"(bx), "+v"(by));
            const auto r0 = __builtin_amdgcn_permlane16_swap(ax, bx, false, false), r1 = __builtin_amdgcn_permlane16_swap(ay, by, false, false);
            *(u32x4*)(op + 16 * k) = (u32x4){r0[0], r1[0], r0[1], r1[1]}; }
        }
        if (VAR != 4 && qq == 0) lse[((size_t)cu.g * M + (size_t)cu.b * SEQ + (size_t)((cu.n * 128 + 16 * w + r16) * cu.dil + cu.r)) * NH + cu.h] = mx + log2f(lsum);
        if ((nx.g * 8 + nx.h) != (cu.g * 8 + cu.h)) {
            ATT_WAITBAR_Q(9, qreg[par ^ 1][0], qreg[par ^ 1][1]); if (tid < LUT_N) LUT[tid] = lutg[(nx.g * 8 + nx.h) * LUT_N + tid]; ATT_WAITBAR(0); }
        else ATT_WAITBAR_Q(9, qreg[par ^ 1][0], qreg[par ^ 1][1]);
        cu = nx;
      }
    }
    ATT_WAITBAR(0);
#undef ATT_SLICE
#undef ATT_GLDS
#undef ATT_DMA_BLOCK
#undef ATT_LDQ
#undef ATT_WAITBAR_Q
#undef ATT_WAITBAR
}
__device__ __forceinline__ void p8_merge(const Ctx& C, int row_lo, const bf16* QKV, const float* lse, bf16* OM) {
    for (int idx = row_lo * 64 + C.tid; idx < (row_lo + 128) * 64; idx += NWAVES * 64) { const int tok = idx >> 6, cch = idx & 63, h = cch >> 3;
        const float l0 = lse[((size_t)0 * M + tok) * NH + h], l1 = lse[((size_t)1 * M + tok) * NH + h], l2 = lse[((size_t)2 * M + tok) * NH + h];
        const float mx = fmaxf(l0, fmaxf(l1, l2)); float w0 = __builtin_amdgcn_exp2f(l0 - mx), w1 = __builtin_amdgcn_exp2f(l1 - mx), w2 = __builtin_amdgcn_exp2f(l2 - mx);
        const float inv = 1.0f / (w0 + w1 + w2); w0 *= inv; w1 *= inv; w2 *= inv;
        const int b = tok >> 13, pos = tok & (SEQ - 1);
        const size_t hs = (size_t)BATCH * SEQ * 64;
        const bf16* base = QKV + ((size_t)b * SEQ) * 64 + (cch & 7) * 8;
        const v4u a = __builtin_nontemporal_load((const v4u*)(base + (size_t)(0 * 8 + h) * hs + (size_t)pos * 64));
        const v4u bb = __builtin_nontemporal_load((const v4u*)(base + (size_t)(1 * 8 + h) * hs + ((size_t)(pos & 3) * (SEQ / 4) + (pos >> 2)) * 64));
        const v4u c = __builtin_nontemporal_load((const v4u*)(base + (size_t)(2 * 8 + h) * hs + ((size_t)(pos & 15) * (SEQ / 16) + (pos >> 4)) * 64));
        v4u o;
        o.x = cvtpk(w0 * bflo(a.x) + w1 * bflo(bb.x) + w2 * bflo(c.x), w0 * bfhi(a.x) + w1 * bfhi(bb.x) + w2 * bfhi(c.x));
        o.y = cvtpk(w0 * bflo(a.y) + w1 * bflo(bb.y) + w2 * bflo(c.y), w0 * bfhi(a.y) + w1 * bfhi(bb.y) + w2 * bfhi(c.y));
        o.z = cvtpk(w0 * bflo(a.z) + w1 * bflo(bb.z) + w2 * bflo(c.z), w0 * bfhi(a.z) + w1 * bfhi(bb.z) + w2 * bfhi(c.z));
        o.w = cvtpk(w0 * bflo(a.w) + w1 * bflo(bb.w) + w2 * bflo(c.w), w0 * bfhi(a.w) + w1 * bfhi(bb.w) + w2 * bfhi(c.w));
        *(v4u*)(OM + (size_t)tok * AW + cch * 8) = o; }
}
__device__ __forceinline__ void p12_final(const Ctx& C, int row_lo, const bf16* hb, float* out, const float* ssq, const float* gfin) {
    f32x4 gv[4];
#pragma unroll
    for (int j = 0; j < 4; ++j) gv[j] = ((const f32x4*)gfin)[C.lane + 64 * j];
    for (int m = row_lo + C.wave; m < row_lo + 128; m += NWAVES) {
        float s = ssq[(size_t)m * 16 + (C.lane & 15)];
        const u32x2v* hr = (const u32x2v*)(hb + (size_t)m * D) + C.lane; u32x2v v[4];
#pragma unroll
        for (int j = 0; j < 4; ++j) v[j] = hr[64 * j];
        s += __shfl_xor(s, 1); s += __shfl_xor(s, 2); s += __shfl_xor(s, 4); s += __shfl_xor(s, 8);
        const float rs = __builtin_amdgcn_rsqf(s * (1.0f / 1024.0f) + EPS);
        f32x4* xr = (f32x4*)(out + (size_t)m * D) + C.lane;
#pragma unroll
        for (int j = 0; j < 4; ++j) xr[64 * j] = (f32x4){bflo(v[j].x), bfhi(v[j].x), bflo(v[j].y), bfhi(v[j].y)} * rs * gv[j]; }
}
__device__ __forceinline__ void gate_arrive(unsigned* cnt) { if (threadIdx.x == 0) (void)__hip_atomic_fetch_add(cnt, 1u, __ATOMIC_RELAXED, __HIP_MEMORY_SCOPE_AGENT); }
struct GrpBar { unsigned* cnt; unsigned phase; unsigned same; };
__device__ __forceinline__ void grp_barrier(GrpBar& b) {
    asm volatile("s_waitcnt vmcnt(0)" ::: "memory");
    __syncthreads();
    if (threadIdx.x == 0) {
        if (!b.same) { __builtin_amdgcn_fence(__ATOMIC_RELEASE, "agent"); asm volatile("s_waitcnt vmcnt(0)" ::: "memory"); }
        const unsigned target = (b.phase + 1u) * 4u;
        (void)__hip_atomic_fetch_add(b.cnt, 1u, __ATOMIC_RELAXED, __HIP_MEMORY_SCOPE_AGENT);
        unsigned sp = 0u;
        while (__hip_atomic_load(b.cnt, __ATOMIC_RELAXED, __HIP_MEMORY_SCOPE_AGENT) < target) { __builtin_amdgcn_s_sleep(1); if (++sp > (1u << 22)) break; }
        __builtin_amdgcn_fence(__ATOMIC_ACQUIRE, "agent"); asm volatile("s_waitcnt vmcnt(0)" ::: "memory");
    }
    __syncthreads();
    ++b.phase;
}
namespace pg8 {
struct EpiFinal {
    static constexpr bool PERM = true, AFTER_DRAIN = false;
    const bf16_t* hb; float* out; float* ssq; const float* gfin; int ldc; GrpBar* gb;
    __device__ __forceinline__ void operator()(f32x4 (&acc)[2][2][4][2], const Unit& u, int wr, int wc, int fr, int fq) const {
        const int row0 = u.pm * BM + wr * 64 + fr, col0 = u.pn * BM + wc * 32 + 8 * fq;
        { u32x4 r[2][4][2];
#pragma unroll
          for (int ai = 0; ai < 2; ++ai)
#pragma unroll
              for (int m = 0; m < 4; ++m)
#pragma unroll
                  for (int bj = 0; bj < 2; ++bj) r[ai][m][bj] = *(const u32x4*)(hb + (size_t)(row0 + ai * HALF + m * 16) * ldc + col0 + bj * HALF);
          asm volatile("s_waitcnt vmcnt(0)" ::: "memory");
#pragma unroll
          for (int ai = 0; ai < 2; ++ai)
#pragma unroll
              for (int m = 0; m < 4; ++m) { float q = 0.f;
#pragma unroll
                  for (int bj = 0; bj < 2; ++bj) { const u32x4 rr = r[ai][m][bj];
                      acc[ai][bj][m][0] += (f32x4){bf_lo(rr.x), bf_hi(rr.x), bf_lo(rr.y), bf_hi(rr.y)}; acc[ai][bj][m][1] += (f32x4){bf_lo(rr.z), bf_hi(rr.z), bf_lo(rr.w), bf_hi(rr.w)};
                      const f32x4 h0 = acc[ai][bj][m][0], h1 = acc[ai][bj][m][1];
                      q += ((h0[0] * h0[0] + h0[1] * h0[1]) + (h0[2] * h0[2] + h0[3] * h0[3])) + ((h1[0] * h1[0] + h1[1] * h1[1]) + (h1[2] * h1[2] + h1[3] * h1[3])); }
                  q += __shfl_xor(q, 16); q += __shfl_xor(q, 32);
                  if (fq == 0) ssq[(size_t)(row0 + ai * HALF + m * 16) * 16 + u.pn * 4 + wc] = q; } }
        f32x4 gv[2][2];
#pragma unroll
        for (int bj = 0; bj < 2; ++bj)
#pragma unroll
            for (int n = 0; n < 2; ++n) gv[bj][n] = *(const f32x4*)(gfin + col0 + bj * HALF + 4 * n);
        grp_barrier(*gb);
        f32x4 p[2][4];
#pragma unroll
        for (int ai = 0; ai < 2; ++ai)
#pragma unroll
            for (int m = 0; m < 4; ++m) p[ai][m] = *(const f32x4*)(ssq + (size_t)(row0 + ai * HALF + m * 16) * 16 + fq * 4);
#pragma unroll
        for (int ai = 0; ai < 2; ++ai)
#pragma unroll
            for (int m = 0; m < 4; ++m) { float s = (p[ai][m][0] + p[ai][m][1]) + (p[ai][m][2] + p[ai][m][3]);
                s += __shfl_xor(s, 16); s += __shfl_xor(s, 32);
                const float rs = __builtin_amdgcn_rsqf(s * (1.0f / 1024.0f) + 1e-6f);
                float* orow = out + (size_t)(row0 + ai * HALF + m * 16) * ldc + col0;
#pragma unroll
                for (int bj = 0; bj < 2; ++bj) { *(f32x4*)(orow + bj * HALF) = acc[ai][bj][m][0] * rs * gv[bj][0]; *(f32x4*)(orow + bj * HALF + 4) = acc[ai][bj][m][1] * rs * gv[bj][1]; } }
    }
};
}
struct Args { const float* in[15]; float* out; unsigned char* ws; int ph_lo, ph_hi; };
__global__ void __launch_bounds__(NWAVES * 64, 2) trunk_fwd(Args args) {
    extern __shared__ __attribute__((aligned(16))) unsigned char lds[];
    Ctx C;
    C.lds = (LAS unsigned char*)lds;
    volatile LAS unsigned* MISC = (volatile LAS unsigned*)(C.lds + MISC_OFF);
    C.tid = threadIdx.x; C.lane = C.tid & 63; C.wave = __builtin_amdgcn_readfirstlane(C.tid >> 6);
    C.G = gridDim.x; { const int bx = blockIdx.x; C.vcu = (C.G % 8 == 0) ? (bx % 8) * (C.G / 8) + bx / 8 : bx; }
    const int gx = (int)blockIdx.x % 8, k8 = ((int)blockIdx.x / 8) % 8, gz = (int)blockIdx.x / 64;
    const int item_row = (16 * gx + 8 * (gz >> 1) + k8) * 256 + (gz & 1) * 128;
    unsigned char* ws = args.ws;
    gu32* ctl = (gu32*)(ws + WS_CTL);
    if (C.tid == 0 && !MK_SPLIT) __hip_atomic_store((unsigned*)(ctl + CW_XCC) + blockIdx.x, xb_xcc_id() + 1u, __ATOMIC_RELAXED, __HIP_MEMORY_SCOPE_AGENT);
    unsigned* gate5 = (unsigned*)(ctl + CW_GATE); unsigned* gate8 = (unsigned*)(ctl + CW_GATE + 64);
    GrpBar gbr; gbr.cnt = (unsigned*)(ctl + CW_GRP) + (gx * 8 + k8) * 64; gbr.phase = 0u; gbr.same = 0u;
    const int cls = (gx >> 1) & 1, cwave = ((gz * 8 + k8) * 4 + ((gx & 1) | ((gx >> 2) << 1))) * NWAVES + C.wave;
    unsigned* s1cnt = (unsigned*)(ctl + CW_GATE + 128);
    for (int u = C.tid; u < (LDS_BYTES - LDSCTL_OFF) / 4; u += NWAVES * 64) ((LAS unsigned*)(C.lds + LDSCTL_OFF))[u] = 0u;
    __syncthreads();
    XcdBarrier bar; bar.bar = (unsigned*)(ctl + CW_BAR); bar.x = 0; bar.st = nullptr;
    if (!MK_SPLIT) bar = xcd_barrier_post((unsigned*)(ctl + CW_BAR), MISC + 8);
    const float* x = args.in[0]; const float* mixg = args.in[1]; const float* mlpg = args.in[2]; const float* fing = args.in[3];
    bf16* XN = (bf16*)(ws + WS_XN); unsigned char* big = ws + WS_BIG; bf16* OM = (bf16*)(ws + WS_OM);
    float* SSQ = (float*)(ws + WS_SSQ); float* VST = (float*)(ws + WS_VST); float* LSE = (float*)(ws + WS_LSE);
    float* out = args.out;
    const int lo = args.ph_lo, hi = args.ph_hi; int pos = 0;
#define GSTEP(BODY) do { if (lo <= pos && pos < hi) { BODY } if (lo <= pos && pos + 1 < hi) { for (int rb_ = 0; rb_ < BAR_REPS; ++rb_) xcd_barrier(bar); } ++pos; } while (0)
#define CSTEP(BODY) do { if (lo <= pos && pos < hi) { BODY } if (lo <= pos && pos + 1 < hi) { for (int rb_ = 0; rb_ < BAR_REPS; ++rb_) grp_barrier(gbr); } ++pos; } while (0)
#define STEP(BODY) do { if (lo <= pos && pos < hi) { BODY } if (lo <= pos && pos + 1 < hi) { for (int rb_ = 0; rb_ < BAR_REPS; ++rb_) xcd_barrier(bar); } ++pos; } while (0)
#define P0ARGS P0Args{x, mixg, mlpg, args.in[4], args.in[7], args.in[9], args.in[10], args.in[11], args.in[12], args.in[13], args.in[14], ws}
#define PH0 { const P0Args A = P0ARGS; p0_prologue(C, A); }
#define PH1 { pg8::Gemm g{XN, (const bf16*)(ws + WS_WIN), M, 2 * D, D, (size_t)256 * D * 2}; pg8::StaticOrder S; S.init(M, 2 * D, C.G, (int)blockIdx.x); pg8::EpiAct<1> E{(bf16*)big, 2 * D, BLK / 2, pg8::RsTable{SSQ, (LAS float*)(C.lds + RSTAB_OFF), -1}, VST, pg8::GateW{nullptr, 0u, 0}}; \
        pg8::gemm_phase<pg8::EpiAct<1>, pg8::StaticOrder, true, true>(C.lds + RING_OFF, g, S, E); }
#define PH2 { p2_gating(C, item_row / CHUNK, big, VST, (const bf16*)(ws + WS_WST), args.in[5], args.in[6], args.in[8]); }
#define S1WAIT { if (C.tid == 0) { unsigned sp = 0u; while (__hip_atomic_load(s1cnt, __ATOMIC_RELAXED, __HIP_MEMORY_SCOPE_AGENT) < 128u) { __builtin_amdgcn_s_sleep(2); if (++sp > (1u << 22)) break; } \
        __builtin_amdgcn_fence(__ATOMIC_ACQUIRE, "agent"); asm volatile("s_waitcnt vmcnt(0)" ::: "memory"); } __syncthreads(); }
#define PH3 { S1WAIT pg8::Gemm g{(const bf16*)(big + BLK_UG), (const bf16*)(ws + WS_WOA), M, D, D, BLK}; pg8::StaticOrder S; S.init(M, D, C.G, (int)blockIdx.x); pg8::EpiRes E{XN, SSQ, D}; \
        pg8::gemm_phase<pg8::EpiRes, pg8::StaticOrder, true, true>(C.lds + RING_OFF, g, S, E); }
#define PHUP(L) { pg8::Gemm g{XN, (const bf16*)(ws + WS_WUP + (L) * 8 * MiB), M, FF, D, (size_t)256 * D * 2}; pg8::StaticOrder S; S.init(M, FF, C.G, (int)blockIdx.x); pg8::EpiAct<2> E{(bf16*)big, FF, BLK / 2, pg8::RsTable{SSQ, (LAS float*)(C.lds + RSTAB_OFF), -1}, nullptr, pg8::GateW{(L) ? gate8 : nullptr, (unsigned)C.G, 0}}; \
        pg8::gemm_phase<pg8::EpiAct<2>, pg8::StaticOrder, true, true>(C.lds + RING_OFF, g, S, E); }
#define PHDN(L) { pg8::Gemm g{(const bf16*)big, (const bf16*)(ws + WS_WDN + (L) * 8 * MiB), M, D, FF, BLK}; pg8::StaticOrder S; S.init(M, D, C.G, (int)blockIdx.x); S.reversed(); pg8::EpiRes E{XN, SSQ, D}; \
        pg8::gemm_phase<pg8::EpiRes, pg8::StaticOrder, true, true>(C.lds + RING_OFF, g, S, E); if ((L) == 0) gate_arrive(gate5); }
#define PHFIN { pg8::Gemm g{(const bf16*)big, (const bf16*)(ws + WS_WDN + 8 * MiB), M, D, FF, BLK}; pg8::StaticOrder S; S.init(M, D, C.G, (int)blockIdx.x); S.reversed(); pg8::EpiFinal E{XN, out, SSQ, fing, D, &gbr}; \
        pg8::gemm_phase<pg8::EpiFinal, pg8::StaticOrder, true, true>(C.lds + RING_OFF, g, S, E); }
#define PH6 { pg8::Gemm g{XN, (const bf16*)(ws + WS_WQKV), M, NQKV, D, (size_t)256 * D * 2}; pg8::StaticOrder S; S.init(M, NQKV, C.G, (int)blockIdx.x); pg8::EpiQKV E{(bf16*)big, pg8::RsTable{SSQ, (LAS float*)(C.lds + RSTAB_OFF), -1}, SEQ, BATCH, pg8::GateW{gate5, (unsigned)C.G, 0}}; \
        pg8::gemm_phase<pg8::EpiQKV, pg8::StaticOrder, true, true>(C.lds + RING_OFF, g, S, E); \
        if (cls == 0) { const P0Args A = P0ARGS; p0_items(C, A, cwave, 128 * NWAVES, P0_AT_UP1, P0_I_UP, P0_AT_DN1, P0_I_DN); } }
#define PH6N { pg8::Gemm g{XN, (const bf16*)(ws + WS_WQKV), M, NQKV, D, (size_t)256 * D * 2}; pg8::StaticOrder S; S.init(M, NQKV, C.G, (int)blockIdx.x); pg8::EpiNull E{}; \
        pg8::gemm_phase<pg8::EpiNull, pg8::StaticOrder, true, true>(C.lds + RING_OFF, g, S, E); }
#define PH6S { pg8::Gemm g{XN, (const bf16*)(ws + WS_WQKV), M, NQKV, D, (size_t)256 * D * 2}; pg8::StaticOrder S; S.init(M, NQKV, C.G, (int)blockIdx.x); pg8::EpiStoreOnly E{(bf16*)big, NQKV}; \
        pg8::gemm_phase<pg8::EpiStoreOnly, pg8::StaticOrder, true, true>(C.lds + RING_OFF, g, S, E); }
#define PH7V(v) { p7_attention<v>(C, (bf16*)big, LSE, (const float*)(ws + WS_LUT)); }
#define PH7 { p7_attention<0>(C, (bf16*)big, LSE, (const float*)(ws + WS_LUT)); }
#define PH8 { p8_merge(C, item_row, (const bf16*)big, LSE, OM); __syncthreads(); gate_arrive(gate8); }
#define PH9 { pg8::Gemm g{OM, (const bf16*)(ws + WS_WOB), M, D, AW, (size_t)256 * AW * 2}; pg8::StaticOrder S; S.init(M, D, C.G, (int)blockIdx.x); pg8::EpiRes E{XN, SSQ, D}; \
        pg8::gemm_phase<pg8::EpiRes, pg8::StaticOrder, true, true>(C.lds + RING_OFF, g, S, E); }
#define PH12 { p12_final(C, item_row, XN, out, SSQ, fing); }
#define DUPAT(k) do { if (DUP_AFTER == (k)) { DUP_BODY } } while (0)
    GSTEP(PH0); DUPAT(0);
    if (lo <= 0 && 1 < hi) {
        const unsigned* xw = (const unsigned*)(ctl + CW_XCC) + k8 * 8 + gx;
        const unsigned a0 = __hip_atomic_load(xw, __ATOMIC_RELAXED, __HIP_MEMORY_SCOPE_AGENT), a1 = __hip_atomic_load(xw + 64, __ATOMIC_RELAXED, __HIP_MEMORY_SCOPE_AGENT),
                       a2 = __hip_atomic_load(xw + 128, __ATOMIC_RELAXED, __HIP_MEMORY_SCOPE_AGENT), a3 = __hip_atomic_load(xw + 192, __ATOMIC_RELAXED, __HIP_MEMORY_SCOPE_AGENT);
        gbr.same = (a0 != 0u && a0 == a1 && a0 == a2 && a0 == a3) ? 1u : 0u; }
    if (lo <= 0 && 1 < hi && cls == 1) { const P0Args A = P0ARGS;
        p0_items(C, A, cwave, 128 * NWAVES, P0_AT_OA, P0_AT_UP1 - P0_AT_OA, P0_AT_DN0, P0_I_DN);
        asm volatile("s_waitcnt vmcnt(0)" ::: "memory"); __syncthreads();
        if (C.tid == 0) { __builtin_amdgcn_fence(__ATOMIC_RELEASE, "agent"); asm volatile("s_waitcnt vmcnt(0)" ::: "memory"); (void)__hip_atomic_fetch_add(s1cnt, 1u, __ATOMIC_RELAXED, __HIP_MEMORY_SCOPE_AGENT); } }
    CSTEP(PH1); DUPAT(1);
    CSTEP(PH2); DUPAT(2);
    CSTEP(PH3); DUPAT(3);
    CSTEP(PHUP(0)); DUPAT(4);
    CSTEP(PHDN(0)); DUPAT(5);
    GSTEP(PH6); DUPAT(6);
    GSTEP(PH7); DUPAT(7);
    CSTEP(PH8); DUPAT(8);
    CSTEP(PH9); DUPAT(9);
    CSTEP(PHUP(1)); DUPAT(10);
    CSTEP(PHFIN);
}

extern "C" void kernel_launch(void* const* d_in, const int* in_sizes, int n_in, void* d_out, int out_size, void* d_ws, size_t ws_size, hipStream_t stream) {
    static int grid = 0;
    if (grid == 0) {
        if (n_in != 15 || in_sizes[0] != M * D || out_size != M * D || ws_size < WS_END) { fprintf(stderr, "kernel_launch: shape/workspace mismatch (n_in %d, in0 %d, out %d, ws %zu); nothing launched\n", n_in, n_in > 0 ? in_sizes[0] : -1, out_size, ws_size); grid = -1; return; }
        int dev = 0, cus = 0, per_cu = 0;
        if (hipGetDevice(&dev) != hipSuccess || hipDeviceGetAttribute(&cus, hipDeviceAttributeMultiprocessorCount, dev) != hipSuccess) { grid = -1; return; }
        if (hipFuncSetAttribute((const void*)trunk_fwd, hipFuncAttributeMaxDynamicSharedMemorySize, LDS_BYTES) != hipSuccess) { fprintf(stderr, "kernel_launch: hipFuncSetAttribute failed\n"); grid = -1; return; }
        if (hipOccupancyMaxActiveBlocksPerMultiprocessor(&per_cu, (const void*)trunk_fwd, NWAVES * 64, LDS_BYTES) != hipSuccess || per_cu < 1)
            fprintf(stderr, "kernel_launch: note: occupancy query reports %d workgroups per CU\n", per_cu);
        (void)hipGetLastError();
        grid = cus;
        if (grid != 256) { fprintf(stderr, "kernel_launch: %d CUs: this kernel's group seams are derived for a 256-workgroup grid; nothing launched\n", grid); grid = -1; return; }
    }
    if (grid < 0) return;
    if (hipMemsetAsync((char*)d_ws + WS_CTL, 0, CTL_ZERO_BYTES, stream) != hipSuccess) return;
    Args a{};
    for (int i = 0; i < 15; ++i) a.in[i] = (const float*)d_in[i];
    a.out = (float*)d_out; a.ws = (unsigned char*)d_ws;
#if MK_SPLIT
    for (int p = 0; p < N_SEQ; ++p) { a.ph_lo = p; a.ph_hi = p + 1; hipLaunchKernelGGL(trunk_fwd, dim3(grid), dim3(NWAVES * 64), LDS_BYTES, stream, a); }
#else
    a.ph_lo = 0; a.ph_hi = N_SEQ;
    hipLaunchKernelGGL(trunk_fwd, dim3(grid), dim3(NWAVES * 64), LDS_BYTES, stream, a);
#endif
    const hipError_t le = hipPeekAtLastError();
    if (le != hipSuccess) fprintf(stderr, "kernel_launch: launch failed: %s\n", hipGetErrorName(le));
}
```
